# Optimizing an MI355X kernel written in HIP

```python
import jax
import jax.numpy as jnp
from jax import lax
import numpy as np

D_MODEL = 1024
BATCH = 8
SEQ = 2048
DEPTH = 2

GRID_W = 64
CTX_LEN = 256
BLOCK = 128
HEAD_DIM = 64
ROPE_THETA = 10000.0
EPS = 1e-6
NEG_INF = -1e30

A_Q_HEADS = 8
A_KV_HEADS = 2
A_WINDOW = 128
B_HEADS = 8
B_NOPE = 64
B_ROPE = 32
B_QK = B_NOPE + B_ROPE
B_V = 64
B_Q_RANK = 256
B_KV_RANK = 256
C_HEADS = 4
C_DK = 64
C_DV = 128
D_Q_HEADS = 8
D_KV_HEADS = 2
PEER_HEADS = 8
PEER_N_KEYS = 128
PEER_N_EXPERTS = PEER_N_KEYS * PEER_N_KEYS
PEER_D_KEY = 256
PEER_TOPK = 16
PEER_BLOCK = 128

N_AB = (DEPTH + 1) // 2
N_CD = DEPTH // 2

A_Q_W = A_Q_HEADS * HEAD_DIM
A_KV_W = A_KV_HEADS * HEAD_DIM
AB_SPLITS = (A_Q_W, A_KV_W, A_KV_W, B_Q_RANK, B_KV_RANK, B_ROPE)
AB_IN = sum(AB_SPLITS)
AB_OUT = A_Q_W + B_HEADS * B_V
C_QK_W = C_HEADS * C_DK
C_V_W = C_HEADS * C_DV
D_Q_W = D_Q_HEADS * HEAD_DIM
D_KV_W = D_KV_HEADS * HEAD_DIM
CD_SPLITS = (C_QK_W, C_QK_W, C_V_W, C_V_W, D_Q_W, D_KV_W, D_KV_W)
CD_IN = sum(CD_SPLITS)
CD_OUT = C_V_W + D_Q_W

kernel_name = "hybrid_dit_window_mla_retention_axialgqa_peer"


def rms_norm(x, w):
    xf = x.astype(jnp.float32)
    y = xf * lax.rsqrt(jnp.mean(xf * xf, axis=-1, keepdims=True) + EPS)
    return (y * w.astype(jnp.float32)).astype(x.dtype)


def modulate(x, w, shift, scale):
    return rms_norm(x, w) * (1 + scale) + shift


def split_cols(z, widths):
    offsets = [int(o) for o in np.cumsum(widths)[:-1]]
    return jnp.split(z, offsets, axis=-1)


def grid_positions(n_tokens):
    rows = n_tokens // GRID_W
    row = jnp.repeat(jnp.arange(rows, dtype=jnp.int32), GRID_W)
    col = jnp.tile(jnp.arange(GRID_W, dtype=jnp.int32), rows)
    return row, col


def rope_1d(x, pos):
    half = x.shape[-1] // 2
    freqs = ROPE_THETA ** (-jnp.arange(half, dtype=jnp.float32) / half)
    ang = pos.astype(jnp.float32)[:, None] * freqs[None, :]
    cos = jnp.cos(ang)[:, None, :]
    sin = jnp.sin(ang)[:, None, :]
    xf = x.astype(jnp.float32)
    x1, x2 = xf[..., :half], xf[..., half:]
    return jnp.concatenate([x1 * cos - x2 * sin, x2 * cos + x1 * sin], axis=-1).astype(x.dtype)


def axial_rope(x, row, col):
    d = x.shape[-1] // 2
    return jnp.concatenate([rope_1d(x[..., :d], row), rope_1d(x[..., d:], col)], axis=-1)


def attend(q, k, v, sink=None):
    B, Q, Hq, d = q.shape
    Hkv = k.shape[2]
    G = Hq // Hkv
    qg = q.reshape(B, Q, Hkv, G, d)
    s = jnp.einsum('bqhgd,bkhd->bhgqk', qg, k).astype(jnp.float32) * d ** -0.5
    if sink is not None:
        s_sink = jnp.broadcast_to(sink.astype(jnp.float32).reshape(1, Hkv, G, 1, 1), s.shape[:-1] + (1,))
        p = jax.nn.softmax(jnp.concatenate([s, s_sink], axis=-1), axis=-1)[..., :-1]
    else:
        p = jax.nn.softmax(s, axis=-1)
    o = jnp.einsum('bhgqk,bkhd->bqhgd', p.astype(v.dtype), v)
    return o.reshape(B, Q, Hq * v.shape[-1])


def blocked_attention(q, k, v):
    B, S = q.shape[:2]
    nb = S // BLOCK
    qb = q.reshape((B, nb, BLOCK) + q.shape[2:]).swapaxes(0, 1)
    o = lax.map(lambda qq: attend(qq, k, v), qb)
    return o.swapaxes(0, 1).reshape(B, S, -1)


def window_attention(q, k, v, kc, vc, sink):
    B, S, Hq, d = q.shape
    Hkv = k.shape[2]
    G = Hq // Hkv
    nb = S // BLOCK
    scale = d ** -0.5
    qb = q.reshape(B, nb, BLOCK, Hkv, G, d)
    pad = ((0, 0), (BLOCK, BLOCK), (0, 0), (0, 0))
    kp = jnp.pad(k, pad).reshape(B, nb + 2, BLOCK, Hkv, d)
    vp = jnp.pad(v, pad).reshape(B, nb + 2, BLOCK, Hkv, v.shape[-1])
    kw = jnp.concatenate([kp[:, :-2], kp[:, 1:-1], kp[:, 2:]], axis=2)
    vw = jnp.concatenate([vp[:, :-2], vp[:, 1:-1], vp[:, 2:]], axis=2)
    qi = jnp.arange(BLOCK)[:, None]
    kj = jnp.arange(3 * BLOCK)[None, :]
    kpos = jnp.arange(nb)[:, None, None] * BLOCK + kj[None] - BLOCK
    valid = (jnp.abs(kj - BLOCK - qi)[None] <= A_WINDOW) & (kpos >= 0) & (kpos < S)
    s_loc = jnp.einsum('bnqhgd,bnkhd->bnhgqk', qb, kw).astype(jnp.float32) * scale
    s_loc = jnp.where(valid[None, :, None, None], s_loc, NEG_INF)
    s_ctx = jnp.einsum('bnqhgd,blhd->bnhgql', qb, kc).astype(jnp.float32) * scale
    s_sink = jnp.broadcast_to(sink.astype(jnp.float32).reshape(1, 1, Hkv, G, 1, 1), s_loc.shape[:-1] + (1,))
    p = jax.nn.softmax(jnp.concatenate([s_loc, s_ctx, s_sink], axis=-1), axis=-1).astype(v.dtype)
    nw = 3 * BLOCK
    o = (jnp.einsum('bnhgqk,bnkhd->bnqhgd', p[..., :nw], vw)
         + jnp.einsum('bnhgql,blhd->bnqhgd', p[..., nw:-1], vc))
    return o.reshape(B, S, Hq * v.shape[-1])


def retention_chunked(q, k, v, log_gamma, s0):
    q = q.astype(jnp.float32)
    k = k.astype(jnp.float32)
    v = v.astype(jnp.float32)
    B, S, H, dk = q.shape
    dv = v.shape[-1]
    nc = S // BLOCK
    idx = jnp.arange(BLOCK, dtype=jnp.float32)
    diff = idx[:, None] - idx[None, :]
    lg = log_gamma[:, None, None]
    decay_in = jnp.exp(lg * jnp.maximum(diff, 0.0)) * (diff >= 0)
    q_dec = jnp.exp(log_gamma[:, None] * (idx[None, :] + 1.0))
    k_dec = jnp.exp(log_gamma[:, None] * (BLOCK - 1.0 - idx[None, :]))
    chunk_dec = jnp.exp(log_gamma * BLOCK)
    qc = q.reshape(B, nc, BLOCK, H, dk).transpose(1, 0, 3, 2, 4)
    kc = k.reshape(B, nc, BLOCK, H, dk).transpose(1, 0, 3, 2, 4)
    vc = v.reshape(B, nc, BLOCK, H, dv).transpose(1, 0, 3, 2, 4)

    def step(state, inp):
        qi, ki, vi = inp
        s = jnp.einsum('bhqd,bhkd->bhqk', qi, ki) * decay_in
        inner = jnp.einsum('bhqk,bhkv->bhqv', s, vi)
        cross = jnp.einsum('bhqd,bhdv->bhqv', qi, state) * q_dec[None, :, :, None]
        new_state = (state * chunk_dec[None, :, None, None]
                     + jnp.einsum('bhkd,bhkv->bhdv', ki * k_dec[None, :, :, None], vi))
        return new_state, inner + cross

    s_fin, o = lax.scan(step, s0, (qc, kc, vc))
    return o.transpose(1, 0, 3, 2, 4).reshape(B, S, H, dv), s_fin


def retention_out(o, g, gn_w):
    mu = jnp.mean(o, axis=-1, keepdims=True)
    var = jnp.mean(jnp.square(o - mu), axis=-1, keepdims=True)
    y = ((o - mu) * lax.rsqrt(var + EPS)).reshape(o.shape[0], o.shape[1], C_V_W) * gn_w.astype(jnp.float32)
    return (jax.nn.silu(g.astype(jnp.float32)) * y).astype(g.dtype)


def flip_seq(t):
    return jnp.flip(t, axis=1)


def mixer_ab(h, hc, w_in, w_o, a_qn, a_kn, a_sink, b_qln, b_kvln, b_wuq, b_wukv, b_qn, b_kn,
             row, col, with_ctx_out):
    def project(z, rotate):
        Bz, n = z.shape[:2]
        qa, ka, va, cq, ckv, kr = split_cols(z @ w_in, AB_SPLITS)
        qa = rms_norm(qa.reshape(Bz, n, A_Q_HEADS, HEAD_DIM), a_qn)
        ka = rms_norm(ka.reshape(Bz, n, A_KV_HEADS, HEAD_DIM), a_kn)
        va = va.reshape(Bz, n, A_KV_HEADS, HEAD_DIM)
        qb = rms_norm((rms_norm(cq, b_qln) @ b_wuq).reshape(Bz, n, B_HEADS, B_QK), b_qn)
        kv = (rms_norm(ckv, b_kvln) @ b_wukv).reshape(Bz, n, B_HEADS, B_NOPE + B_V)
        kb = jnp.concatenate([kv[..., :B_NOPE],
                              jnp.broadcast_to(kr[:, :, None, :], (Bz, n, B_HEADS, B_ROPE))], axis=-1)
        kb = rms_norm(kb, b_kn)
        vb = kv[..., B_NOPE:]
        if rotate:
            qa = axial_rope(qa, row, col)
            ka = axial_rope(ka, row, col)
            qb = jnp.concatenate([qb[..., :B_NOPE], axial_rope(qb[..., B_NOPE:], row, col)], axis=-1)
            kb = jnp.concatenate([kb[..., :B_NOPE], axial_rope(kb[..., B_NOPE:], row, col)], axis=-1)
        return qa, ka, va, qb, kb, vb

    qa, ka, va, qb, kb, vb = project(h, True)
    qac, kac, vac, qbc, kbc, vbc = project(hc, False)
    o_a = window_attention(qa, ka, va, kac, vac, a_sink)
    o_b = blocked_attention(qb, jnp.concatenate([kbc, kb], axis=1), jnp.concatenate([vbc, vb], axis=1))
    y = jnp.concatenate([o_a, o_b], axis=-1) @ w_o
    yc = None
    if with_ctx_out:
        yc = jnp.concatenate([attend(qac, kac, vac, a_sink), attend(qbc, kbc, vbc)], axis=-1) @ w_o
    return y, yc


def mixer_cd(h, hc, w_in, w_o, dec_f, dec_b, gn_w, d_qn, d_kn, row, col, with_ctx_out):
    def project(z, rotate):
        Bz, n = z.shape[:2]
        q_r, k_r, v_r, g_r, q_d, k_d, v_d = split_cols(z @ w_in, CD_SPLITS)
        q_r = q_r.reshape(Bz, n, C_HEADS, C_DK)
        k_r = k_r.reshape(Bz, n, C_HEADS, C_DK) * C_DK ** -0.5
        v_r = v_r.reshape(Bz, n, C_HEADS, C_DV)
        q_d = rms_norm(q_d.reshape(Bz, n, D_Q_HEADS, HEAD_DIM), d_qn)
        k_d = rms_norm(k_d.reshape(Bz, n, D_KV_HEADS, HEAD_DIM), d_kn)
        v_d = v_d.reshape(Bz, n, D_KV_HEADS, HEAD_DIM)
        if rotate:
            q_r = axial_rope(q_r, row, col)
            k_r = axial_rope(k_r, row, col)
            q_d = axial_rope(q_d, row, col)
            k_d = axial_rope(k_d, row, col)
        return q_r, k_r, v_r, g_r, q_d, k_d, v_d

    q_r, k_r, v_r, g_r, q_d, k_d, v_d = project(h, True)
    q_rc, k_rc, v_rc, g_rc, q_dc, k_dc, v_dc = project(hc, False)
    lg_f = jax.nn.log_sigmoid(dec_f.astype(jnp.float32))
    lg_b = jax.nn.log_sigmoid(dec_b.astype(jnp.float32))
    zero = jnp.zeros((h.shape[0], C_HEADS, C_DK, C_DV), jnp.float32)
    oc_f, st_f = retention_chunked(q_rc, k_rc, v_rc, lg_f, zero)
    oc_b, st_b = retention_chunked(flip_seq(q_rc), flip_seq(k_rc), flip_seq(v_rc), lg_b, zero)
    o_f, _ = retention_chunked(q_r, k_r, v_r, lg_f, st_f)
    o_b, _ = retention_chunked(flip_seq(q_r), flip_seq(k_r), flip_seq(v_r), lg_b, st_b)
    y_ret = retention_out(o_f + flip_seq(o_b), g_r, gn_w)
    o_d = blocked_attention(q_d, jnp.concatenate([k_dc, k_d], axis=1), jnp.concatenate([v_dc, v_d], axis=1))
    y = jnp.concatenate([y_ret, o_d], axis=-1) @ w_o
    yc = None
    if with_ctx_out:
        yc_ret = retention_out(oc_f + flip_seq(oc_b), g_rc, gn_w)
        yc = jnp.concatenate([yc_ret, attend(q_dc, k_dc, v_dc)], axis=-1) @ w_o
    return y, yc


def peer(h, w_q, sub_keys, u_tab, v_tab):
    T, D = h.shape
    q = (h @ w_q).reshape(T, PEER_HEADS, 2, PEER_D_KEY // 2)
    scores = jnp.einsum('thpd,hpnd->thpn', q, sub_keys).astype(jnp.float32)
    s_top, i_top = lax.top_k(scores, PEER_TOPK)
    cand = s_top[:, :, 0, :, None] + s_top[:, :, 1, None, :]
    cand_idx = i_top[:, :, 0, :, None] * PEER_N_KEYS + i_top[:, :, 1, None, :]
    best, pos = lax.top_k(cand.reshape(T, PEER_HEADS, PEER_TOPK * PEER_TOPK), PEER_TOPK)
    experts = jnp.take_along_axis(cand_idx.reshape(T, PEER_HEADS, PEER_TOPK * PEER_TOPK), pos, axis=-1)
    gates = jax.nn.softmax(best, axis=-1)
    nblk = T // PEER_BLOCK
    hk = PEER_HEADS * PEER_TOPK

    def one_block(args):
        hb, eb, gb = args
        u = u_tab[eb]
        a = jax.nn.gelu(jnp.einsum('cd,ced->ce', hb, u).astype(jnp.float32))
        return jnp.einsum('ce,ced->cd', (gb * a).astype(hb.dtype), v_tab[eb])

    out = lax.map(one_block, (h.reshape(nblk, PEER_BLOCK, D),
                              experts.reshape(nblk, PEER_BLOCK, hk),
                              gates.reshape(nblk, PEER_BLOCK, hk)))
    return out.reshape(T, D)


def setup_inputs(seed: int = 0) -> dict:
    key = jax.random.key(seed)
    ks = iter(jax.random.split(key, 40))

    def normal(shape, scale):
        return jax.random.normal(next(ks), shape, jnp.float32) * scale

    def gain(shape):
        return 1.0 + normal(shape, 0.02)

    base = 1.0 - 2.0 ** (-5.0 - np.arange(C_HEADS))
    decay_logit = jnp.asarray(np.log(base / (1.0 - base)), jnp.float32)
    return {
        "x": normal((BATCH, SEQ, D_MODEL), 1.0),
        "c": normal((BATCH, D_MODEL), 1.0),
        "ctx": normal((BATCH, CTX_LEN, D_MODEL), 1.0),
        "c_ctx": normal((D_MODEL,), 1.0),
        "ada_w": normal((DEPTH, D_MODEL, 6 * D_MODEL), 0.5 * D_MODEL ** -0.5),
        "ada_b": normal((DEPTH, 6 * D_MODEL), 0.02),
        "norm1_w": gain((DEPTH, D_MODEL)),
        "norm2_w": gain((DEPTH, D_MODEL)),
        "ab_w_in": normal((N_AB, D_MODEL, AB_IN), D_MODEL ** -0.5),
        "ab_w_o": normal((N_AB, AB_OUT, D_MODEL), AB_OUT ** -0.5),
        "a_q_norm": gain((N_AB, HEAD_DIM)),
        "a_k_norm": gain((N_AB, HEAD_DIM)),
        "a_sink": normal((N_AB, A_Q_HEADS), 0.5),
        "b_q_lora_norm": gain((N_AB, B_Q_RANK)),
        "b_kv_lora_norm": gain((N_AB, B_KV_RANK)),
        "b_w_uq": normal((N_AB, B_Q_RANK, B_HEADS * B_QK), B_Q_RANK ** -0.5),
        "b_w_ukv": normal((N_AB, B_KV_RANK, B_HEADS * (B_NOPE + B_V)), B_KV_RANK ** -0.5),
        "b_q_norm": gain((N_AB, B_QK)),
        "b_k_norm": gain((N_AB, B_QK)),
        "cd_w_in": normal((N_CD, D_MODEL, CD_IN), D_MODEL ** -0.5),
        "cd_w_o": normal((N_CD, CD_OUT, D_MODEL), CD_OUT ** -0.5),
        "c_decay_fwd": decay_logit + normal((N_CD, C_HEADS), 0.05),
        "c_decay_bwd": decay_logit + normal((N_CD, C_HEADS), 0.05),
        "c_gn_w": gain((N_CD, C_V_W)),
        "d_q_norm": gain((N_CD, HEAD_DIM)),
        "d_k_norm": gain((N_CD, HEAD_DIM)),
        "peer_w_q": normal((DEPTH, D_MODEL, PEER_HEADS * PEER_D_KEY), D_MODEL ** -0.5),
        "peer_keys": normal((DEPTH, PEER_HEADS, 2, PEER_N_KEYS, PEER_D_KEY // 2), (PEER_D_KEY // 2) ** -0.5),
        "peer_u": normal((DEPTH, PEER_N_EXPERTS, D_MODEL), D_MODEL ** -0.5),
        "peer_v": normal((DEPTH, PEER_N_EXPERTS, D_MODEL), 0.1),
    }


def reference(x, c, ctx, c_ctx, ada_w, ada_b, norm1_w, norm2_w, ab_w_in, ab_w_o, a_q_norm, a_k_norm,
              a_sink, b_q_lora_norm, b_kv_lora_norm, b_w_uq, b_w_ukv, b_q_norm, b_k_norm, cd_w_in, cd_w_o,
              c_decay_fwd, c_decay_bwd, c_gn_w, d_q_norm, d_k_norm, peer_w_q, peer_keys, peer_u, peer_v):
    B, S, D = x.shape
    row, col = grid_positions(S)
    xc = ctx
    for l in range(DEPTH):
        last = l == DEPTH - 1
        i = l // 2
        mod = jax.nn.silu(c) @ ada_w[l] + ada_b[l]
        mod_c = jax.nn.silu(c_ctx) @ ada_w[l] + ada_b[l]
        sh1, sc1, g1, sh2, sc2, g2 = jnp.split(mod[:, None, :], 6, axis=-1)
        sh1c, sc1c, g1c, sh2c, sc2c, g2c = jnp.split(mod_c, 6, axis=-1)
        h = modulate(x, norm1_w[l], sh1, sc1)
        hc = modulate(xc, norm1_w[l], sh1c, sc1c)
        if l % 2 == 0:
            y, yc = mixer_ab(h, hc, ab_w_in[i], ab_w_o[i], a_q_norm[i], a_k_norm[i], a_sink[i],
                             b_q_lora_norm[i], b_kv_lora_norm[i], b_w_uq[i], b_w_ukv[i], b_q_norm[i],
                             b_k_norm[i], row, col, not last)
        else:
            y, yc = mixer_cd(h, hc, cd_w_in[i], cd_w_o[i], c_decay_fwd[i], c_decay_bwd[i], c_gn_w[i],
                             d_q_norm[i], d_k_norm[i], row, col, not last)
        x = x + g1 * y
        h2 = modulate(x, norm2_w[l], sh2, sc2)
        if last:
            f = peer(h2.reshape(B * S, D), peer_w_q[l], peer_keys[l], peer_u[l], peer_v[l])
            x = x + g2 * f.reshape(B, S, D)
        else:
            xc = xc + g1c * yc
            h2c = modulate(xc, norm2_w[l], sh2c, sc2c)
            f = peer(jnp.concatenate([h2.reshape(B * S, D), h2c.reshape(-1, D)], axis=0),
                     peer_w_q[l], peer_keys[l], peer_u[l], peer_v[l])
            x = x + g2 * f[:B * S].reshape(B, S, D)
            xc = xc + g2c * f[B * S:].reshape(xc.shape)
    return x
```

```cpp
#include <hip/hip_runtime.h>
#include <hip/hip_cooperative_groups.h>
#include <cstdio>
#include <cstring>
namespace cg = cooperative_groups;

#ifndef MULTI_LAUNCH
#define MULTI_LAUNCH 0
#endif

typedef unsigned short u16;
typedef short bf16x8 __attribute__((ext_vector_type(8)));
typedef float f32x16 __attribute__((ext_vector_type(16)));
typedef short s16x4 __attribute__((ext_vector_type(4)));
#define LDS3 __attribute__((address_space(3)))
typedef __bf16 bf2_t __attribute__((ext_vector_type(2)));
typedef float f2_t __attribute__((ext_vector_type(2)));
typedef unsigned int u32x4 __attribute__((ext_vector_type(4)));
typedef unsigned int u32x2 __attribute__((ext_vector_type(2)));
typedef float f32x4 __attribute__((ext_vector_type(4)));
typedef float f32x2 __attribute__((ext_vector_type(2)));
#define DI __device__ __forceinline__
#define MFMA(a, b, c) __builtin_amdgcn_mfma_f32_32x32x16_bf16((a), (b), (c), 0, 0, 0)

constexpr int TL = 16384;
constexpr int TC = 2048;
constexpr int TA = 18432;
constexpr int NPHASE = 19;
constexpr float EPSF = 1e-6f;
constexpr float LOG2E = 1.4426950408889634f;

struct KArgs {
  const float* in[30];
  float* out;
  char* ws;
#ifdef EXPERIMENT
  int rep[8];
#endif
};
struct Params {
  const float *x, *c, *ctx, *c_ctx, *ada_w, *ada_b, *norm1_w, *norm2_w, *ab_w_in, *ab_w_o, *a_q_norm, *a_k_norm, *a_sink,
      *b_q_lora_norm, *b_kv_lora_norm, *b_w_uq, *b_w_ukv, *b_q_norm, *b_k_norm, *cd_w_in, *cd_w_o, *c_decay_fwd, *c_decay_bwd,
      *c_gn_w, *d_q_norm, *d_k_norm, *peer_w_q, *peer_keys, *peer_u, *peer_v;
  float* out;
  u16 *U16, *V16, *WT_ABIN, *WT_ABO, *WT_UQ, *WT_UKV, *WT_CDIN, *WT_CDO, *WT_PQ, *KEYS16;
  float *MOD, *ROPE16, *ROPE8, *XRES;
  u16 *HB, *AO, *Z, *QB, *KVR, *KB, *VB;
  float* LST;
  float* SC;
  u16* PQ;
  int* EIDX;
  float* GATE;
  unsigned* BAR;
  unsigned char *U8, *V8;
  float *SCU, *SCV;
#ifdef EXPERIMENT
  int rep[8];
#endif
};
constexpr size_t al256(size_t x) { return (x + 255) & ~(size_t)255; }
constexpr size_t OFF_U16 = 0;
constexpr size_t OFF_V16 = OFF_U16 + al256(2UL * 16384 * 1024 * 2);
constexpr size_t OFF_WT_ABIN = OFF_V16 + al256(2UL * 16384 * 1024 * 2);
constexpr size_t OFF_WT_ABO = OFF_WT_ABIN + al256(1408UL * 1024 * 2);
constexpr size_t OFF_WT_UQ = OFF_WT_ABO + al256(1024UL * 1024 * 2);
constexpr size_t OFF_WT_UKV = OFF_WT_UQ + al256(768UL * 256 * 2);
constexpr size_t OFF_WT_CDIN = OFF_WT_UKV + al256(1024UL * 256 * 2);
constexpr size_t OFF_WT_CDO = OFF_WT_CDIN + al256(2304UL * 1024 * 2);
constexpr size_t OFF_WT_PQ = OFF_WT_CDO + al256(1024UL * 1024 * 2);
constexpr size_t OFF_KEYS16 = OFF_WT_PQ + al256(2UL * 2048 * 1024 * 2);
constexpr size_t OFF_MOD = OFF_KEYS16 + al256(2UL * 16 * 128 * 128 * 2);
constexpr size_t OFF_ROPE16 = OFF_MOD + al256(2UL * 9 * 6144 * 4);
constexpr size_t OFF_ROPE8 = OFF_ROPE16 + al256(64UL * 16 * 2 * 4);
constexpr size_t OFF_BAR = OFF_ROPE8 + al256(64UL * 8 * 2 * 4);
constexpr size_t OFF_SCU = OFF_BAR + al256(4096UL * 4);
constexpr size_t OFF_SCV = OFF_SCU + al256(2UL * 16384 * 4);
constexpr size_t OFF_XRES = OFF_SCV + al256(2UL * 16384 * 4);
constexpr size_t OFF_HB = OFF_XRES + al256((size_t)TA * 1024 * 4);
constexpr size_t OFF_R = OFF_HB + al256((size_t)TA * 1024 * 2);
constexpr size_t OFF_AO = OFF_R;
constexpr size_t OFF_Z = OFF_AO + (size_t)TA * 1024 * 2;
constexpr size_t OFF_QB = OFF_Z + (size_t)TA * 2304 * 2;
constexpr size_t OFF_KVR = OFF_QB + (size_t)TA * 768 * 2;
constexpr size_t OFF_KB = OFF_KVR + (size_t)TA * 1024 * 2;
constexpr size_t OFF_VB = OFF_KB + (size_t)TA * 768 * 2;
constexpr size_t OFF_SC = OFF_R;
constexpr size_t OFF_PQ = OFF_SC + (size_t)TA * 2048 * 4;
constexpr size_t OFF_EIDX = OFF_PQ + (size_t)TA * 2048 * 2;
constexpr size_t OFF_GATE = OFF_EIDX + (size_t)TA * 128 * 4;
constexpr size_t WS_END = OFF_GATE + (size_t)TA * 128 * 4;
static_assert(WS_END <= 536870912UL, "workspace map exceeds 512 MiB");
static_assert(OFF_VB + (size_t)TA * 512 * 2 <= 536870912UL, "workspace map exceeds 512 MiB");

DI Params make_params(const KArgs& a) {
  Params p;
  p.x = a.in[0]; p.c = a.in[1]; p.ctx = a.in[2]; p.c_ctx = a.in[3]; p.ada_w = a.in[4]; p.ada_b = a.in[5]; p.norm1_w = a.in[6];
  p.norm2_w = a.in[7]; p.ab_w_in = a.in[8]; p.ab_w_o = a.in[9]; p.a_q_norm = a.in[10]; p.a_k_norm = a.in[11]; p.a_sink = a.in[12];
  p.b_q_lora_norm = a.in[13]; p.b_kv_lora_norm = a.in[14]; p.b_w_uq = a.in[15]; p.b_w_ukv = a.in[16]; p.b_q_norm = a.in[17];
  p.b_k_norm = a.in[18]; p.cd_w_in = a.in[19]; p.cd_w_o = a.in[20]; p.c_decay_fwd = a.in[21]; p.c_decay_bwd = a.in[22];
  p.c_gn_w = a.in[23]; p.d_q_norm = a.in[24]; p.d_k_norm = a.in[25]; p.peer_w_q = a.in[26]; p.peer_keys = a.in[27];
  p.peer_u = a.in[28]; p.peer_v = a.in[29];
  p.out = a.out;
#ifdef EXPERIMENT
  for (int i = 0; i < 8; ++i) p.rep[i] = a.rep[i];
#endif
  char* ws = a.ws;
  p.U16 = (u16*)(ws + OFF_U16); p.V16 = (u16*)(ws + OFF_V16); p.WT_ABIN = (u16*)(ws + OFF_WT_ABIN); p.WT_ABO = (u16*)(ws + OFF_WT_ABO);
  p.WT_UQ = (u16*)(ws + OFF_WT_UQ); p.WT_UKV = (u16*)(ws + OFF_WT_UKV); p.WT_CDIN = (u16*)(ws + OFF_WT_CDIN); p.WT_CDO = (u16*)(ws + OFF_WT_CDO);
  p.WT_PQ = (u16*)(ws + OFF_WT_PQ); p.KEYS16 = (u16*)(ws + OFF_KEYS16); p.MOD = (float*)(ws + OFF_MOD); p.ROPE16 = (float*)(ws + OFF_ROPE16);
  p.ROPE8 = (float*)(ws + OFF_ROPE8); p.BAR = (unsigned*)(ws + OFF_BAR); p.XRES = (float*)(ws + OFF_XRES); p.HB = (u16*)(ws + OFF_HB);
  p.AO = (u16*)(ws + OFF_AO); p.Z = (u16*)(ws + OFF_Z); p.QB = (u16*)(ws + OFF_QB); p.LST = (float*)(ws + OFF_QB); p.KVR = (u16*)(ws + OFF_KVR);
  p.KB = (u16*)(ws + OFF_KB); p.VB = (u16*)(ws + OFF_VB); p.SC = (float*)(ws + OFF_SC); p.PQ = (u16*)(ws + OFF_PQ);
  p.EIDX = (int*)(ws + OFF_EIDX); p.GATE = (float*)(ws + OFF_GATE);
  p.U8 = (unsigned char*)(ws + OFF_U16); p.V8 = (unsigned char*)(ws + OFF_V16); p.SCU = (float*)(ws + OFF_SCU); p.SCV = (float*)(ws + OFF_SCV);
  return p;
}

DI unsigned pack2(float a, float b) {
  f2_t v = {a, b};
  return __builtin_bit_cast(unsigned, __builtin_convertvector(v, bf2_t));
}
DI u16 f2bf(float a) { return (u16)(pack2(a, 0.f) & 0xffffu); }
DI float bf2f(u16 v) { return __uint_as_float(((unsigned)v) << 16); }
DI float bflo(unsigned v) { return __uint_as_float(v << 16); }
DI float bfhi(unsigned v) { return __uint_as_float(v & 0xffff0000u); }
DI float wsum(float v) {
#pragma unroll
  for (int o = 32; o >= 1; o >>= 1) v += __shfl_xor(v, o);
  return v;
}
DI float wmax(float v) {
#pragma unroll
  for (int o = 32; o >= 1; o >>= 1) v = fmaxf(v, __shfl_xor(v, o));
  return v;
}
DI int crow(int reg, int h) { return (reg & 3) + 8 * (reg >> 2) + 4 * h; }
DI float ex2(float x) { return __builtin_amdgcn_exp2f(x); }
DI bf16x8 as_bf16x8(u32x4 v) { return __builtin_bit_cast(bf16x8, v); }
DI bf16x8 join8(u32x2 a, u32x2 b) { u32x4 v = {a.x, a.y, b.x, b.y}; return __builtin_bit_cast(bf16x8, v); }
DI bf16x8 pack8(const f32x16& x, int s) {
  u32x4 v;
  v.x = pack2(x[8 * s + 0], x[8 * s + 1]);
  v.y = pack2(x[8 * s + 2], x[8 * s + 3]);
  v.z = pack2(x[8 * s + 4], x[8 * s + 5]);
  v.w = pack2(x[8 * s + 6], x[8 * s + 7]);
  return __builtin_bit_cast(bf16x8, v);
}
DI f32x16 zero16() {
  f32x16 z;
#pragma unroll
  for (int i = 0; i < 16; ++i) z[i] = 0.f;
  return z;
}
DI float log_sigmoid(float x) { return -log1pf(__expf(-x)); }
DI float silu(float x) { return x / (1.f + __expf(-x)); }
DI float gelu_tanh(float x) {
  float u = 0.7978845608028654f * (x + 0.044715f * x * x * x);
  float t = 1.f - 2.f / (__expf(2.f * u) + 1.f);
  return 0.5f * x * (1.f + t);
}

DI float rowsum16(float v) {
  v += __builtin_bit_cast(float, __builtin_amdgcn_update_dpp(0, __builtin_bit_cast(int, v), 0x128, 0xf, 0xf, false));
  v += __builtin_bit_cast(float, __builtin_amdgcn_update_dpp(0, __builtin_bit_cast(int, v), 0x124, 0xf, 0xf, false));
  v += __builtin_bit_cast(float, __builtin_amdgcn_update_dpp(0, __builtin_bit_cast(int, v), 0x122, 0xf, 0xf, false));
  v += __builtin_bit_cast(float, __builtin_amdgcn_update_dpp(0, __builtin_bit_cast(int, v), 0x121, 0xf, 0xf, false));
  return v;
}
DI float wsum_fast(float v) {
  v = rowsum16(v);
  const int iv = __builtin_bit_cast(int, v);
  const float a = __builtin_bit_cast(float, __builtin_amdgcn_readlane(iv, 0));
  const float b = __builtin_bit_cast(float, __builtin_amdgcn_readlane(iv, 16));
  const float c = __builtin_bit_cast(float, __builtin_amdgcn_readlane(iv, 32));
  const float d = __builtin_bit_cast(float, __builtin_amdgcn_readlane(iv, 48));
  return (a + b) + (c + d);
}
DI float rowmax16(float v) {
  v = fmaxf(v, __builtin_bit_cast(float, __builtin_amdgcn_update_dpp(0, __builtin_bit_cast(int, v), 0x128, 0xf, 0xf, false)));
  v = fmaxf(v, __builtin_bit_cast(float, __builtin_amdgcn_update_dpp(0, __builtin_bit_cast(int, v), 0x124, 0xf, 0xf, false)));
  v = fmaxf(v, __builtin_bit_cast(float, __builtin_amdgcn_update_dpp(0, __builtin_bit_cast(int, v), 0x122, 0xf, 0xf, false)));
  v = fmaxf(v, __builtin_bit_cast(float, __builtin_amdgcn_update_dpp(0, __builtin_bit_cast(int, v), 0x121, 0xf, 0xf, false)));
  return v;
}
DI float wmax_fast(float v) {
  v = rowmax16(v);
  const int iv = __builtin_bit_cast(int, v);
  const float a = __builtin_bit_cast(float, __builtin_amdgcn_readlane(iv, 0));
  const float b = __builtin_bit_cast(float, __builtin_amdgcn_readlane(iv, 16));
  const float c = __builtin_bit_cast(float, __builtin_amdgcn_readlane(iv, 32));
  const float d = __builtin_bit_cast(float, __builtin_amdgcn_readlane(iv, 48));
  return fmaxf(fmaxf(a, b), fmaxf(c, d));
}
DI void convert_fp8_rows(const float* __restrict__ src, unsigned char* __restrict__ dst, float* __restrict__ scl, int nrows, int wi, int nwk) {
  const int lane = threadIdx.x & 63, w = threadIdx.x >> 6;
  for (int row0 = (wi * 4 + w) * 4; row0 < nrows; row0 += nwk * 16) {
    f32x4 v[4][4];
#pragma unroll
    for (int rr = 0; rr < 4; ++rr) {
      const float* sp = src + (long)(row0 + rr) * 1024 + lane * 16;
#pragma unroll
      for (int q = 0; q < 4; ++q) v[rr][q] = *(const f32x4*)(sp + q * 4);
    }
#pragma unroll
    for (int rr = 0; rr < 4; ++rr) {
      float am = 0.f;
#pragma unroll
      for (int q = 0; q < 4; ++q)
        am = fmaxf(am, fmaxf(fmaxf(fabsf(v[rr][q].x), fabsf(v[rr][q].y)), fmaxf(fabsf(v[rr][q].z), fabsf(v[rr][q].w))));
      am = wmax_fast(am);
      const float inv = am > 0.f ? 224.f / am : 0.f;
      u32x4 o;
#pragma unroll
      for (int q = 0; q < 4; ++q) {
        int pk = 0;
        pk = __builtin_amdgcn_cvt_pk_fp8_f32(v[rr][q].x * inv, v[rr][q].y * inv, pk, false);
        pk = __builtin_amdgcn_cvt_pk_fp8_f32(v[rr][q].z * inv, v[rr][q].w * inv, pk, true);
        o[q] = (unsigned)pk;
      }
      *(u32x4*)(dst + (long)(row0 + rr) * 1024 + lane * 16) = o;
      if (lane == 0) scl[row0 + rr] = am * (1.f / 224.f);
    }
  }
}

DI void convert_fp4_rows(const float* __restrict__ src, unsigned char* __restrict__ dst, float* __restrict__ scl, int nrows, int wi, int nwk) {
  const int lane = threadIdx.x & 63, w = threadIdx.x >> 6;
  for (int row0 = (wi * 4 + w) * 4; row0 < nrows; row0 += nwk * 16) {
    f32x4 v[4][4];
#pragma unroll
    for (int rr = 0; rr < 4; ++rr) {
      const float* sp = src + (long)(row0 + rr) * 1024 + lane * 16;
#pragma unroll
      for (int q = 0; q < 4; ++q) v[rr][q] = *(const f32x4*)(sp + q * 4);
    }
#pragma unroll
    for (int rr = 0; rr < 4; ++rr) {
      float am = 0.f;
#pragma unroll
      for (int q = 0; q < 4; ++q)
        am = fmaxf(am, fmaxf(fmaxf(fabsf(v[rr][q].x), fabsf(v[rr][q].y)), fmaxf(fabsf(v[rr][q].z), fabsf(v[rr][q].w))));
      am = wmax_fast(am);
      const float inv = am > 0.f ? 6.f / am : 0.f;
      u32x2 o;
#pragma unroll
      for (int d = 0; d < 2; ++d) {
        unsigned pk = 0u;
        pk = __builtin_amdgcn_cvt_scalef32_pk_fp4_f32(pk, v[rr][2 * d].x * inv, v[rr][2 * d].y * inv, 1.0f, 0);
        pk = __builtin_amdgcn_cvt_scalef32_pk_fp4_f32(pk, v[rr][2 * d].z * inv, v[rr][2 * d].w * inv, 1.0f, 1);
        pk = __builtin_amdgcn_cvt_scalef32_pk_fp4_f32(pk, v[rr][2 * d + 1].x * inv, v[rr][2 * d + 1].y * inv, 1.0f, 2);
        pk = __builtin_amdgcn_cvt_scalef32_pk_fp4_f32(pk, v[rr][2 * d + 1].z * inv, v[rr][2 * d + 1].w * inv, 1.0f, 3);
        o[d] = pk;
      }
      *(u32x2*)(dst + (long)(row0 + rr) * 512 + lane * 8) = o;
      if (lane == 0) scl[row0 + rr] = am * (1.f / 6.f);
    }
  }
}

DI void transpose_w(const float* __restrict__ W, int K, int N, int Npad, u16* __restrict__ Wt, long gtid, long gsz) {
  const long items = (long)Npad * (K / 8);
  for (long id0 = gtid; id0 < items; id0 += 2 * gsz) {
    u32x4 o[2];
    long idv[2];
#pragma unroll
    for (int u = 0; u < 2; ++u) {
      const long id = id0 + u * gsz;
      idv[u] = id;
      u32x4 oo = {0u, 0u, 0u, 0u};
      if (id < items) {
        const int n = (int)(id % Npad), k8 = (int)(id / Npad);
        if (n < N) {
          const float* sp = W + (long)(k8 * 8) * N + n;
          oo.x = pack2(sp[0], sp[(long)N]);
          oo.y = pack2(sp[2L * N], sp[3L * N]);
          oo.z = pack2(sp[4L * N], sp[5L * N]);
          oo.w = pack2(sp[6L * N], sp[7L * N]);
        }
      }
      o[u] = oo;
    }
#pragma unroll
    for (int u = 0; u < 2; ++u) {
      const long id = idv[u];
      if (id < items) {
        const int n = (int)(id % Npad), k8 = (int)(id / Npad);
        *(u32x4*)(Wt + (long)n * K + k8 * 8) = o[u];
      }
    }
  }
}
DI void convert8(const float* __restrict__ src, u16* __restrict__ dst, long n8, long gtid, long gsz) {
  for (long i = gtid; i < n8; i += gsz) {
    const f32x4 a = ((const f32x4*)src)[2 * i], b = ((const f32x4*)src)[2 * i + 1];
    u32x4 o;
    o.x = pack2(a.x, a.y); o.y = pack2(a.z, a.w); o.z = pack2(b.x, b.y); o.w = pack2(b.z, b.w);
    ((u32x4*)dst)[i] = o;
  }
}

DI void phase_prep(const Params& p, char* smem) {
  const int tid = threadIdx.x;
  const long gtid = (long)blockIdx.x * 256 + tid, gsz = (long)gridDim.x * 256;
  {
    float* sS = (float*)smem;
    float* sR = sS + 9 * 256;
    for (int it = blockIdx.x; it < 768; it += gridDim.x) {
      const int kq = it & 3, cb = (it >> 2) % 96, l = it / 384;
      __syncthreads();
      for (int i = tid; i < 9 * 256; i += 256) {
        const int bi = i >> 8, k = kq * 256 + (i & 255);
        const float v = (bi < 8) ? p.c[bi * 1024 + k] : p.c_ctx[k];
        sS[i] = silu(v);
      }
      __syncthreads();
      const int col = cb * 64 + (tid & 63), kg = tid >> 6;
      const float* wp = p.ada_w + (long)l * 1024 * 6144 + (long)(kq * 256 + kg * 64) * 6144 + col;
      float acc[9];
#pragma unroll
      for (int i = 0; i < 9; ++i) acc[i] = 0.f;
#pragma unroll 8
      for (int k = 0; k < 64; ++k) {
        const float wv = wp[(long)k * 6144];
#pragma unroll
        for (int i = 0; i < 9; ++i) acc[i] += sS[i * 256 + kg * 64 + k] * wv;
      }
#pragma unroll
      for (int i = 0; i < 9; ++i) sR[(kg * 9 + i) * 64 + (tid & 63)] = acc[i];
      __syncthreads();
      for (int i = tid; i < 9 * 64; i += 256) {
        const int bi = i >> 6, cc = i & 63;
        float sm = sR[(0 * 9 + bi) * 64 + cc] + sR[(1 * 9 + bi) * 64 + cc] + sR[(2 * 9 + bi) * 64 + cc] + sR[(3 * 9 + bi) * 64 + cc];
        if (kq == 0) sm += p.ada_b[l * 6144 + cb * 64 + cc];
        atomicAdd(&p.MOD[((long)l * 9 + bi) * 6144 + cb * 64 + cc], sm);
      }
    }
    __syncthreads();
  }
  for (long i = gtid; i < 64 * 16; i += gsz) {
    const int pos = (int)(i >> 4), f = (int)(i & 15);
    const float ang = (float)pos * exp2f(-(float)f * (13.287712379549449f / 16.f));
    p.ROPE16[2 * i] = __cosf(ang); p.ROPE16[2 * i + 1] = __sinf(ang);
  }
  for (long i = gtid; i < 64 * 8; i += gsz) {
    const int pos = (int)(i >> 3), f = (int)(i & 7);
    const float ang = (float)pos * exp2f(-(float)f * (13.287712379549449f / 8.f));
    p.ROPE8[2 * i] = __cosf(ang); p.ROPE8[2 * i + 1] = __sinf(ang);
  }
  transpose_w(p.ab_w_in, 1024, 1312, 1408, p.WT_ABIN, gtid, gsz);
  transpose_w(p.ab_w_o, 1024, 1024, 1024, p.WT_ABO, gtid, gsz);
  transpose_w(p.b_w_uq, 256, 768, 768, p.WT_UQ, gtid, gsz);
  transpose_w(p.b_w_ukv, 256, 1024, 1024, p.WT_UKV, gtid, gsz);
  transpose_w(p.cd_w_in, 1024, 2304, 2304, p.WT_CDIN, gtid, gsz);
  transpose_w(p.cd_w_o, 1024, 1024, 1024, p.WT_CDO, gtid, gsz);
  transpose_w(p.peer_w_q, 1024, 2048, 2048, p.WT_PQ, gtid, gsz);
  transpose_w(p.peer_w_q + 1024L * 2048, 1024, 2048, 2048, p.WT_PQ + 2048L * 1024, gtid, gsz);
  convert8(p.peer_keys, p.KEYS16, 2L * 16 * 128 * 128 / 8, gtid, gsz);
}

DI void phase_modulate(const Params& p, const float* src_lat, const float* src_ctx, int nrows, const float* normw,
                       const float* modl, int sh_off, int sc_off) {
  const int lane = threadIdx.x & 63, w = threadIdx.x >> 6;
  const int stride = gridDim.x * 4;
  int m = blockIdx.x * 4 + w;
  f32x4 v[4], vn[4];
  f32x4 nw[4];
#pragma unroll
  for (int i = 0; i < 4; ++i) nw[i] = *(const f32x4*)(normw + i * 256 + lane * 4);
  if (m < nrows) {
    const float* src = (m < TL) ? src_lat + (long)m * 1024 : src_ctx + (long)(m - TL) * 1024;
#pragma unroll
    for (int i = 0; i < 4; ++i) v[i] = *(const f32x4*)(src + i * 256 + lane * 4);
  }
  while (m < nrows) {
    const int mn = m + stride;
    if (mn < nrows) {
      const float* src = (mn < TL) ? src_lat + (long)mn * 1024 : src_ctx + (long)(mn - TL) * 1024;
#pragma unroll
      for (int i = 0; i < 4; ++i) vn[i] = *(const f32x4*)(src + i * 256 + lane * 4);
    }
    const int bi = (m < TL) ? (m >> 11) : 8;
    const float* md = modl + bi * 6144;
    f32x4 sc[4], sh[4];
#pragma unroll
    for (int i = 0; i < 4; ++i) {
      sc[i] = *(const f32x4*)(md + sc_off + i * 256 + lane * 4);
      sh[i] = *(const f32x4*)(md + sh_off + i * 256 + lane * 4);
    }
    float ss = 0.f;
#pragma unroll
    for (int i = 0; i < 4; ++i) ss += v[i].x * v[i].x + v[i].y * v[i].y + v[i].z * v[i].z + v[i].w * v[i].w;
    ss = wsum_fast(ss);
    const float rstd = rsqrtf(ss * (1.f / 1024.f) + EPSF);
#pragma unroll
    for (int i = 0; i < 4; ++i) {
      const int col = i * 256 + lane * 4;
      const float y0 = v[i].x * rstd * nw[i].x * (1.f + sc[i].x) + sh[i].x;
      const float y1 = v[i].y * rstd * nw[i].y * (1.f + sc[i].y) + sh[i].y;
      const float y2 = v[i].z * rstd * nw[i].z * (1.f + sc[i].z) + sh[i].z;
      const float y3 = v[i].w * rstd * nw[i].w * (1.f + sc[i].w) + sh[i].w;
      u32x2 o = {pack2(y0, y1), pack2(y2, y3)};
      *(u32x2*)(p.HB + (long)m * 1024 + col) = o;
    }
#pragma unroll
    for (int i = 0; i < 4; ++i) v[i] = vn[i];
    m = mn;
  }
}

struct EpiArgs {
  void* C; int ldc; int N;
  const float* xin_lat; const float* xin_ctx; const float* g;
};
template <int EPI>
DI void gemm_phase(char* smem, const u16* __restrict__ A, int lda, int acs, const u16* __restrict__ Wt, int K, int MT, int NT,
                   int rot, const EpiArgs& ea) {
  u16* sAB = (u16*)smem;
  constexpr int STG = 2 * 128 * 72;
  const int tid = threadIdx.x, lane = tid & 63, w = tid >> 6, r = lane & 31, h = lane >> 5;
  const int wm = w >> 1, wn = w & 1;
  const int nslot = gridDim.x >> 3, xcd = blockIdx.x & 7;
  int first = ((int)(blockIdx.x >> 3) - rot) % nslot;
  if (first < 0) first += nslot;
  const int lrow = tid >> 3, lkc = tid & 7;
  const int per_xcd = (MT >> 3) * NT;
  for (int t = first; t < per_xcd; t += nslot) {
    const int mt = xcd + 8 * (t / NT), nt = t % NT;
    const u16* Ab = A + (long)(mt * 128 + lrow) * lda + nt * acs + lkc * 8;
    const u16* Bb = Wt + (long)(nt * 128 + lrow) * K + lkc * 8;
    f32x16 acc[2][2];
#pragma unroll
    for (int i = 0; i < 2; ++i)
#pragma unroll
      for (int j = 0; j < 2; ++j) acc[i][j] = zero16();
    u32x4 ra0[4], rb0[4], ra1[4], rb1[4];
    const int nk = K >> 6;
#pragma unroll
    for (int i = 0; i < 4; ++i) {
      ra0[i] = *(const u32x4*)(Ab + (long)(32 * i) * lda);
      rb0[i] = *(const u32x4*)(Bb + (long)(32 * i) * K);
    }
#pragma unroll
    for (int i = 0; i < 4; ++i) {
      ra1[i] = *(const u32x4*)(Ab + (long)(32 * i) * lda + 64);
      rb1[i] = *(const u32x4*)(Bb + (long)(32 * i) * K + 64);
    }
    __syncthreads();
#pragma unroll
    for (int i = 0; i < 4; ++i) {
      *(u32x4*)(sAB + (lrow + 32 * i) * 72 + lkc * 8) = ra0[i];
      *(u32x4*)(sAB + 128 * 72 + (lrow + 32 * i) * 72 + lkc * 8) = rb0[i];
    }
    __syncthreads();
    for (int k0 = 0; k0 < nk; k0 += 2) {
      if (k0 + 2 < nk) {
#pragma unroll
        for (int i = 0; i < 4; ++i) {
          ra0[i] = *(const u32x4*)(Ab + (long)(32 * i) * lda + (k0 + 2) * 64);
          rb0[i] = *(const u32x4*)(Bb + (long)(32 * i) * K + (k0 + 2) * 64);
        }
      }
      {
        const u16* cA = sAB;
        const u16* cB = cA + 128 * 72;
#pragma unroll
        for (int ks = 0; ks < 4; ++ks) {
          bf16x8 af[2], bfr[2];
#pragma unroll
          for (int i = 0; i < 2; ++i) {
            af[i] = *(const bf16x8*)(cA + (wm * 64 + i * 32 + r) * 72 + ks * 16 + h * 8);
            bfr[i] = *(const bf16x8*)(cB + (wn * 64 + i * 32 + r) * 72 + ks * 16 + h * 8);
          }
#pragma unroll
          for (int i = 0; i < 2; ++i)
#pragma unroll
            for (int j = 0; j < 2; ++j) acc[i][j] = MFMA(af[i], bfr[j], acc[i][j]);
        }
      }
      {
        u16* nA = sAB + STG;
#pragma unroll
        for (int i = 0; i < 4; ++i) {
          *(u32x4*)(nA + (lrow + 32 * i) * 72 + lkc * 8) = ra1[i];
          *(u32x4*)(nA + 128 * 72 + (lrow + 32 * i) * 72 + lkc * 8) = rb1[i];
        }
        __syncthreads();
      }
      if (k0 + 3 < nk) {
#pragma unroll
        for (int i = 0; i < 4; ++i) {
          ra1[i] = *(const u32x4*)(Ab + (long)(32 * i) * lda + (k0 + 3) * 64);
          rb1[i] = *(const u32x4*)(Bb + (long)(32 * i) * K + (k0 + 3) * 64);
        }
      }
      {
        const u16* cA = sAB + STG;
        const u16* cB = cA + 128 * 72;
#pragma unroll
        for (int ks = 0; ks < 4; ++ks) {
          bf16x8 af[2], bfr[2];
#pragma unroll
          for (int i = 0; i < 2; ++i) {
            af[i] = *(const bf16x8*)(cA + (wm * 64 + i * 32 + r) * 72 + ks * 16 + h * 8);
            bfr[i] = *(const bf16x8*)(cB + (wn * 64 + i * 32 + r) * 72 + ks * 16 + h * 8);
          }
#pragma unroll
          for (int i = 0; i < 2; ++i)
#pragma unroll
            for (int j = 0; j < 2; ++j) acc[i][j] = MFMA(af[i], bfr[j], acc[i][j]);
        }
      }
      if (k0 + 2 < nk) {
        u16* nA = sAB;
#pragma unroll
        for (int i = 0; i < 4; ++i) {
          *(u32x4*)(nA + (lrow + 32 * i) * 72 + lkc * 8) = ra0[i];
          *(u32x4*)(nA + 128 * 72 + (lrow + 32 * i) * 72 + lkc * 8) = rb0[i];
        }
        __syncthreads();
      }
    }
#pragma unroll
    for (int i = 0; i < 2; ++i)
#pragma unroll
      for (int j = 0; j < 2; ++j) {
        const int n = nt * 128 + wn * 64 + j * 32 + r;
        if (n < ea.N) {
#pragma unroll
          for (int reg = 0; reg < 16; ++reg) {
            const int m = mt * 128 + wm * 64 + i * 32 + crow(reg, h);
            const float v = acc[i][j][reg];
            if (EPI == 0) {
              ((u16*)ea.C)[(long)m * ea.ldc + n] = f2bf(v);
            } else if (EPI == 1) {
              ((float*)ea.C)[(long)m * ea.ldc + n] = v;
            } else {
              const int bi = (m < TL) ? (m >> 11) : 8;
              const float g = ea.g[bi * 6144 + n];
              float* dst = (float*)ea.C + (long)m * 1024 + n;
              float base;
              if (EPI == 2) base = (m < TL) ? ea.xin_lat[(long)m * 1024 + n] : ea.xin_ctx[(long)(m - TL) * 1024 + n];
              else base = *dst;
              *dst = base + g * v;
            }
          }
        }
      }
  }
}

DI void gemm_pq_scores(char* smem, const u16* __restrict__ A, const u16* __restrict__ Wt, const u16* __restrict__ KEYS, float* __restrict__ SC, int MT) {
  constexpr int lda = 1024, acs = 0, K = 1024, NT = 16, rot = 0;
  u16* sAB = (u16*)smem;
  constexpr int STG = 2 * 128 * 72;
  const int tid = threadIdx.x, lane = tid & 63, w = tid >> 6, r = lane & 31, h = lane >> 5;
  const int wm = w >> 1, wn = w & 1;
  const int nslot = gridDim.x >> 3, xcd = blockIdx.x & 7;
  int first = ((int)(blockIdx.x >> 3) - rot) % nslot;
  if (first < 0) first += nslot;
  const int lrow = tid >> 3, lkc = tid & 7;
  const int per_xcd = (MT >> 3) * NT;
  for (int t = first; t < per_xcd; t += nslot) {
    const int mt = xcd + 8 * (t / NT), nt = t % NT;
    const u16* Ab = A + (long)(mt * 128 + lrow) * lda + nt * acs + lkc * 8;
    const u16* Bb = Wt + (long)(nt * 128 + lrow) * K + lkc * 8;
    f32x16 acc[2][2];
#pragma unroll
    for (int i = 0; i < 2; ++i)
#pragma unroll
      for (int j = 0; j < 2; ++j) acc[i][j] = zero16();
    u32x4 ra0[4], rb0[4], ra1[4], rb1[4];
    const int nk = K >> 6;
#pragma unroll
    for (int i = 0; i < 4; ++i) {
      ra0[i] = *(const u32x4*)(Ab + (long)(32 * i) * lda);
      rb0[i] = *(const u32x4*)(Bb + (long)(32 * i) * K);
    }
#pragma unroll
    for (int i = 0; i < 4; ++i) {
      ra1[i] = *(const u32x4*)(Ab + (long)(32 * i) * lda + 64);
      rb1[i] = *(const u32x4*)(Bb + (long)(32 * i) * K + 64);
    }
    __syncthreads();
#pragma unroll
    for (int i = 0; i < 4; ++i) {
      *(u32x4*)(sAB + (lrow + 32 * i) * 72 + lkc * 8) = ra0[i];
      *(u32x4*)(sAB + 128 * 72 + (lrow + 32 * i) * 72 + lkc * 8) = rb0[i];
    }
    __syncthreads();
    for (int k0 = 0; k0 < nk; k0 += 2) {
      if (k0 + 2 < nk) {
#pragma unroll
        for (int i = 0; i < 4; ++i) {
          ra0[i] = *(const u32x4*)(Ab + (long)(32 * i) * lda + (k0 + 2) * 64);
          rb0[i] = *(const u32x4*)(Bb + (long)(32 * i) * K + (k0 + 2) * 64);
        }
      }
      {
        const u16* cA = sAB;
        const u16* cB = cA + 128 * 72;
#pragma unroll
        for (int ks = 0; ks < 4; ++ks) {
          bf16x8 af[2], bfr[2];
#pragma unroll
          for (int i = 0; i < 2; ++i) {
            af[i] = *(const bf16x8*)(cA + (wm * 64 + i * 32 + r) * 72 + ks * 16 + h * 8);
            bfr[i] = *(const bf16x8*)(cB + (wn * 64 + i * 32 + r) * 72 + ks * 16 + h * 8);
          }
#pragma unroll
          for (int i = 0; i < 2; ++i)
#pragma unroll
            for (int j = 0; j < 2; ++j) acc[i][j] = MFMA(bfr[j], af[i], acc[i][j]);
        }
      }
      {
        u16* nA = sAB + STG;
#pragma unroll
        for (int i = 0; i < 4; ++i) {
          *(u32x4*)(nA + (lrow + 32 * i) * 72 + lkc * 8) = ra1[i];
          *(u32x4*)(nA + 128 * 72 + (lrow + 32 * i) * 72 + lkc * 8) = rb1[i];
        }
        __syncthreads();
      }
      if (k0 + 3 < nk) {
#pragma unroll
        for (int i = 0; i < 4; ++i) {
          ra1[i] = *(const u32x4*)(Ab + (long)(32 * i) * lda + (k0 + 3) * 64);
          rb1[i] = *(const u32x4*)(Bb + (long)(32 * i) * K + (k0 + 3) * 64);
        }
      }
      {
        const u16* cA = sAB + STG;
        const u16* cB = cA + 128 * 72;
#pragma unroll
        for (int ks = 0; ks < 4; ++ks) {
          bf16x8 af[2], bfr[2];
#pragma unroll
          for (int i = 0; i < 2; ++i) {
            af[i] = *(const bf16x8*)(cA + (wm * 64 + i * 32 + r) * 72 + ks * 16 + h * 8);
            bfr[i] = *(const bf16x8*)(cB + (wn * 64 + i * 32 + r) * 72 + ks * 16 + h * 8);
          }
#pragma unroll
          for (int i = 0; i < 2; ++i)
#pragma unroll
            for (int j = 0; j < 2; ++j) acc[i][j] = MFMA(bfr[j], af[i], acc[i][j]);
        }
      }
      if (k0 + 2 < nk) {
        u16* nA = sAB;
#pragma unroll
        for (int i = 0; i < 4; ++i) {
          *(u32x4*)(nA + (lrow + 32 * i) * 72 + lkc * 8) = ra0[i];
          *(u32x4*)(nA + 128 * 72 + (lrow + 32 * i) * 72 + lkc * 8) = rb0[i];
        }
        __syncthreads();
      }
    }
    u16* sQ = (u16*)smem;
    u16* sKy = sQ + 128 * 136;
    u32x4 kreg[8];
    {
      const u16* kp = KEYS + (long)nt * 128 * 128;
#pragma unroll
      for (int i = 0; i < 8; ++i) { const int c = tid + i * 256; kreg[i] = *(const u32x4*)(kp + (long)(c >> 4) * 128 + (c & 15) * 8); }
    }
    __syncthreads();
#pragma unroll
    for (int i = 0; i < 2; ++i)
#pragma unroll
      for (int j = 0; j < 2; ++j)
#pragma unroll
        for (int g = 0; g < 4; ++g) {
          u32x2 o = {pack2(acc[i][j][4 * g], acc[i][j][4 * g + 1]), pack2(acc[i][j][4 * g + 2], acc[i][j][4 * g + 3])};
          *(u32x2*)(sQ + (wm * 64 + i * 32 + r) * 136 + wn * 64 + j * 32 + 8 * g + 4 * h) = o;
        }
#pragma unroll
    for (int i = 0; i < 8; ++i) { const int c = tid + i * 256; *(u32x4*)(sKy + (c >> 4) * 136 + (c & 15) * 8) = kreg[i]; }
    __syncthreads();
#pragma unroll
    for (int i = 0; i < 2; ++i)
#pragma unroll
      for (int j = 0; j < 2; ++j) acc[i][j] = zero16();
#pragma unroll
    for (int ks = 0; ks < 8; ++ks) {
      bf16x8 af[2], bfr[2];
#pragma unroll
      for (int i = 0; i < 2; ++i) {
        af[i] = *(const bf16x8*)(sQ + (wm * 64 + i * 32 + r) * 136 + ks * 16 + h * 8);
        bfr[i] = *(const bf16x8*)(sKy + (wn * 64 + i * 32 + r) * 136 + ks * 16 + h * 8);
      }
#pragma unroll
      for (int i = 0; i < 2; ++i)
#pragma unroll
        for (int j = 0; j < 2; ++j) acc[i][j] = MFMA(af[i], bfr[j], acc[i][j]);
    }
#pragma unroll
    for (int i = 0; i < 2; ++i)
#pragma unroll
      for (int j = 0; j < 2; ++j) {
        const int n = nt * 128 + wn * 64 + j * 32 + r;
#pragma unroll
        for (int reg = 0; reg < 16; ++reg) {
          const int m = mt * 128 + wm * 64 + i * 32 + crow(reg, h);
          SC[(long)m * 2048 + n] = acc[i][j][reg];
        }
      }
  }
}

DI float rope64(float y, int lane, int prow, int pcol, const float* __restrict__ R16) {
  const float partner = __shfl_xor(y, 16);
  const int pos = (lane < 32) ? prow : pcol;
  const f32x2 cs = *(const f32x2*)(R16 + (pos * 16 + (lane & 15)) * 2);
  return (lane & 16) ? (y * cs.x + partner * cs.y) : (y * cs.x - partner * cs.y);
}
DI float rope32(float y, int lane, int prow, int pcol, const float* __restrict__ R8) {
  const float partner = __shfl_xor(y, 8);
  const int pp = lane & 31;
  const int pos = (pp < 16) ? prow : pcol;
  const f32x2 cs = *(const f32x2*)(R8 + (pos * 8 + (pp & 7)) * 2);
  return (pp & 8) ? (y * cs.x + partner * cs.y) : (y * cs.x - partner * cs.y);
}

template <int CTRL>
DI float dppf(float v) { return __builtin_bit_cast(float, __builtin_amdgcn_update_dpp(0, __builtin_bit_cast(int, v), CTRL, 0xf, 0xf, false)); }
DI void unpack8(u32x4 r, float* x) {
#pragma unroll
  for (int q = 0; q < 4; ++q) { x[2 * q] = bflo(r[q]); x[2 * q + 1] = bfhi(r[q]); }
}
DI u32x4 pack8f(const float* y) { u32x4 o = {pack2(y[0], y[1]), pack2(y[2], y[3]), pack2(y[4], y[5]), pack2(y[6], y[7])}; return o; }
DI float sumsq8(const float* x) { float s = 0.f;
#pragma unroll
  for (int j = 0; j < 8; ++j) s += x[j] * x[j];
  return s; }
DI float sum_group8(float v) { v += dppf<0xB1>(v); v += dppf<0x4E>(v); v += dppf<0x141>(v); return v; }
DI void rope_head64(float* y, int cc8, const float* cs) {
  const bool second = (cc8 & 2) != 0;
#pragma unroll
  for (int j = 0; j < 8; ++j) {
    const float pr = dppf<0x4E>(y[j]);
    y[j] = second ? (y[j] * cs[2 * j] + pr * cs[2 * j + 1]) : (y[j] * cs[2 * j] - pr * cs[2 * j + 1]);
  }
}
DI void load_cs8(const float* tab, float* cs) {
#pragma unroll
  for (int q = 0; q < 4; ++q) { const f32x4 t = *(const f32x4*)(tab + q * 4); cs[4 * q] = t.x; cs[4 * q + 1] = t.y; cs[4 * q + 2] = t.z; cs[4 * q + 3] = t.w; }
}
DI void load_w8(const float* wsrc, float* wv) {
  const f32x4 a = *(const f32x4*)wsrc, b = *(const f32x4*)(wsrc + 4);
  wv[0] = a.x; wv[1] = a.y; wv[2] = a.z; wv[3] = a.w; wv[4] = b.x; wv[5] = b.y; wv[6] = b.z; wv[7] = b.w;
}
DI void phase_post0a(const Params& p) {
  const int lane = threadIdx.x & 63, w = threadIdx.x >> 6, cc8 = lane & 7;
  float wq[8], wk[8], wl[8];
  load_w8(p.a_q_norm + cc8 * 8, wq);
  load_w8(p.a_k_norm + cc8 * 8, wk);
  load_w8((lane < 32 ? p.b_kv_lora_norm : p.b_q_lora_norm) + (lane & 31) * 8, wl);
  const int offB = (lane < 32) ? 512 + (lane & 15) * 8 : 768 + (lane - 32) * 8;
  const int stride = gridDim.x * 4;
  int m = blockIdx.x * 4 + w;
  u32x4 rA, rB, rC, nA, nB, nC;
  if (m < TA) {
    const u16* z0 = p.Z + (long)m * 1312;
    rA = *(const u32x4*)(z0 + lane * 8); rB = *(const u32x4*)(z0 + offB); rC = *(const u32x4*)(z0 + 1024 + (lane & 31) * 8);
  }
  for (; m < TA; m += stride) {
    u16* z = p.Z + (long)m * 1312;
    const bool lat = m < TL;
    const int s = m & 2047, prow = s >> 6, pcol = s & 63;
    if (m + stride < TA) {
      const u16* zn = p.Z + (long)(m + stride) * 1312;
      nA = *(const u32x4*)(zn + lane * 8); nB = *(const u32x4*)(zn + offB); nC = *(const u32x4*)(zn + 1024 + (lane & 31) * 8);
    }
    float cs[16];
    load_cs8(p.ROPE16 + ((((cc8 < 4) ? prow : pcol) * 16 + (cc8 & 1) * 8) * 2), cs);
    float x[8];
    {
      unpack8(rA, x);
      const float rstd = rsqrtf(sum_group8(sumsq8(x)) * (1.f / 64.f) + EPSF);
#pragma unroll
      for (int j = 0; j < 8; ++j) x[j] *= rstd * wq[j] * (0.125f * LOG2E);
      if (lat) rope_head64(x, cc8, cs);
      *(u32x4*)(z + lane * 8) = pack8f(x);
    }
    {
      unpack8(rB, x);
      const float ssq = sumsq8(x);
      const float g8 = sum_group8(ssq);
      const float r16 = rowsum16(ssq);
      const int ir = __builtin_bit_cast(int, r16);
      const float t256 = __builtin_bit_cast(float, __builtin_amdgcn_readlane(ir, 32)) + __builtin_bit_cast(float, __builtin_amdgcn_readlane(ir, 48));
      if (lane < 32) {
        const float rstd = rsqrtf(g8 * (1.f / 64.f) + EPSF);
#pragma unroll
        for (int j = 0; j < 8; ++j) x[j] *= rstd * wk[j];
      } else {
        const float rstd = rsqrtf(t256 * (1.f / 256.f) + EPSF);
#pragma unroll
        for (int j = 0; j < 8; ++j) x[j] *= rstd * wl[j];
      }
      float xr[8];
#pragma unroll
      for (int j = 0; j < 8; ++j) xr[j] = x[j];
      rope_head64(xr, cc8, cs);
      if (lat && lane < 16) {
#pragma unroll
        for (int j = 0; j < 8; ++j) x[j] = xr[j];
      }
      if (lane < 16 || lane >= 32) *(u32x4*)(z + offB) = pack8f(x);
    }
    {
      unpack8(rC, x);
      const float r16 = rowsum16(sumsq8(x));
      const int ir = __builtin_bit_cast(int, r16);
      const float t256 = __builtin_bit_cast(float, __builtin_amdgcn_readlane(ir, 0)) + __builtin_bit_cast(float, __builtin_amdgcn_readlane(ir, 16));
      const float rstd = rsqrtf(t256 * (1.f / 256.f) + EPSF);
#pragma unroll
      for (int j = 0; j < 8; ++j) x[j] *= rstd * wl[j];
      if (lane < 32) *(u32x4*)(z + 1024 + lane * 8) = pack8f(x);
    }
    rA = nA; rB = nB; rC = nC;
  }
}
DI void rope_tail96(float* y, int c16, const float* cs) {
  const bool second = (c16 & 1) != 0;
#pragma unroll
  for (int j = 0; j < 8; ++j) {
    const float pr = dppf<0xB1>(y[j]);
    const float rz = second ? (y[j] * cs[2 * j] + pr * cs[2 * j + 1]) : (y[j] * cs[2 * j] - pr * cs[2 * j + 1]);
    y[j] = (c16 >= 8) ? rz : y[j];
  }
}
DI void phase_post0b(const Params& p) {
  const int lane = threadIdx.x & 63, w = threadIdx.x >> 6, c16 = lane & 15, hr = lane >> 4;
  const bool act = c16 < 12;
  float wq[8], wk[8];
  load_w8(p.b_q_norm + (act ? c16 : 0) * 8, wq);
  load_w8(p.b_k_norm + (act ? c16 : 0) * 8, wk);
  for (int m = blockIdx.x * 4 + w; m < TA; m += gridDim.x * 4) {
    const bool lat = m < TL;
    const int s = m & 2047, prow = s >> 6, pcol = s & 63;
    u16* q = p.QB + (long)m * 768;
    const u16* kv = p.KVR + (long)m * 1024;
    u16* kb = p.KB + (long)m * 768;
    u16* vb = p.VB + (long)m * 512;
    const u16* kr = p.Z + (long)m * 1312 + 1280;
    const u32x4 zero4 = {0u, 0u, 0u, 0u};
    u32x4 rq[2], rk[2];
#pragma unroll
    for (int ps = 0; ps < 2; ++ps) {
      const int hd = ps * 4 + hr;
      rq[ps] = act ? *(const u32x4*)(q + hd * 96 + c16 * 8) : zero4;
      rk[ps] = act ? ((c16 < 8) ? *(const u32x4*)(kv + hd * 128 + c16 * 8) : *(const u32x4*)(kr + (c16 - 8) * 8)) : zero4;
    }
    const u32x4 rv = *(const u32x4*)(kv + (lane >> 3) * 128 + 64 + (lane & 7) * 8);
    float cs[16];
    load_cs8(p.ROPE8 + ((((c16 < 10) ? prow : pcol) * 8) * 2), cs);
    float x[8];
#pragma unroll
    for (int ps = 0; ps < 2; ++ps) {
      const int hd = ps * 4 + hr;
      unpack8(rq[ps], x);
      float rstd = rsqrtf(rowsum16(sumsq8(x)) * (1.f / 96.f) + EPSF);
#pragma unroll
      for (int j = 0; j < 8; ++j) x[j] *= rstd * wq[j] * (0.10206207261596575f * LOG2E);
      if (lat) rope_tail96(x, c16, cs);
      if (act) *(u32x4*)(q + hd * 96 + c16 * 8) = pack8f(x);
      unpack8(rk[ps], x);
      rstd = rsqrtf(rowsum16(sumsq8(x)) * (1.f / 96.f) + EPSF);
#pragma unroll
      for (int j = 0; j < 8; ++j) x[j] *= rstd * wk[j];
      if (lat) rope_tail96(x, c16, cs);
      if (act) *(u32x4*)(kb + hd * 96 + c16 * 8) = pack8f(x);
    }
    *(u32x4*)(vb + lane * 8) = rv;
  }
}
DI void phase_post1(const Params& p) {
  const int lane = threadIdx.x & 63, w = threadIdx.x >> 6, cc8 = lane & 7;
  float wq[8], wk[8];
  load_w8(p.d_q_norm + cc8 * 8, wq);
  load_w8(p.d_k_norm + cc8 * 8, wk);
  const int stride = gridDim.x * 4;
  int m = blockIdx.x * 4 + w;
  u32x4 rA, rB, rC, nA, nB, nC;
  if (m < TA) {
    const u16* z0 = p.Z + (long)m * 2304;
    rA = *(const u32x4*)(z0 + lane * 8); rB = *(const u32x4*)(z0 + 1536 + lane * 8); rC = *(const u32x4*)(z0 + 2048 + (lane & 15) * 8);
  }
  for (; m < TA; m += stride) {
    u16* z = p.Z + (long)m * 2304;
    const bool lat = m < TL;
    const int s = m & 2047, prow = s >> 6, pcol = s & 63;
    if (m + stride < TA) {
      const u16* zn = p.Z + (long)(m + stride) * 2304;
      nA = *(const u32x4*)(zn + lane * 8); nB = *(const u32x4*)(zn + 1536 + lane * 8); nC = *(const u32x4*)(zn + 2048 + (lane & 15) * 8);
    }
    float cs[16];
    load_cs8(p.ROPE16 + ((((cc8 < 4) ? prow : pcol) * 16 + (cc8 & 1) * 8) * 2), cs);
    float x[8];
    {
      unpack8(rA, x);
      const float sc = (lane >= 32) ? 0.125f : 1.f;
#pragma unroll
      for (int j = 0; j < 8; ++j) x[j] *= sc;
      if (lat) rope_head64(x, cc8, cs);
      if (lat || lane >= 32) *(u32x4*)(z + lane * 8) = pack8f(x);
    }
    {
      unpack8(rB, x);
      const float rstd = rsqrtf(sum_group8(sumsq8(x)) * (1.f / 64.f) + EPSF);
#pragma unroll
      for (int j = 0; j < 8; ++j) x[j] *= rstd * wq[j] * (0.125f * LOG2E);
      if (lat) rope_head64(x, cc8, cs);
      *(u32x4*)(z + 1536 + lane * 8) = pack8f(x);
    }
    {
      unpack8(rC, x);
      const float rstd = rsqrtf(sum_group8(sumsq8(x)) * (1.f / 64.f) + EPSF);
#pragma unroll
      for (int j = 0; j < 8; ++j) x[j] *= rstd * wk[j];
      if (lat) rope_head64(x, cc8, cs);
      if (lane < 16) *(u32x4*)(z + 2048 + lane * 8) = pack8f(x);
    }
    rA = nA; rB = nB; rC = nC;
  }
}

template <int DQK>
DI void attn_item(char* smem, const u16* __restrict__ Qp, int qs, const u16* __restrict__ K0, const u16* __restrict__ V0,
                  int ks0, int vs0, int n0, const u16* __restrict__ K1, const u16* __restrict__ V1, int ks1, int vs1, int kbeg,
                  int kend, bool band, int qpos0, float scale, bool has_sink, float sink, u16* __restrict__ Op, int os) {
  constexpr int KSTR = DQK + 8, VROW = 96, KCH = DQK / 8, NKL = (64 * KCH) / 256;
  constexpr int NKS = DQK / 16;
  u16* sK = (u16*)smem;
  u16* sV = sK + 64 * KSTR;
  const int tid = threadIdx.x, lane = tid & 63, w = tid >> 6, r = lane & 31, h = lane >> 5;
  bf16x8 qf[NKS];
#pragma unroll
  for (int ks = 0; ks < NKS; ++ks) qf[ks] = *(const bf16x8*)(Qp + (long)(w * 32 + r) * qs + ks * 16 + h * 8);
  f32x16 oT[2];
  oT[0] = zero16(); oT[1] = zero16();
  (void)scale;
  float mrun = has_sink ? sink * LOG2E : -1e30f;
  float lrun = (has_sink && h == 0) ? 1.f : 0.f;
  const int nt0 = n0 >> 6, nt1 = (kend - kbeg) >> 6, ntot = nt0 + nt1;
  const int qpos = qpos0 + w * 32 + r;
  u32x4 rk[NKL], rv[2];
  auto tile_ptrs = [&](int t, const u16*& kp, const u16*& vp, int& kst, int& vst) {
    if (t < nt0) { kp = K0 + (long)(t * 64) * ks0; vp = V0 + (long)(t * 64) * vs0; kst = ks0; vst = vs0; }
    else { const int k0 = kbeg + (t - nt0) * 64; kp = K1 + (long)k0 * ks1; vp = V1 + (long)k0 * vs1; kst = ks1; vst = vs1; }
  };
  {
    const u16 *kp, *vp; int kst, vst;
    tile_ptrs(0, kp, vp, kst, vst);
#pragma unroll
    for (int i = 0; i < NKL; ++i) { const int c = tid + i * 256, key = c / KCH, kc = c % KCH; rk[i] = *(const u32x4*)(kp + (long)key * kst + kc * 8); }
#pragma unroll
    for (int i = 0; i < 2; ++i) { const int c = tid + i * 256, key = c >> 3, dc = c & 7; rv[i] = *(const u32x4*)(vp + (long)key * vst + dc * 8); }
  }
  for (int t = 0; t < ntot; ++t) {
    __syncthreads();
#pragma unroll
    for (int i = 0; i < NKL; ++i) { const int c = tid + i * 256, key = c / KCH, kc = c % KCH; *(u32x4*)(sK + key * KSTR + kc * 8) = rk[i]; }
#pragma unroll
    for (int i = 0; i < 2; ++i) { const int c = tid + i * 256, key = c >> 3, dc = c & 7; *(u32x4*)(sV + key * VROW + dc * 8) = rv[i]; }
    __syncthreads();
    if (t + 1 < ntot) {
      const u16 *kp, *vp; int kst, vst;
      tile_ptrs(t + 1, kp, vp, kst, vst);
#pragma unroll
      for (int i = 0; i < NKL; ++i) { const int c = tid + i * 256, key = c / KCH, kc = c % KCH; rk[i] = *(const u32x4*)(kp + (long)key * kst + kc * 8); }
#pragma unroll
      for (int i = 0; i < 2; ++i) { const int c = tid + i * 256, key = c >> 3, dc = c & 7; rv[i] = *(const u32x4*)(vp + (long)key * vst + dc * 8); }
    }
    f32x16 sT[2];
    sT[0] = zero16(); sT[1] = zero16();
#pragma unroll
    for (int kt = 0; kt < 2; ++kt)
#pragma unroll
      for (int ks = 0; ks < NKS; ++ks) {
        const bf16x8 kf = *(const bf16x8*)(sK + (kt * 32 + r) * KSTR + ks * 16 + h * 8);
        sT[kt] = MFMA(kf, qf[ks], sT[kt]);
      }
    const bool masked = band && (t >= nt0);
    const int kbase = kbeg + (t - nt0) * 64;
    float mx = -1e30f;
#pragma unroll
    for (int kt = 0; kt < 2; ++kt)
#pragma unroll
      for (int reg = 0; reg < 16; ++reg) {
        float sv = sT[kt][reg];
        if (masked) {
          const int kpos = kbase + kt * 32 + crow(reg, h);
          const int d = qpos - kpos;
          if (d > 128 || d < -128) sv = -1e30f;
        }
        sT[kt][reg] = sv;
        mx = fmaxf(mx, sv);
      }
    mx = fmaxf(mx, __shfl_xor(mx, 32));
    const float mnew = fmaxf(mrun, mx);
    const float alpha = ex2(mrun - mnew);
    mrun = mnew;
    float ps = 0.f;
#pragma unroll
    for (int kt = 0; kt < 2; ++kt)
#pragma unroll
      for (int reg = 0; reg < 16; ++reg) {
        const float pv = ex2(sT[kt][reg] - mnew);
        sT[kt][reg] = pv;
        ps += pv;
      }
    lrun = lrun * alpha + ps;
#pragma unroll
    for (int dt = 0; dt < 2; ++dt)
#pragma unroll
      for (int reg = 0; reg < 16; ++reg) oT[dt][reg] *= alpha;
#pragma unroll
    for (int kt = 0; kt < 2; ++kt)
#pragma unroll
      for (int s = 0; s < 2; ++s) {
        const bf16x8 pf = pack8(sT[kt], s);
#pragma unroll
        for (int dt = 0; dt < 2; ++dt) {
          const u16* vb0 = sV + (kt * 32 + s * 16 + 4 * h + ((lane & 15) >> 2)) * VROW + dt * 32 + ((lane >> 4) & 1) * 16 + (lane & 3) * 4;
          const s16x4 lo4 = __builtin_amdgcn_ds_read_tr16_b64_v4i16((LDS3 s16x4*)vb0);
          const s16x4 hi4 = __builtin_amdgcn_ds_read_tr16_b64_v4i16((LDS3 s16x4*)(vb0 + 8 * VROW));
          const bf16x8 vf = __builtin_shufflevector(lo4, hi4, 0, 1, 2, 3, 4, 5, 6, 7);
          oT[dt] = MFMA(vf, pf, oT[dt]);
        }
      }
  }
  const float ltot = lrun + __shfl_xor(lrun, 32);
  const float inv = 1.f / ltot;
#pragma unroll
  for (int dt = 0; dt < 2; ++dt)
#pragma unroll
    for (int g = 0; g < 4; ++g) {
      u32x2 o = {pack2(oT[dt][4 * g] * inv, oT[dt][4 * g + 1] * inv), pack2(oT[dt][4 * g + 2] * inv, oT[dt][4 * g + 3] * inv)};
      *(u32x2*)(Op + (long)(w * 32 + r) * os + dt * 32 + 8 * g + 4 * h) = o;
    }
}

DI void phase_attn0(const Params& p, char* smem) {
  const float sc96 = 0.10206207261596575f;
  for (int id = blockIdx.x; id < 2304; id += gridDim.x) {
    if (id < 1024) {
      const int b = id >> 7, hd = (id >> 4) & 7, qb = id & 15;
      const long qrow = (long)b * 2048 + qb * 128, crw = (long)TL + b * 256, lrow = (long)b * 2048;
      attn_item<96>(smem, p.QB + qrow * 768 + hd * 96, 768, p.KB + crw * 768 + hd * 96, p.VB + crw * 512 + hd * 64, 768, 512, 256,
                    p.KB + lrow * 768 + hd * 96, p.VB + lrow * 512 + hd * 64, 768, 512, 0, 2048, false, 0, sc96, false, 0.f,
                    p.AO + qrow * 1024 + 512 + hd * 64, 1024);
    } else if (id < 2048) {
      const int i2 = id - 1024;
      const int b = i2 >> 7, hd = (i2 >> 4) & 7, qb = i2 & 15, kvh = hd >> 2;
      const long qrow = (long)b * 2048 + qb * 128, crw = (long)TL + b * 256, lrow = (long)b * 2048;
      const int kbeg = (qb * 128 - 128) < 0 ? 0 : (qb * 128 - 128);
      const int kend = (qb * 128 + 256) > 2048 ? 2048 : (qb * 128 + 256);
      attn_item<64>(smem, p.Z + qrow * 1312 + hd * 64, 1312, p.Z + crw * 1312 + 512 + kvh * 64, p.Z + crw * 1312 + 640 + kvh * 64, 1312,
                    1312, 256, p.Z + lrow * 1312 + 512 + kvh * 64, p.Z + lrow * 1312 + 640 + kvh * 64, 1312, 1312, kbeg, kend, true,
                    qb * 128, 0.125f, true, p.a_sink[hd], p.AO + qrow * 1024 + hd * 64, 1024);
    } else if (id < 2176) {
      const int i2 = id - 2048;
      const int b = i2 >> 4, hd = (i2 >> 1) & 7, qb = i2 & 1, kvh = hd >> 2;
      const long qrow = (long)TL + b * 256 + qb * 128, crw = (long)TL + b * 256;
      attn_item<64>(smem, p.Z + qrow * 1312 + hd * 64, 1312, p.Z + crw * 1312 + 512 + kvh * 64, p.Z + crw * 1312 + 640 + kvh * 64, 1312,
                    1312, 256, p.Z, p.Z, 1312, 1312, 0, 0, false, 0, 0.125f, true, p.a_sink[hd], p.AO + qrow * 1024 + hd * 64, 1024);
    } else {
      const int i2 = id - 2176;
      const int b = i2 >> 4, hd = (i2 >> 1) & 7, qb = i2 & 1;
      const long qrow = (long)TL + b * 256 + qb * 128, crw = (long)TL + b * 256;
      attn_item<96>(smem, p.QB + qrow * 768 + hd * 96, 768, p.KB + crw * 768 + hd * 96, p.VB + crw * 512 + hd * 64, 768, 512, 256,
                    p.KB, p.VB, 768, 512, 0, 0, false, 0, sc96, false, 0.f, p.AO + qrow * 1024 + 512 + hd * 64, 1024);
    }
  }
}

DI long ret_row(int b, int dir, int c, int pp) {
  const int q = (c < 2) ? c * 128 + pp : (c - 2) * 128 + pp;
  if (c < 2) return (long)TL + b * 256 + (dir ? 255 - q : q);
  return (long)b * 2048 + (dir ? 2047 - q : q);
}
DI void ret_local_item(const Params& p, char* smem, int id) {
  const int c = id % 18, dir = (id / 18) & 1, hh = (id / 36) & 3, b = id / 144;
  u16* sK = (u16*)smem;
  u16* sV = sK + 128 * 64;
  float* sW = (float*)(sV + 128 * 128);
  const int tid = threadIdx.x;
  const float lg = log_sigmoid((dir ? p.c_decay_bwd : p.c_decay_fwd)[hh]);
  __syncthreads();
  for (int i = tid; i < 128 * 8; i += 256) {
    const int pp = i >> 3, ch = i & 7;
    const long row = ret_row(b, dir, c, pp);
    *(u32x4*)(sK + pp * 64 + ch * 8) = *(const u32x4*)(p.Z + row * 2304 + 256 + hh * 64 + ch * 8);
  }
  for (int i = tid; i < 128 * 16; i += 256) {
    const int pp = i >> 4, ch = i & 15;
    const long row = ret_row(b, dir, c, pp);
    *(u32x4*)(sV + pp * 128 + ch * 8) = *(const u32x4*)(p.Z + row * 2304 + 512 + hh * 128 + ch * 8);
  }
  if (tid < 128) sW[tid] = __expf(lg * (float)(127 - tid));
  __syncthreads();
  const int d = tid >> 2, vq = tid & 3;
  float acc[32];
#pragma unroll
  for (int j = 0; j < 32; ++j) acc[j] = 0.f;
  for (int pp = 0; pp < 128; ++pp) {
    const float kv = bf2f(sK[pp * 64 + d]) * sW[pp];
#pragma unroll
    for (int q = 0; q < 4; ++q) {
      const u32x4 vv = *(const u32x4*)(sV + pp * 128 + vq * 32 + q * 8);
      acc[q * 8 + 0] += kv * bflo(vv.x); acc[q * 8 + 1] += kv * bfhi(vv.x);
      acc[q * 8 + 2] += kv * bflo(vv.y); acc[q * 8 + 3] += kv * bfhi(vv.y);
      acc[q * 8 + 4] += kv * bflo(vv.z); acc[q * 8 + 5] += kv * bfhi(vv.z);
      acc[q * 8 + 6] += kv * bflo(vv.w); acc[q * 8 + 7] += kv * bfhi(vv.w);
    }
  }
  u16* dst = (u16*)p.LST + (long)id * 8192 + d * 128 + vq * 32;
#pragma unroll
  for (int q = 0; q < 4; ++q) *(u32x4*)(dst + q * 8) = pack8f(acc + q * 8);
}

DI void phase_attn1(const Params& p, char* smem) {
  for (int id = blockIdx.x; id < 1024 + 1152; id += gridDim.x) {
    if (id < 1024) {
      const int b = id >> 7, hd = (id >> 4) & 7, qb = id & 15, kvh = hd >> 2;
      const long qrow = (long)b * 2048 + qb * 128, crw = (long)TL + b * 256, lrow = (long)b * 2048;
      attn_item<64>(smem, p.Z + qrow * 2304 + 1536 + hd * 64, 2304, p.Z + crw * 2304 + 2048 + kvh * 64, p.Z + crw * 2304 + 2176 + kvh * 64,
                    2304, 2304, 256, p.Z + lrow * 2304 + 2048 + kvh * 64, p.Z + lrow * 2304 + 2176 + kvh * 64, 2304, 2304, 0, 2048, false, 0,
                    0.125f, false, 0.f, p.AO + qrow * 1024 + 512 + hd * 64, 1024);
    } else {
      ret_local_item(p, smem, id - 1024);
    }
  }
}

DI void ret_out_item(const Params& p, char* smem, int id) {
  const int c = id & 15, hh = (id >> 4) & 3, b = id >> 6;
  const int tid = threadIdx.x, lane = tid & 63, w = tid >> 6, r = lane & 31, h = lane >> 5;
  const float lgf = log_sigmoid(p.c_decay_fwd[hh]), lgb = log_sigmoid(p.c_decay_bwd[hh]);
  u16* sS = (u16*)smem;
  __syncthreads();
  {
    const int d = tid >> 2, vq = tid & 3;
#pragma unroll 1
    for (int dir = 0; dir < 2; ++dir) {
      const int cc = dir ? (17 - c) : (c + 2);
      const float lgG = (dir ? lgb : lgf) * 128.f;
      float acc[32];
#pragma unroll
      for (int j = 0; j < 32; ++j) acc[j] = 0.f;
#pragma unroll 8
      for (int c2 = 0; c2 < cc; ++c2) {
        const float coef = __expf(lgG * (float)(cc - 1 - c2));
        const u16* src = (const u16*)p.LST + ((long)(((b * 4 + hh) * 2 + dir) * 18 + c2)) * 8192 + d * 128 + vq * 32;
#pragma unroll
        for (int q = 0; q < 4; ++q) {
          const u32x4 v = *(const u32x4*)(src + q * 8);
          acc[q * 8] += coef * bflo(v.x); acc[q * 8 + 1] += coef * bfhi(v.x); acc[q * 8 + 2] += coef * bflo(v.y); acc[q * 8 + 3] += coef * bfhi(v.y);
          acc[q * 8 + 4] += coef * bflo(v.z); acc[q * 8 + 5] += coef * bfhi(v.z); acc[q * 8 + 6] += coef * bflo(v.w); acc[q * 8 + 7] += coef * bfhi(v.w);
        }
      }
#pragma unroll
      for (int j = 0; j < 32; ++j) sS[dir * 128 * 72 + (vq * 32 + j) * 72 + d] = f2bf(acc[j]);
    }
  }
  __syncthreads();
  const long qrow = (long)b * 2048 + c * 128 + w * 32 + r;
  const int qi = w * 32 + r;
  u32x4 qraw[4];
#pragma unroll
  for (int ks = 0; ks < 4; ++ks) qraw[ks] = *(const u32x4*)(p.Z + qrow * 2304 + hh * 64 + ks * 16 + h * 8);
  f32x16 oT[4];
#pragma unroll
  for (int vt = 0; vt < 4; ++vt) oT[vt] = zero16();
#pragma unroll 1
  for (int dir = 0; dir < 2; ++dir) {
    const float qd = dir ? __expf(lgb * (float)(128 - qi)) : __expf(lgf * (float)(qi + 1));
#pragma unroll
    for (int ks = 0; ks < 4; ++ks) {
      u32x4 sq;
      sq.x = pack2(bflo(qraw[ks].x) * qd, bfhi(qraw[ks].x) * qd);
      sq.y = pack2(bflo(qraw[ks].y) * qd, bfhi(qraw[ks].y) * qd);
      sq.z = pack2(bflo(qraw[ks].z) * qd, bfhi(qraw[ks].z) * qd);
      sq.w = pack2(bflo(qraw[ks].w) * qd, bfhi(qraw[ks].w) * qd);
      const bf16x8 qs8 = as_bf16x8(sq);
#pragma unroll
      for (int vt = 0; vt < 4; ++vt) {
        const bf16x8 sf = *(const bf16x8*)(sS + dir * 128 * 72 + (vt * 32 + r) * 72 + ks * 16 + h * 8);
        oT[vt] = MFMA(sf, qs8, oT[vt]);
      }
    }
  }
  __syncthreads();
  u16* sK = (u16*)smem;
  u16* sVt = sK + 128 * 72;
  const long crow0 = (long)b * 2048 + c * 128;
  for (int i = tid; i < 128 * 8; i += 256) {
    const int j = i >> 3, ch = i & 7;
    *(u32x4*)(sK + j * 72 + ch * 8) = *(const u32x4*)(p.Z + (crow0 + j) * 2304 + 256 + hh * 64 + ch * 8);
  }
  for (int i = tid; i < 128 * 16; i += 256) {
    const int j = i & 127, ch = i >> 7;
    const u32x4 vv = *(const u32x4*)(p.Z + (crow0 + j) * 2304 + 512 + hh * 128 + ch * 8);
    const unsigned ve[4] = {vv.x, vv.y, vv.z, vv.w};
#pragma unroll
    for (int q = 0; q < 4; ++q) {
      sVt[(ch * 8 + 2 * q) * 132 + j] = (u16)(ve[q] & 0xffffu);
      sVt[(ch * 8 + 2 * q + 1) * 132 + j] = (u16)(ve[q] >> 16);
    }
  }
  __syncthreads();
  const float l2f = lgf * LOG2E, l2b = lgb * LOG2E;
#pragma unroll 1
  for (int jt = 0; jt < 4; ++jt) {
    f32x16 sT = zero16();
#pragma unroll
    for (int ks = 0; ks < 4; ++ks) {
      const bf16x8 kf = *(const bf16x8*)(sK + (jt * 32 + r) * 72 + ks * 16 + h * 8);
      sT = MFMA(kf, as_bf16x8(qraw[ks]), sT);
    }
#pragma unroll
    for (int reg = 0; reg < 16; ++reg) {
      const int j = jt * 32 + crow(reg, h);
      const int df = qi - j;
      const float dec = (df > 0) ? ex2(l2f * (float)df) : ((df < 0) ? ex2(l2b * (float)(-df)) : 2.f);
      sT[reg] *= dec;
    }
#pragma unroll
    for (int s = 0; s < 2; ++s) {
      const bf16x8 pf = pack8(sT, s);
#pragma unroll
      for (int vt = 0; vt < 4; ++vt) {
        const u16* vr = sVt + (vt * 32 + r) * 132 + jt * 32 + s * 16 + h * 4;
        const bf16x8 vf = join8(*(const u32x2*)vr, *(const u32x2*)(vr + 8));
        oT[vt] = MFMA(vf, pf, oT[vt]);
      }
    }
  }
  float sm = 0.f;
#pragma unroll
  for (int vt = 0; vt < 4; ++vt)
#pragma unroll
    for (int reg = 0; reg < 16; ++reg) sm += oT[vt][reg];
  sm += __shfl_xor(sm, 32);
  const float mu = sm * (1.f / 128.f);
  float sv = 0.f;
#pragma unroll
  for (int vt = 0; vt < 4; ++vt)
#pragma unroll
    for (int reg = 0; reg < 16; ++reg) { const float dd = oT[vt][reg] - mu; sv += dd * dd; }
  sv += __shfl_xor(sv, 32);
  const float rstd = rsqrtf(sv * (1.f / 128.f) + EPSF);
#pragma unroll
  for (int vt = 0; vt < 4; ++vt) {
    __builtin_amdgcn_sched_barrier(0);
#pragma unroll
    for (int g = 0; g < 4; ++g) {
      const int v0 = vt * 32 + 8 * g + 4 * h;
      const u32x2 graw = *(const u32x2*)(p.Z + qrow * 2304 + 1024 + hh * 128 + v0);
      const f32x4 gw = *(const f32x4*)(p.c_gn_w + hh * 128 + v0);
      const float y0 = silu(bflo(graw.x)) * (oT[vt][4 * g] - mu) * rstd * gw.x;
      const float y1 = silu(bfhi(graw.x)) * (oT[vt][4 * g + 1] - mu) * rstd * gw.y;
      const float y2 = silu(bflo(graw.y)) * (oT[vt][4 * g + 2] - mu) * rstd * gw.z;
      const float y3 = silu(bfhi(graw.y)) * (oT[vt][4 * g + 3] - mu) * rstd * gw.w;
      u32x2 o = {pack2(y0, y1), pack2(y2, y3)};
      *(u32x2*)(p.AO + qrow * 1024 + hh * 128 + v0) = o;
    }
  }
}

DI unsigned fkey(float f) {
  const unsigned u = __float_as_uint(f);
  return u ^ ((unsigned)((int)u >> 31) | 0x80000000u);
}
DI unsigned wmax_u32_fast(unsigned v) {
  unsigned t;
  t = (unsigned)__builtin_amdgcn_update_dpp(0, (int)v, 0x128, 0xf, 0xf, false); v = v > t ? v : t;
  t = (unsigned)__builtin_amdgcn_update_dpp(0, (int)v, 0x124, 0xf, 0xf, false); v = v > t ? v : t;
  t = (unsigned)__builtin_amdgcn_update_dpp(0, (int)v, 0x122, 0xf, 0xf, false); v = v > t ? v : t;
  t = (unsigned)__builtin_amdgcn_update_dpp(0, (int)v, 0x121, 0xf, 0xf, false); v = v > t ? v : t;
  const unsigned a = (unsigned)__builtin_amdgcn_readlane((int)v, 0), b = (unsigned)__builtin_amdgcn_readlane((int)v, 16);
  const unsigned c = (unsigned)__builtin_amdgcn_readlane((int)v, 32), d = (unsigned)__builtin_amdgcn_readlane((int)v, 48);
  const unsigned ab = a > b ? a : b, cd = c > d ? c : d;
  return ab > cd ? ab : cd;
}
DI float fkey_inv(unsigned k) { return __uint_as_float((k & 0x80000000u) ? (k ^ 0x80000000u) : ~k); }
DI int lane_rank(unsigned long long m) {
  return __builtin_amdgcn_mbcnt_hi((unsigned)(m >> 32), __builtin_amdgcn_mbcnt_lo((unsigned)m, 0u));
}
template <int G>
DI void topk_group(const float (&vin)[G][4], float* wbase, int* oidx, float* ogate) {
  const int lane = threadIdx.x & 63;
  {
    unsigned k[G][4];
    float v[G][4];
#pragma unroll
    for (int g = 0; g < G; ++g) {
#pragma unroll
      for (int q = 0; q < 4; ++q) { v[g][q] = vin[g][q]; k[g][q] = fkey(v[g][q]); }
    }
    unsigned T[G][2], Mk[G][2];
    int n[G][2];
#pragma unroll
    for (int g = 0; g < G; ++g)
#pragma unroll
      for (int part = 0; part < 2; ++part) {
        const unsigned ka = k[g][2 * part], kb = k[g][2 * part + 1];
        const unsigned M = wmax_u32_fast(ka > kb ? ka : kb);
        Mk[g][part] = M;
        unsigned P = M >> 23;
        unsigned Tc; int c;
        for (;;) {
          Tc = P << 23;
          c = __popcll(__ballot(ka >= Tc)) + __popcll(__ballot(kb >= Tc));
          if (c >= 16 || P == 0u) break;
          --P;
        }
        T[g][part] = Tc; n[g][part] = c;
      }
#pragma unroll 1
    for (int bit = 22; bit >= 0; --bit) {
      bool done = true;
#pragma unroll
      for (int g = 0; g < G; ++g) done = done && (n[g][0] == 16) && (n[g][1] == 16);
      if (done) break;
      const unsigned bm = 1u << bit;
#pragma unroll
      for (int g = 0; g < G; ++g) {
        const unsigned t0 = T[g][0] | bm, t1 = T[g][1] | bm;
        const int c0 = __popcll(__ballot(k[g][0] >= t0)) + __popcll(__ballot(k[g][1] >= t0));
        const int c1 = __popcll(__ballot(k[g][2] >= t1)) + __popcll(__ballot(k[g][3] >= t1));
        if (c0 >= 16) { T[g][0] = t0; n[g][0] = c0; }
        if (c1 >= 16) { T[g][1] = t1; n[g][1] = c1; }
      }
    }
    unsigned ck[G][4];
    float cv[G][4];
#pragma unroll
    for (int g = 0; g < G; ++g) {
      float* sv = wbase + g * 128;
      int* si = (int*)(sv + 32);
#pragma unroll
      for (int part = 0; part < 2; ++part) {
        const unsigned Tp = T[g][part];
        const unsigned long long m0 = __ballot(k[g][2 * part] >= Tp), m1 = __ballot(k[g][2 * part + 1] >= Tp);
        const int r0 = lane_rank(m0), r1 = __popcll(m0) + lane_rank(m1);
        if (k[g][2 * part] >= Tp && r0 < 16) { sv[part * 16 + r0] = v[g][2 * part]; si[part * 16 + r0] = lane; }
        if (k[g][2 * part + 1] >= Tp && r1 < 16) { sv[part * 16 + r1] = v[g][2 * part + 1]; si[part * 16 + r1] = 64 + lane; }
      }
    }
#pragma unroll
    for (int g = 0; g < G; ++g) {
      const float* sv = wbase + g * 128;
      const float a = sv[lane >> 2];
#pragma unroll
      for (int q = 0; q < 4; ++q) { cv[g][q] = a + sv[16 + (lane & 3) * 4 + q]; ck[g][q] = fkey(cv[g][q]); }
    }
    unsigned T2[G];
    int n2[G];
#pragma unroll
    for (int g = 0; g < G; ++g) {
      const unsigned M = fkey(fkey_inv(Mk[g][0]) + fkey_inv(Mk[g][1]));
      unsigned P = M >> 23;
      unsigned Tc; int c;
      for (;;) {
        Tc = P << 23;
        c = __popcll(__ballot(ck[g][0] >= Tc)) + __popcll(__ballot(ck[g][1] >= Tc)) + __popcll(__ballot(ck[g][2] >= Tc)) + __popcll(__ballot(ck[g][3] >= Tc));
        if (c >= 16 || P == 0u) break;
        --P;
      }
      T2[g] = Tc; n2[g] = c;
    }
#pragma unroll 1
    for (int bit = 22; bit >= 0; --bit) {
      bool done = true;
#pragma unroll
      for (int g = 0; g < G; ++g) done = done && (n2[g] == 16);
      if (done) break;
      const unsigned bm = 1u << bit;
#pragma unroll
      for (int g = 0; g < G; ++g) {
        const unsigned t2 = T2[g] | bm;
        const int c = __popcll(__ballot(ck[g][0] >= t2)) + __popcll(__ballot(ck[g][1] >= t2)) + __popcll(__ballot(ck[g][2] >= t2)) + __popcll(__ballot(ck[g][3] >= t2));
        if (c >= 16) { T2[g] = t2; n2[g] = c; }
      }
    }
#pragma unroll
    for (int g = 0; g < G; ++g) {
      float* sv = wbase + g * 128;
      float* s2v = sv + 64;
      int* s2c = (int*)(sv + 80);
      int base = 0;
#pragma unroll
      for (int q = 0; q < 4; ++q) {
        const unsigned long long m = __ballot(ck[g][q] >= T2[g]);
        const int r = base + lane_rank(m);
        if (ck[g][q] >= T2[g] && r < 16) { s2v[r] = cv[g][q]; s2c[r] = lane * 4 + q; }
        base += __popcll(m);
      }
    }
    {
      const int g = (lane >> 4) % G, kk = lane & 15;
      const float* sv = wbase + g * 128;
      const int* si = (const int*)(sv + 32);
      const float* s2v = sv + 64;
      const int* s2c = (const int*)(sv + 80);
      const float val = s2v[kk];
      const float mx = rowmax16(val);
      const float ev = __expf(val - mx);
      const float ssum = rowsum16(ev);
      if (lane < 16 * G) {
        const int bc = s2c[kk];
        const int i0 = si[bc >> 4], i1 = si[16 + (bc & 15)];
        oidx[g * 16 + kk] = i0 * 128 + i1;
        ogate[g * 16 + kk] = ev / ssum;
      }
    }
  }
}
DI float dot16(const f32x2* hp, u32x4 u) {
  f32x2 d0 = {0.f, 0.f}, d1 = {0.f, 0.f};
#pragma unroll
  for (int q = 0; q < 4; ++q) {
    const int wq = (int)u[q];
    const f32x2 lo = __builtin_amdgcn_cvt_pk_f32_fp8(wq, false), hi = __builtin_amdgcn_cvt_pk_f32_fp8(wq, true);
    d0 = __builtin_elementwise_fma(hp[2 * q], lo, d0);
    d1 = __builtin_elementwise_fma(hp[2 * q + 1], hi, d1);
  }
  const f32x2 d = d0 + d1;
  return d.x + d.y;
}
DI float dot16_fp4(const f32x2* hp, u32x2 u) {
  f32x2 d0 = {0.f, 0.f}, d1 = {0.f, 0.f};
#pragma unroll
  for (int d = 0; d < 2; ++d) {
    const unsigned wq = u[d];
    d0 = __builtin_elementwise_fma(hp[4 * d], __builtin_amdgcn_cvt_scalef32_pk_f32_fp4(wq, 1.0f, 0), d0);
    d1 = __builtin_elementwise_fma(hp[4 * d + 1], __builtin_amdgcn_cvt_scalef32_pk_f32_fp4(wq, 1.0f, 1), d1);
    d0 = __builtin_elementwise_fma(hp[4 * d + 2], __builtin_amdgcn_cvt_scalef32_pk_f32_fp4(wq, 1.0f, 2), d0);
    d1 = __builtin_elementwise_fma(hp[4 * d + 3], __builtin_amdgcn_cvt_scalef32_pk_f32_fp4(wq, 1.0f, 3), d1);
  }
  const f32x2 dd = d0 + d1;
  return dd.x + dd.y;
}
DI void axpy16_fp4(f32x2* acc, float wgt, u32x2 v) {
  const f32x2 w2 = {wgt, wgt};
#pragma unroll
  for (int d = 0; d < 2; ++d) {
    const unsigned wq = v[d];
    acc[4 * d] = __builtin_elementwise_fma(w2, __builtin_amdgcn_cvt_scalef32_pk_f32_fp4(wq, 1.0f, 0), acc[4 * d]);
    acc[4 * d + 1] = __builtin_elementwise_fma(w2, __builtin_amdgcn_cvt_scalef32_pk_f32_fp4(wq, 1.0f, 1), acc[4 * d + 1]);
    acc[4 * d + 2] = __builtin_elementwise_fma(w2, __builtin_amdgcn_cvt_scalef32_pk_f32_fp4(wq, 1.0f, 2), acc[4 * d + 2]);
    acc[4 * d + 3] = __builtin_elementwise_fma(w2, __builtin_amdgcn_cvt_scalef32_pk_f32_fp4(wq, 1.0f, 3), acc[4 * d + 3]);
  }
}
DI void phase_peer(const Params& p, int layer, int ntok, float* dstbase, char* smem) {
  const int lane = threadIdx.x & 63;
  const int w = __builtin_amdgcn_readfirstlane(threadIdx.x >> 6);
  const unsigned char* U = p.U8 + (long)layer * 16384 * 512;
  const unsigned char* V = p.V8 + (long)layer * 16384 * 512;
  const float* SU = p.SCU + layer * 16384;
  const float* SV = p.SCV + layer * 16384;
  const float* modl = p.MOD + (long)layer * 9 * 6144;
  float* wtk = (float*)smem + w * 768;
  int* eidx_s = (int*)(wtk + 512);
  float* gate_s = wtk + 640;
  for (int t = blockIdx.x * 4 + w; t < ntok; t += gridDim.x * 4) {
    f32x2 hp[8];
    {
      const u32x4 ha = *(const u32x4*)(p.HB + (long)t * 1024 + lane * 16);
      const u32x4 hb = *(const u32x4*)(p.HB + (long)t * 1024 + lane * 16 + 8);
#pragma unroll
      for (int q = 0; q < 4; ++q) { hp[q].x = bflo(ha[q]); hp[q].y = bfhi(ha[q]); hp[4 + q].x = bflo(hb[q]); hp[4 + q].y = bfhi(hb[q]); }
    }
    {
      float sva[4][4], svb[4][4];
      const float* scp = p.SC + (long)t * 2048 + lane;
#pragma unroll
      for (int g = 0; g < 4; ++g)
#pragma unroll
        for (int q = 0; q < 4; ++q) { sva[g][q] = scp[g * 256 + q * 64]; svb[g][q] = scp[1024 + g * 256 + q * 64]; }
      topk_group<4>(sva, wtk, eidx_s, gate_s);
      topk_group<4>(svb, wtk, eidx_s + 64, gate_s + 64);
    }
    const int idxA = eidx_s[lane], idxB = eidx_s[64 + lane];
    const float gA = gate_s[lane], gB = gate_s[64 + lane];
    const float suA = SU[idxA], suB = SU[idxB];
    const float gvA = gA * SV[idxA], gvB = gB * SV[idxB];
    f32x2 acc2[8];
#pragma unroll
    for (int j = 0; j < 8; ++j) { acc2[j].x = 0.f; acc2[j].y = 0.f; }
    constexpr int NB = 16;
    u32x2 un[NB], vn[NB];
#pragma unroll
    for (int j = 0; j < NB; ++j) {
      const int idx = __builtin_amdgcn_readlane(idxA, j);
      un[j] = *(const u32x2*)(U + (long)idx * 512 + lane * 8);
      vn[j] = *(const u32x2*)(V + (long)idx * 512 + lane * 8);
    }
    const int bi = (t < TL) ? (t >> 11) : 8;
    f32x4 xpre[4], gpre[4];
    {
      const float* g2 = modl + bi * 6144 + 5120 + lane * 16;
      const float* xr = p.XRES + (long)t * 1024 + lane * 16;
#pragma unroll
      for (int q = 0; q < 4; ++q) { xpre[q] = *(const f32x4*)(xr + q * 4); gpre[q] = *(const f32x4*)(g2 + q * 4); }
    }
#pragma unroll 1
    for (int b = 0; b < 128 / NB; ++b) {
      const int l0 = (b * NB) & 63;
      const bool hiHalf = b * NB >= 64;
      u32x2 uc[NB];
      u32x2 vc[NB];
#pragma unroll
      for (int j = 0; j < NB; ++j) {
        uc[j] = un[j];
        vc[j] = vn[j];
      }
      if (b + 1 < 128 / NB) {
        const int l1 = ((b + 1) * NB) & 63;
        const bool hi1 = (b + 1) * NB >= 64;
#pragma unroll
        for (int j = 0; j < NB; ++j) {
          const int idx = hi1 ? __builtin_amdgcn_readlane(idxB, l1 + j) : __builtin_amdgcn_readlane(idxA, l1 + j);
          un[j] = *(const u32x2*)(U + (long)idx * 512 + lane * 8);
          vn[j] = *(const u32x2*)(V + (long)idx * 512 + lane * 8);
        }
      }
      float dsel = 0.f;
#pragma unroll
      for (int j = 0; j < NB; ++j) {
        const float d = rowsum16(dot16_fp4(hp, uc[j]));
        if ((lane & (NB - 1)) == j) dsel = d;
      }
      dsel += __shfl_xor(dsel, 16);
      dsel += __shfl_xor(dsel, 32);
      const float wv = hiHalf ? gvB * gelu_tanh(dsel * suB) : gvA * gelu_tanh(dsel * suA);
      const int wvi = __builtin_bit_cast(int, wv);
#pragma unroll
      for (int j = 0; j < NB; ++j) {
        const float wj = __builtin_bit_cast(float, __builtin_amdgcn_readlane(wvi, l0 + j));
        axpy16_fp4(acc2, wj, vc[j]);
      }
    }
    float acc[16];
#pragma unroll
    for (int j = 0; j < 8; ++j) { acc[2 * j] = acc2[j].x; acc[2 * j + 1] = acc2[j].y; }
    float* dst = dstbase + (long)t * 1024 + lane * 16;
    float ssq = 0.f;
#pragma unroll
    for (int q = 0; q < 4; ++q) {
      const f32x4 x0 = xpre[q];
      const f32x4 ga = gpre[q];
      f32x4 o = {x0.x + ga.x * acc[q * 4], x0.y + ga.y * acc[q * 4 + 1], x0.z + ga.z * acc[q * 4 + 2], x0.w + ga.w * acc[q * 4 + 3]};
      *(f32x4*)(dst + q * 4) = o;
      acc[q * 4] = o.x; acc[q * 4 + 1] = o.y; acc[q * 4 + 2] = o.z; acc[q * 4 + 3] = o.w;
      ssq += o.x * o.x + o.y * o.y + o.z * o.z + o.w * o.w;
    }
    if (layer == 0) {
      const float rstd = rsqrtf(wsum_fast(ssq) * (1.f / 1024.f) + EPSF);
      const float* md1 = p.MOD + (long)(9 + bi) * 6144 + lane * 16;
      const float* nw1 = p.norm1_w + 1024 + lane * 16;
      float y[16];
#pragma unroll
      for (int q = 0; q < 4; ++q) {
        const f32x4 nw = *(const f32x4*)(nw1 + q * 4);
        const f32x4 sh = *(const f32x4*)(md1 + q * 4);
        const f32x4 sc = *(const f32x4*)(md1 + 1024 + q * 4);
        y[q * 4] = acc[q * 4] * rstd * nw.x * (1.f + sc.x) + sh.x;
        y[q * 4 + 1] = acc[q * 4 + 1] * rstd * nw.y * (1.f + sc.y) + sh.y;
        y[q * 4 + 2] = acc[q * 4 + 2] * rstd * nw.z * (1.f + sc.z) + sh.z;
        y[q * 4 + 3] = acc[q * 4 + 3] * rstd * nw.w * (1.f + sc.w) + sh.w;
      }
      *(u32x4*)(p.HB + (long)t * 1024 + lane * 16) = pack8f(y);
      *(u32x4*)(p.HB + (long)t * 1024 + lane * 16 + 8) = pack8f(y + 8);
    }
  }
}

#ifdef EXPERIMENT
#define REPL(k) for (int rep_ = 0; rep_ < p.rep[k]; ++rep_)
#else
#define REPL(k)
#endif
DI void run_phase(const Params& p, int ph, char* smem) {
  const float* mod0 = p.MOD;
  const float* mod1 = p.MOD + 9 * 6144;
  EpiArgs ea;
  ea.C = nullptr; ea.ldc = 0; ea.N = 0; ea.xin_lat = nullptr; ea.xin_ctx = nullptr; ea.g = nullptr;
  switch (ph) {
    case 0: REPL(5) phase_prep(p, smem); break;
    case 1: REPL(1) phase_modulate(p, p.x, p.ctx, TA, p.norm1_w, mod0, 0, 1024); break;
    case 2: ea.C = p.Z; ea.ldc = 1312; ea.N = 1312; gemm_phase<0>(smem, p.HB, 1024, 0, p.WT_ABIN, 1024, 144, 11, 0, ea);
      {
        const int nslot = gridDim.x >> 3, slot = blockIdx.x >> 3, busy = 198 % nslot;
        const int nidle = nslot - busy;
        if (slot >= busy) {
          const int wi = (slot - busy) * 8 + (blockIdx.x & 7), nwk = nidle * 8;
          convert_fp4_rows(p.peer_u, p.U8, p.SCU, 2 * 16384, wi, nwk);
        }
      }
      break;
    case 3: phase_post0a(p); break;
    case 4:
      ea.C = p.QB; ea.ldc = 768; ea.N = 768; gemm_phase<0>(smem, p.Z + 768, 1312, 0, p.WT_UQ, 256, 144, 6, 0, ea);
      ea.C = p.KVR; ea.ldc = 1024; ea.N = 1024; gemm_phase<0>(smem, p.Z + 1024, 1312, 0, p.WT_UKV, 256, 144, 8, 108, ea);
      break;
    case 5: phase_post0b(p); break;
    case 6: REPL(3) phase_attn0(p, smem); break;
    case 7: ea.C = p.XRES; ea.N = 1024; ea.xin_lat = p.x; ea.xin_ctx = p.ctx; ea.g = mod0 + 2048;
      gemm_phase<2>(smem, p.AO, 1024, 0, p.WT_ABO, 1024, 144, 8, 0, ea);
      {
        const int nslot = gridDim.x >> 3, slot = blockIdx.x >> 3, busy = 144 % nslot;
        if (slot >= busy) convert_fp4_rows(p.peer_v, p.V8, p.SCV, 2 * 16384, (slot - busy) * 8 + (blockIdx.x & 7), (nslot - busy) * 8);
      }
      break;
    case 8: REPL(1) phase_modulate(p, p.XRES, p.XRES + (long)TL * 1024, TA, p.norm2_w, mod0, 3072, 4096); break;
    case 9: gemm_pq_scores(smem, p.HB, p.WT_PQ, p.KEYS16, p.SC, 144); break;
    case 10: phase_peer(p, 0, TA, p.XRES, smem); break;
    case 11: ea.C = p.Z; ea.ldc = 2304; ea.N = 2304; gemm_phase<0>(smem, p.HB, 1024, 0, p.WT_CDIN, 1024, 144, 18, 0, ea); break;
    case 12: phase_post1(p); break;
    case 13: REPL(4) phase_attn1(p, smem); break;
    case 14: REPL(2) for (int id = blockIdx.x; id < 512; id += gridDim.x) ret_out_item(p, smem, id); break;
    case 15: ea.C = p.XRES; ea.N = 1024; ea.g = mod1 + 2048; gemm_phase<3>(smem, p.AO, 1024, 0, p.WT_CDO, 1024, 128, 8, 0, ea); break;
    case 16: REPL(1) phase_modulate(p, p.XRES, p.XRES + (long)TL * 1024, TL, p.norm2_w + 1024, mod1, 3072, 4096); break;
    case 17: gemm_pq_scores(smem, p.HB, p.WT_PQ + 2048L * 1024, p.KEYS16 + 16L * 128 * 128, p.SC, 128); break;
    case 18: phase_peer(p, 1, TL, p.out, smem); break;
    default: break;
  }
}


#define XB_TMO      128
#define XB_XCNT(j)  (256  + 64 * (j))
#define XB_XSUB(j)  (1280 + 64 * (j))
#define XB_XGEN(j)  (2304 + 64 * (j))
#define XB_TOP      3328
#define XB_TOPGEN   3392
#define XCD_BAR_WORDS 3456
#define XB_SPIN_CAP (1u << 20)
#define LAS __attribute__((address_space(3)))
DI unsigned xb_ld(unsigned* p) { return __hip_atomic_load(p, __ATOMIC_RELAXED, __HIP_MEMORY_SCOPE_AGENT); }
DI unsigned xb_add(unsigned* p, unsigned v) { return __hip_atomic_fetch_add(p, v, __ATOMIC_RELAXED, __HIP_MEMORY_SCOPE_AGENT); }
DI unsigned xb_xcc_id() { return (unsigned)__builtin_amdgcn_s_getreg((3 << 11) | 20) & 0xFu; }
#define XB_SPIN(cond, bar) do { unsigned _sp = 0; while (cond) { __builtin_amdgcn_s_sleep(1); \
    if ((++_sp & 255u) == 0u) { if (xb_ld(&(bar)[XB_TMO])) break; if (_sp > XB_SPIN_CAP) { atomicAdd(&(bar)[XB_TMO], 1u); break; } } } } while (0)
struct XcdBarrier { unsigned* bar; unsigned x; volatile LAS unsigned* st; };
DI XcdBarrier xcd_barrier_post(unsigned* bar, volatile LAS unsigned* st) {
  XcdBarrier b; b.bar = bar; b.x = xb_xcc_id(); b.st = st;
  if (threadIdx.x == 0) (void)xb_add(&bar[XB_XCNT(b.x)], 1u);
  return b;
}
DI void xcd_barrier_complete(unsigned* bar, unsigned x, unsigned& nloc, unsigned& nx) {
  const unsigned G = gridDim.x * gridDim.y * gridDim.z;
  unsigned sum, cnt, mine, sp = 0u;
  for (;;) {
    sum = 0u; cnt = 0u; mine = 0u;
#pragma unroll
    for (unsigned j = 0; j < 16; ++j) { const unsigned c = xb_ld(&bar[XB_XCNT(j)]); sum += c; cnt += (c > 0u) ? 1u : 0u; mine = (j == x) ? c : mine; }
    if (sum == G) break;
    __builtin_amdgcn_s_sleep(1);
    if ((++sp & 255u) == 0u) { if (xb_ld(&bar[XB_TMO])) break; if (sp > XB_SPIN_CAP) { atomicAdd(&bar[XB_TMO], 1u); break; } }
  }
  nloc = mine > 0u ? mine : 1u; nx = cnt > 0u ? cnt : 1u;
}
DI void xcd_barrier(const XcdBarrier& b) {
  asm volatile("s_waitcnt vmcnt(0)" ::: "memory");
  __syncthreads();
  if (threadIdx.x == 0) {
    unsigned* bar = b.bar;
    __builtin_amdgcn_s_waitcnt(0);
    unsigned nloc = b.st[0], nx = b.st[1];
    if (nloc == 0u) { xcd_barrier_complete(bar, b.x, nloc, nx); b.st[0] = nloc; b.st[1] = nx; }
    const unsigned old = xb_add(&bar[XB_XSUB(b.x)], 1u);
    const unsigned gen = old / nloc;
    if (old + 1u == (gen + 1u) * nloc) {
      __builtin_amdgcn_fence(__ATOMIC_RELEASE, "agent");
      asm volatile("s_waitcnt vmcnt(0)" ::: "memory");
      const unsigned og = xb_add(&bar[XB_TOP], 1u);
      const unsigned tg = og / nx;
      if (og + 1u == (tg + 1u) * nx) xb_add(&bar[XB_TOPGEN], 1u);
      else XB_SPIN(xb_ld(&bar[XB_TOPGEN]) == tg, bar);
      __builtin_amdgcn_fence(__ATOMIC_ACQUIRE, "agent");
      xb_add(&bar[XB_XGEN(b.x)], 1u);
      asm volatile("s_waitcnt vmcnt(0)" ::: "memory");
    } else {
      XB_SPIN(xb_ld(&bar[XB_XGEN(b.x)]) == gen, bar);
      __builtin_amdgcn_fence(__ATOMIC_ACQUIRE, "agent");
      asm volatile("s_waitcnt vmcnt(0)" ::: "memory");
    }
  }
  __syncthreads();
}

#if MULTI_LAUNCH
template <int PH>
__global__ void __launch_bounds__(256, 2) phase_kernel(KArgs a) {
  __shared__ __attribute__((aligned(16))) char smem[73728];
  const Params p = make_params(a);
  run_phase(p, PH, smem);
}
template <int PH>
static void launch_all(const KArgs& a, hipStream_t stream) {
  hipLaunchKernelGGL(phase_kernel<PH>, dim3(512), dim3(256), 0, stream, a);
  if constexpr (PH + 1 < NPHASE) launch_all<PH + 1>(a, stream);
}
#else
template <int PH>
DI void run_from(const Params& p, char* smem, cg::grid_group& grid, const XcdBarrier& xb) {
  run_phase(p, PH, smem);
  if constexpr (PH + 1 < NPHASE) {
    if constexpr (PH == 0) { if (p.out == nullptr) grid.sync(); }
    xcd_barrier(xb);
    run_from<PH + 1>(p, smem, grid, xb);
  }
}
__global__ void __launch_bounds__(256, 2) mega_kernel(KArgs a) {
  __shared__ __attribute__((aligned(16))) char smem[73728];
  __shared__ __attribute__((aligned(16))) unsigned xb_words[4];
  if (threadIdx.x < 4) xb_words[threadIdx.x] = 0u;
  __syncthreads();
  const Params p = make_params(a);
  const XcdBarrier xb = xcd_barrier_post(p.BAR, (volatile LAS unsigned*)xb_words);
  cg::grid_group grid = cg::this_grid();
  run_from<0>(p, smem, grid, xb);
}
#endif

extern "C" void kernel_launch(void* const* d_in, const int* in_sizes, int n_in, void* d_out, int out_size, void* d_ws, size_t ws_size,
                              hipStream_t stream) {
  KArgs a;
  memset(&a, 0, sizeof(a));
  for (int i = 0; i < 30; ++i) a.in[i] = (const float*)d_in[i];
  a.out = (float*)d_out;
  a.ws = (char*)d_ws;
#ifdef EXPERIMENT
  { const int r[8] = {EXPERIMENT}; for (int i = 0; i < 8; ++i) a.rep[i] = r[i]; }
#endif
  (void)hipMemsetAsync((char*)d_ws + OFF_MOD, 0, (OFF_BAR - OFF_MOD) + 4096 * 4, stream);
#if MULTI_LAUNCH
  launch_all<0>(a, stream);
#else
  static int grid_blocks = 0;
  if (!grid_blocks) {
    int dev = 0, cus = 0, per_cu = 0;
    (void)hipGetDevice(&dev);
    (void)hipDeviceGetAttribute(&cus, hipDeviceAttributeMultiprocessorCount, dev);
    (void)hipOccupancyMaxActiveBlocksPerMultiprocessor(&per_cu, mega_kernel, 256, 0);
    if (per_cu > 2) per_cu = 2;
    if (per_cu < 1) per_cu = 1;
    grid_blocks = (cus * per_cu) & ~7;
  }
  void* args[] = {&a};
  hipError_t e = hipLaunchCooperativeKernel((void*)mega_kernel, dim3(grid_blocks), dim3(256), args, 0, stream);
  if (e != hipSuccess) fprintf(stderr, "cooperative launch failed: %s (grid %d)\n", hipGetErrorString(e), grid_blocks);
#endif
}
```

```cpp
#include <hip/hip_runtime.h>
#include <hip/hip_cooperative_groups.h>
#include <cstdio>
#include <cstring>
namespace cg = cooperative_groups;

#ifndef MULTI_LAUNCH
#define MULTI_LAUNCH 0
#endif

typedef unsigned short u16;
typedef short bf16x8 __attribute__((ext_vector_type(8)));
typedef float f32x16 __attribute__((ext_vector_type(16)));
typedef short s16x4 __attribute__((ext_vector_type(4)));
#define LDS3 __attribute__((address_space(3)))
typedef __bf16 bf2_t __attribute__((ext_vector_type(2)));
typedef float f2_t __attribute__((ext_vector_type(2)));
typedef unsigned int u32x4 __attribute__((ext_vector_type(4)));
typedef unsigned int u32x2 __attribute__((ext_vector_type(2)));
typedef float f32x4 __attribute__((ext_vector_type(4)));
typedef float f32x2 __attribute__((ext_vector_type(2)));
#define DI __device__ __forceinline__
#define MFMA(a, b, c) __builtin_amdgcn_mfma_f32_32x32x16_bf16((a), (b), (c), 0, 0, 0)

constexpr int TL = 16384;
constexpr int TC = 2048;
constexpr int TA = 18432;
constexpr int NPHASE = 19;
constexpr float EPSF = 1e-6f;
constexpr float LOG2E = 1.4426950408889634f;

struct KArgs {
  const float* in[30];
  float* out;
  char* ws;
#ifdef EXPERIMENT
  int rep[8];
#endif
};
struct Params {
  const float *x, *c, *ctx, *c_ctx, *ada_w, *ada_b, *norm1_w, *norm2_w, *ab_w_in, *ab_w_o, *a_q_norm, *a_k_norm, *a_sink,
      *b_q_lora_norm, *b_kv_lora_norm, *b_w_uq, *b_w_ukv, *b_q_norm, *b_k_norm, *cd_w_in, *cd_w_o, *c_decay_fwd, *c_decay_bwd,
      *c_gn_w, *d_q_norm, *d_k_norm, *peer_w_q, *peer_keys, *peer_u, *peer_v;
  float* out;
  u16 *U16, *V16, *WT_ABIN, *WT_ABO, *WT_UQ, *WT_UKV, *WT_CDIN, *WT_CDO, *WT_PQ, *KEYS16;
  float *MOD, *ROPE16, *ROPE8, *XRES;
  u16 *HB, *AO, *Z, *QB, *KVR, *KB, *VB;
  float* LST;
  float* SC;
  u16* PQ;
  int* EIDX;
  float* GATE;
  unsigned* BAR;
  unsigned char *U8, *V8;
  float *SCU, *SCV;
#ifdef EXPERIMENT
  int rep[8];
#endif
};
constexpr size_t al256(size_t x) { return (x + 255) & ~(size_t)255; }
constexpr size_t OFF_U16 = 0;
constexpr size_t OFF_V16 = OFF_U16 + al256(2UL * 16384 * 1024 * 2);
constexpr size_t OFF_WT_ABIN = OFF_V16 + al256(2UL * 16384 * 1024 * 2);
constexpr size_t OFF_WT_ABO = OFF_WT_ABIN + al256(1408UL * 1024 * 2);
constexpr size_t OFF_WT_UQ = OFF_WT_ABO + al256(1024UL * 1024 * 2);
constexpr size_t OFF_WT_UKV = OFF_WT_UQ + al256(768UL * 256 * 2);
constexpr size_t OFF_WT_CDIN = OFF_WT_UKV + al256(1024UL * 256 * 2);
constexpr size_t OFF_WT_CDO = OFF_WT_CDIN + al256(2304UL * 1024 * 2);
constexpr size_t OFF_WT_PQ = OFF_WT_CDO + al256(1024UL * 1024 * 2);
constexpr size_t OFF_KEYS16 = OFF_WT_PQ + al256(2UL * 2048 * 1024 * 2);
constexpr size_t OFF_MOD = OFF_KEYS16 + al256(2UL * 16 * 128 * 128 * 2);
constexpr size_t OFF_ROPE16 = OFF_MOD + al256(2UL * 9 * 6144 * 4);
constexpr size_t OFF_ROPE8 = OFF_ROPE16 + al256(64UL * 16 * 2 * 4);
constexpr size_t OFF_BAR = OFF_ROPE8 + al256(64UL * 8 * 2 * 4);
constexpr size_t OFF_SCU = OFF_BAR + al256(4096UL * 4);
constexpr size_t OFF_SCV = OFF_SCU + al256(2UL * 16384 * 4);
constexpr size_t OFF_XRES = OFF_SCV + al256(2UL * 16384 * 4);
constexpr size_t OFF_HB = OFF_XRES + al256((size_t)TA * 1024 * 4);
constexpr size_t OFF_R = OFF_HB + al256((size_t)TA * 1024 * 2);
constexpr size_t OFF_AO = OFF_R;
constexpr size_t OFF_Z = OFF_AO + (size_t)TA * 1024 * 2;
constexpr size_t OFF_QB = OFF_Z + (size_t)TA * 2304 * 2;
constexpr size_t OFF_KVR = OFF_QB + (size_t)TA * 768 * 2;
constexpr size_t OFF_KB = OFF_KVR + (size_t)TA * 1024 * 2;
constexpr size_t OFF_VB = OFF_KB + (size_t)TA * 768 * 2;
constexpr size_t OFF_SC = OFF_R;
constexpr size_t OFF_PQ = OFF_SC + (size_t)TA * 2048 * 4;
constexpr size_t OFF_EIDX = OFF_PQ + (size_t)TA * 2048 * 2;
constexpr size_t OFF_GATE = OFF_EIDX + (size_t)TA * 128 * 4;
constexpr size_t WS_END = OFF_GATE + (size_t)TA * 128 * 4;
static_assert(WS_END <= 536870912UL, "workspace map exceeds 512 MiB");
static_assert(OFF_VB + (size_t)TA * 512 * 2 <= 536870912UL, "workspace map exceeds 512 MiB");

DI Params make_params(const KArgs& a) {
  Params p;
  p.x = a.in[0]; p.c = a.in[1]; p.ctx = a.in[2]; p.c_ctx = a.in[3]; p.ada_w = a.in[4]; p.ada_b = a.in[5]; p.norm1_w = a.in[6];
  p.norm2_w = a.in[7]; p.ab_w_in = a.in[8]; p.ab_w_o = a.in[9]; p.a_q_norm = a.in[10]; p.a_k_norm = a.in[11]; p.a_sink = a.in[12];
  p.b_q_lora_norm = a.in[13]; p.b_kv_lora_norm = a.in[14]; p.b_w_uq = a.in[15]; p.b_w_ukv = a.in[16]; p.b_q_norm = a.in[17];
  p.b_k_norm = a.in[18]; p.cd_w_in = a.in[19]; p.cd_w_o = a.in[20]; p.c_decay_fwd = a.in[21]; p.c_decay_bwd = a.in[22];
  p.c_gn_w = a.in[23]; p.d_q_norm = a.in[24]; p.d_k_norm = a.in[25]; p.peer_w_q = a.in[26]; p.peer_keys = a.in[27];
  p.peer_u = a.in[28]; p.peer_v = a.in[29];
  p.out = a.out;
#ifdef EXPERIMENT
  for (int i = 0; i < 8; ++i) p.rep[i] = a.rep[i];
#endif
  char* ws = a.ws;
  p.U16 = (u16*)(ws + OFF_U16); p.V16 = (u16*)(ws + OFF_V16); p.WT_ABIN = (u16*)(ws + OFF_WT_ABIN); p.WT_ABO = (u16*)(ws + OFF_WT_ABO);
  p.WT_UQ = (u16*)(ws + OFF_WT_UQ); p.WT_UKV = (u16*)(ws + OFF_WT_UKV); p.WT_CDIN = (u16*)(ws + OFF_WT_CDIN); p.WT_CDO = (u16*)(ws + OFF_WT_CDO);
  p.WT_PQ = (u16*)(ws + OFF_WT_PQ); p.KEYS16 = (u16*)(ws + OFF_KEYS16); p.MOD = (float*)(ws + OFF_MOD); p.ROPE16 = (float*)(ws + OFF_ROPE16);
  p.ROPE8 = (float*)(ws + OFF_ROPE8); p.BAR = (unsigned*)(ws + OFF_BAR); p.XRES = (float*)(ws + OFF_XRES); p.HB = (u16*)(ws + OFF_HB);
  p.AO = (u16*)(ws + OFF_AO); p.Z = (u16*)(ws + OFF_Z); p.QB = (u16*)(ws + OFF_QB); p.LST = (float*)(ws + OFF_QB); p.KVR = (u16*)(ws + OFF_KVR);
  p.KB = (u16*)(ws + OFF_KB); p.VB = (u16*)(ws + OFF_VB); p.SC = (float*)(ws + OFF_SC); p.PQ = (u16*)(ws + OFF_PQ);
  p.EIDX = (int*)(ws + OFF_EIDX); p.GATE = (float*)(ws + OFF_GATE);
  p.U8 = (unsigned char*)(ws + OFF_U16); p.V8 = (unsigned char*)(ws + OFF_V16); p.SCU = (float*)(ws + OFF_SCU); p.SCV = (float*)(ws + OFF_SCV);
  return p;
}

DI unsigned pack2(float a, float b) {
  f2_t v = {a, b};
  return __builtin_bit_cast(unsigned, __builtin_convertvector(v, bf2_t));
}
DI u16 f2bf(float a) { return (u16)(pack2(a, 0.f) & 0xffffu); }
DI float bf2f(u16 v) { return __uint_as_float(((unsigned)v) << 16); }
DI float bflo(unsigned v) { return __uint_as_float(v << 16); }
DI float bfhi(unsigned v) { return __uint_as_float(v & 0xffff0000u); }
DI float wsum(float v) {
#pragma unroll
  for (int o = 32; o >= 1; o >>= 1) v += __shfl_xor(v, o);
  return v;
}
DI float wmax(float v) {
#pragma unroll
  for (int o = 32; o >= 1; o >>= 1) v = fmaxf(v, __shfl_xor(v, o));
  return v;
}
DI int crow(int reg, int h) { return (reg & 3) + 8 * (reg >> 2) + 4 * h; }
DI float ex2(float x) { return __builtin_amdgcn_exp2f(x); }
DI bf16x8 as_bf16x8(u32x4 v) { return __builtin_bit_cast(bf16x8, v); }
DI bf16x8 join8(u32x2 a, u32x2 b) { u32x4 v = {a.x, a.y, b.x, b.y}; return __builtin_bit_cast(bf16x8, v); }
DI bf16x8 pack8(const f32x16& x, int s) {
  u32x4 v;
  v.x = pack2(x[8 * s + 0], x[8 * s + 1]);
  v.y = pack2(x[8 * s + 2], x[8 * s + 3]);
  v.z = pack2(x[8 * s + 4], x[8 * s + 5]);
  v.w = pack2(x[8 * s + 6], x[8 * s + 7]);
  return __builtin_bit_cast(bf16x8, v);
}
DI f32x16 zero16() {
  f32x16 z;
#pragma unroll
  for (int i = 0; i < 16; ++i) z[i] = 0.f;
  return z;
}
DI float log_sigmoid(float x) { return -log1pf(__expf(-x)); }
DI float silu(float x) { return x / (1.f + __expf(-x)); }
DI float gelu_tanh(float x) {
  float u = 0.7978845608028654f * (x + 0.044715f * x * x * x);
  float t = 1.f - 2.f / (__expf(2.f * u) + 1.f);
  return 0.5f * x * (1.f + t);
}

DI float rowsum16(float v) {
  v += __builtin_bit_cast(float, __builtin_amdgcn_update_dpp(0, __builtin_bit_cast(int, v), 0x128, 0xf, 0xf, false));
  v += __builtin_bit_cast(float, __builtin_amdgcn_update_dpp(0, __builtin_bit_cast(int, v), 0x124, 0xf, 0xf, false));
  v += __builtin_bit_cast(float, __builtin_amdgcn_update_dpp(0, __builtin_bit_cast(int, v), 0x122, 0xf, 0xf, false));
  v += __builtin_bit_cast(float, __builtin_amdgcn_update_dpp(0, __builtin_bit_cast(int, v), 0x121, 0xf, 0xf, false));
  return v;
}
DI float wsum_fast(float v) {
  v = rowsum16(v);
  const int iv = __builtin_bit_cast(int, v);
  const float a = __builtin_bit_cast(float, __builtin_amdgcn_readlane(iv, 0));
  const float b = __builtin_bit_cast(float, __builtin_amdgcn_readlane(iv, 16));
  const float c = __builtin_bit_cast(float, __builtin_amdgcn_readlane(iv, 32));
  const float d = __builtin_bit_cast(float, __builtin_amdgcn_readlane(iv, 48));
  return (a + b) + (c + d);
}
DI float rowmax16(float v) {
  v = fmaxf(v, __builtin_bit_cast(float, __builtin_amdgcn_update_dpp(0, __builtin_bit_cast(int, v), 0x128, 0xf, 0xf, false)));
  v = fmaxf(v, __builtin_bit_cast(float, __builtin_amdgcn_update_dpp(0, __builtin_bit_cast(int, v), 0x124, 0xf, 0xf, false)));
  v = fmaxf(v, __builtin_bit_cast(float, __builtin_amdgcn_update_dpp(0, __builtin_bit_cast(int, v), 0x122, 0xf, 0xf, false)));
  v = fmaxf(v, __builtin_bit_cast(float, __builtin_amdgcn_update_dpp(0, __builtin_bit_cast(int, v), 0x121, 0xf, 0xf, false)));
  return v;
}
DI float wmax_fast(float v) {
  v = rowmax16(v);
  const int iv = __builtin_bit_cast(int, v);
  const float a = __builtin_bit_cast(float, __builtin_amdgcn_readlane(iv, 0));
  const float b = __builtin_bit_cast(float, __builtin_amdgcn_readlane(iv, 16));
  const float c = __builtin_bit_cast(float, __builtin_amdgcn_readlane(iv, 32));
  const float d = __builtin_bit_cast(float, __builtin_amdgcn_readlane(iv, 48));
  return fmaxf(fmaxf(a, b), fmaxf(c, d));
}
DI void convert_fp8_rows(const float* __restrict__ src, unsigned char* __restrict__ dst, float* __restrict__ scl, int nrows, int wi, int nwk) {
  const int lane = threadIdx.x & 63, w = threadIdx.x >> 6;
  for (int row0 = (wi * 4 + w) * 4; row0 < nrows; row0 += nwk * 16) {
    f32x4 v[4][4];
#pragma unroll
    for (int rr = 0; rr < 4; ++rr) {
      const float* sp = src + (long)(row0 + rr) * 1024 + lane * 16;
#pragma unroll
      for (int q = 0; q < 4; ++q) v[rr][q] = *(const f32x4*)(sp + q * 4);
    }
#pragma unroll
    for (int rr = 0; rr < 4; ++rr) {
      float am = 0.f;
#pragma unroll
      for (int q = 0; q < 4; ++q)
        am = fmaxf(am, fmaxf(fmaxf(fabsf(v[rr][q].x), fabsf(v[rr][q].y)), fmaxf(fabsf(v[rr][q].z), fabsf(v[rr][q].w))));
      am = wmax_fast(am);
      const float inv = am > 0.f ? 224.f / am : 0.f;
      u32x4 o;
#pragma unroll
      for (int q = 0; q < 4; ++q) {
        int pk = 0;
        pk = __builtin_amdgcn_cvt_pk_fp8_f32(v[rr][q].x * inv, v[rr][q].y * inv, pk, false);
        pk = __builtin_amdgcn_cvt_pk_fp8_f32(v[rr][q].z * inv, v[rr][q].w * inv, pk, true);
        o[q] = (unsigned)pk;
      }
      *(u32x4*)(dst + (long)(row0 + rr) * 1024 + lane * 16) = o;
      if (lane == 0) scl[row0 + rr] = am * (1.f / 224.f);
    }
  }
}

DI void convert_fp4_rows(const float* __restrict__ src, unsigned char* __restrict__ dst, float* __restrict__ scl, int nrows, int wi, int nwk) {
  const int lane = threadIdx.x & 63, w = threadIdx.x >> 6;
  for (int row0 = (wi * 4 + w) * 4; row0 < nrows; row0 += nwk * 16) {
    f32x4 v[4][4];
#pragma unroll
    for (int rr = 0; rr < 4; ++rr) {
      const float* sp = src + (long)(row0 + rr) * 1024 + lane * 16;
#pragma unroll
      for (int q = 0; q < 4; ++q) v[rr][q] = *(const f32x4*)(sp + q * 4);
    }
#pragma unroll
    for (int rr = 0; rr < 4; ++rr) {
      float am = 0.f;
#pragma unroll
      for (int q = 0; q < 4; ++q)
        am = fmaxf(am, fmaxf(fmaxf(fabsf(v[rr][q].x), fabsf(v[rr][q].y)), fmaxf(fabsf(v[rr][q].z), fabsf(v[rr][q].w))));
      am = wmax_fast(am);
      const float inv = am > 0.f ? 6.f / am : 0.f;
      u32x2 o;
#pragma unroll
      for (int d = 0; d < 2; ++d) {
        unsigned pk = 0u;
        pk = __builtin_amdgcn_cvt_scalef32_pk_fp4_f32(pk, v[rr][2 * d].x * inv, v[rr][2 * d].y * inv, 1.0f, 0);
        pk = __builtin_amdgcn_cvt_scalef32_pk_fp4_f32(pk, v[rr][2 * d].z * inv, v[rr][2 * d].w * inv, 1.0f, 1);
        pk = __builtin_amdgcn_cvt_scalef32_pk_fp4_f32(pk, v[rr][2 * d + 1].x * inv, v[rr][2 * d + 1].y * inv, 1.0f, 2);
        pk = __builtin_amdgcn_cvt_scalef32_pk_fp4_f32(pk, v[rr][2 * d + 1].z * inv, v[rr][2 * d + 1].w * inv, 1.0f, 3);
        o[d] = pk;
      }
      *(u32x2*)(dst + (long)(row0 + rr) * 512 + lane * 8) = o;
      if (lane == 0) scl[row0 + rr] = am * (1.f / 6.f);
    }
  }
}

DI void transpose_w(const float* __restrict__ W, int K, int N, int Npad, u16* __restrict__ Wt, long gtid, long gsz) {
  const long items = (long)Npad * (K / 8);
  for (long id0 = gtid; id0 < items; id0 += 2 * gsz) {
    u32x4 o[2];
    long idv[2];
#pragma unroll
    for (int u = 0; u < 2; ++u) {
      const long id = id0 + u * gsz;
      idv[u] = id;
      u32x4 oo = {0u, 0u, 0u, 0u};
      if (id < items) {
        const int n = (int)(id % Npad), k8 = (int)(id / Npad);
        if (n < N) {
          const float* sp = W + (long)(k8 * 8) * N + n;
          oo.x = pack2(sp[0], sp[(long)N]);
          oo.y = pack2(sp[2L * N], sp[3L * N]);
          oo.z = pack2(sp[4L * N], sp[5L * N]);
          oo.w = pack2(sp[6L * N], sp[7L * N]);
        }
      }
      o[u] = oo;
    }
#pragma unroll
    for (int u = 0; u < 2; ++u) {
      const long id = idv[u];
      if (id < items) {
        const int n = (int)(id % Npad), k8 = (int)(id / Npad);
        *(u32x4*)(Wt + (long)n * K + k8 * 8) = o[u];
      }
    }
  }
}
DI void convert8(const float* __restrict__ src, u16* __restrict__ dst, long n8, long gtid, long gsz) {
  for (long i = gtid; i < n8; i += gsz) {
    const f32x4 a = ((const f32x4*)src)[2 * i], b = ((const f32x4*)src)[2 * i + 1];
    u32x4 o;
    o.x = pack2(a.x, a.y); o.y = pack2(a.z, a.w); o.z = pack2(b.x, b.y); o.w = pack2(b.z, b.w);
    ((u32x4*)dst)[i] = o;
  }
}

DI void phase_prep(const Params& p, char* smem) {
  const int tid = threadIdx.x;
  const long gtid = (long)blockIdx.x * 256 + tid, gsz = (long)gridDim.x * 256;
  {
    float* sS = (float*)smem;
    float* sR = sS + 9 * 256;
    for (int it = blockIdx.x; it < 768; it += gridDim.x) {
      const int kq = it & 3, cb = (it >> 2) % 96, l = it / 384;
      __syncthreads();
      for (int i = tid; i < 9 * 256; i += 256) {
        const int bi = i >> 8, k = kq * 256 + (i & 255);
        const float v = (bi < 8) ? p.c[bi * 1024 + k] : p.c_ctx[k];
        sS[i] = silu(v);
      }
      __syncthreads();
      const int col = cb * 64 + (tid & 63), kg = tid >> 6;
      const float* wp = p.ada_w + (long)l * 1024 * 6144 + (long)(kq * 256 + kg * 64) * 6144 + col;
      float acc[9];
#pragma unroll
      for (int i = 0; i < 9; ++i) acc[i] = 0.f;
#pragma unroll 8
      for (int k = 0; k < 64; ++k) {
        const float wv = wp[(long)k * 6144];
#pragma unroll
        for (int i = 0; i < 9; ++i) acc[i] += sS[i * 256 + kg * 64 + k] * wv;
      }
#pragma unroll
      for (int i = 0; i < 9; ++i) sR[(kg * 9 + i) * 64 + (tid & 63)] = acc[i];
      __syncthreads();
      for (int i = tid; i < 9 * 64; i += 256) {
        const int bi = i >> 6, cc = i & 63;
        float sm = sR[(0 * 9 + bi) * 64 + cc] + sR[(1 * 9 + bi) * 64 + cc] + sR[(2 * 9 + bi) * 64 + cc] + sR[(3 * 9 + bi) * 64 + cc];
        if (kq == 0) sm += p.ada_b[l * 6144 + cb * 64 + cc];
        atomicAdd(&p.MOD[((long)l * 9 + bi) * 6144 + cb * 64 + cc], sm);
      }
    }
    __syncthreads();
  }
  for (long i = gtid; i < 64 * 16; i += gsz) {
    const int pos = (int)(i >> 4), f = (int)(i & 15);
    const float ang = (float)pos * exp2f(-(float)f * (13.287712379549449f / 16.f));
    p.ROPE16[2 * i] = __cosf(ang); p.ROPE16[2 * i + 1] = __sinf(ang);
  }
  for (long i = gtid; i < 64 * 8; i += gsz) {
    const int pos = (int)(i >> 3), f = (int)(i & 7);
    const float ang = (float)pos * exp2f(-(float)f * (13.287712379549449f / 8.f));
    p.ROPE8[2 * i] = __cosf(ang); p.ROPE8[2 * i + 1] = __sinf(ang);
  }
  transpose_w(p.ab_w_in, 1024, 1312, 1408, p.WT_ABIN, gtid, gsz);
  transpose_w(p.ab_w_o, 1024, 1024, 1024, p.WT_ABO, gtid, gsz);
  transpose_w(p.b_w_uq, 256, 768, 768, p.WT_UQ, gtid, gsz);
  transpose_w(p.b_w_ukv, 256, 1024, 1024, p.WT_UKV, gtid, gsz);
  transpose_w(p.cd_w_in, 1024, 2304, 2304, p.WT_CDIN, gtid, gsz);
  transpose_w(p.cd_w_o, 1024, 1024, 1024, p.WT_CDO, gtid, gsz);
  transpose_w(p.peer_w_q, 1024, 2048, 2048, p.WT_PQ, gtid, gsz);
  transpose_w(p.peer_w_q + 1024L * 2048, 1024, 2048, 2048, p.WT_PQ + 2048L * 1024, gtid, gsz);
  convert8(p.peer_keys, p.KEYS16, 2L * 16 * 128 * 128 / 8, gtid, gsz);
}

DI void phase_modulate(const Params& p, const float* src_lat, const float* src_ctx, int nrows, const float* normw,
                       const float* modl, int sh_off, int sc_off) {
  const int lane = threadIdx.x & 63, w = threadIdx.x >> 6;
  const int stride = gridDim.x * 4;
  int m = blockIdx.x * 4 + w;
  f32x4 v[4], vn[4];
  f32x4 nw[4];
#pragma unroll
  for (int i = 0; i < 4; ++i) nw[i] = *(const f32x4*)(normw + i * 256 + lane * 4);
  if (m < nrows) {
    const float* src = (m < TL) ? src_lat + (long)m * 1024 : src_ctx + (long)(m - TL) * 1024;
#pragma unroll
    for (int i = 0; i < 4; ++i) v[i] = *(const f32x4*)(src + i * 256 + lane * 4);
  }
  while (m < nrows) {
    const int mn = m + stride;
    if (mn < nrows) {
      const float* src = (mn < TL) ? src_lat + (long)mn * 1024 : src_ctx + (long)(mn - TL) * 1024;
#pragma unroll
      for (int i = 0; i < 4; ++i) vn[i] = *(const f32x4*)(src + i * 256 + lane * 4);
    }
    const int bi = (m < TL) ? (m >> 11) : 8;
    const float* md = modl + bi * 6144;
    f32x4 sc[4], sh[4];
#pragma unroll
    for (int i = 0; i < 4; ++i) {
      sc[i] = *(const f32x4*)(md + sc_off + i * 256 + lane * 4);
      sh[i] = *(const f32x4*)(md + sh_off + i * 256 + lane * 4);
    }
    float ss = 0.f;
#pragma unroll
    for (int i = 0; i < 4; ++i) ss += v[i].x * v[i].x + v[i].y * v[i].y + v[i].z * v[i].z + v[i].w * v[i].w;
    ss = wsum_fast(ss);
    const float rstd = rsqrtf(ss * (1.f / 1024.f) + EPSF);
#pragma unroll
    for (int i = 0; i < 4; ++i) {
      const int col = i * 256 + lane * 4;
      const float y0 = v[i].x * rstd * nw[i].x * (1.f + sc[i].x) + sh[i].x;
      const float y1 = v[i].y * rstd * nw[i].y * (1.f + sc[i].y) + sh[i].y;
      const float y2 = v[i].z * rstd * nw[i].z * (1.f + sc[i].z) + sh[i].z;
      const float y3 = v[i].w * rstd * nw[i].w * (1.f + sc[i].w) + sh[i].w;
      u32x2 o = {pack2(y0, y1), pack2(y2, y3)};
      *(u32x2*)(p.HB + (long)m * 1024 + col) = o;
    }
#pragma unroll
    for (int i = 0; i < 4; ++i) v[i] = vn[i];
    m = mn;
  }
}

struct EpiArgs {
  void* C; int ldc; int N;
  const float* xin_lat; const float* xin_ctx; const float* g;
};
template <int EPI>
DI void gemm_phase(char* smem, const u16* __restrict__ A, int lda, int acs, const u16* __restrict__ Wt, int K, int MT, int NT,
                   int rot, const EpiArgs& ea) {
  u16* sAB = (u16*)smem;
  constexpr int STG = 2 * 128 * 72;
  const int tid = threadIdx.x, lane = tid & 63, w = tid >> 6, r = lane & 31, h = lane >> 5;
  const int wm = w >> 1, wn = w & 1;
  const int nslot = gridDim.x >> 3, xcd = blockIdx.x & 7;
  int first = ((int)(blockIdx.x >> 3) - rot) % nslot;
  if (first < 0) first += nslot;
  const int lrow = tid >> 3, lkc = tid & 7;
  const int per_xcd = (MT >> 3) * NT;
  for (int t = first; t < per_xcd; t += nslot) {
    const int mt = xcd + 8 * (t / NT), nt = t % NT;
    const u16* Ab = A + (long)(mt * 128 + lrow) * lda + nt * acs + lkc * 8;
    const u16* Bb = Wt + (long)(nt * 128 + lrow) * K + lkc * 8;
    f32x16 acc[2][2];
#pragma unroll
    for (int i = 0; i < 2; ++i)
#pragma unroll
      for (int j = 0; j < 2; ++j) acc[i][j] = zero16();
    u32x4 ra0[4], rb0[4], ra1[4], rb1[4];
    const int nk = K >> 6;
#pragma unroll
    for (int i = 0; i < 4; ++i) {
      ra0[i] = *(const u32x4*)(Ab + (long)(32 * i) * lda);
      rb0[i] = *(const u32x4*)(Bb + (long)(32 * i) * K);
    }
#pragma unroll
    for (int i = 0; i < 4; ++i) {
      ra1[i] = *(const u32x4*)(Ab + (long)(32 * i) * lda + 64);
      rb1[i] = *(const u32x4*)(Bb + (long)(32 * i) * K + 64);
    }
    __syncthreads();
#pragma unroll
    for (int i = 0; i < 4; ++i) {
      *(u32x4*)(sAB + (lrow + 32 * i) * 72 + lkc * 8) = ra0[i];
      *(u32x4*)(sAB + 128 * 72 + (lrow + 32 * i) * 72 + lkc * 8) = rb0[i];
    }
    __syncthreads();
    for (int k0 = 0; k0 < nk; k0 += 2) {
      if (k0 + 2 < nk) {
#pragma unroll
        for (int i = 0; i < 4; ++i) {
          ra0[i] = *(const u32x4*)(Ab + (long)(32 * i) * lda + (k0 + 2) * 64);
          rb0[i] = *(const u32x4*)(Bb + (long)(32 * i) * K + (k0 + 2) * 64);
        }
      }
      {
        const u16* cA = sAB;
        const u16* cB = cA + 128 * 72;
#pragma unroll
        for (int ks = 0; ks < 4; ++ks) {
          bf16x8 af[2], bfr[2];
#pragma unroll
          for (int i = 0; i < 2; ++i) {
            af[i] = *(const bf16x8*)(cA + (wm * 64 + i * 32 + r) * 72 + ks * 16 + h * 8);
            bfr[i] = *(const bf16x8*)(cB + (wn * 64 + i * 32 + r) * 72 + ks * 16 + h * 8);
          }
#pragma unroll
          for (int i = 0; i < 2; ++i)
#pragma unroll
            for (int j = 0; j < 2; ++j) acc[i][j] = MFMA(af[i], bfr[j], acc[i][j]);
        }
      }
      {
        u16* nA = sAB + STG;
#pragma unroll
        for (int i = 0; i < 4; ++i) {
          *(u32x4*)(nA + (lrow + 32 * i) * 72 + lkc * 8) = ra1[i];
          *(u32x4*)(nA + 128 * 72 + (lrow + 32 * i) * 72 + lkc * 8) = rb1[i];
        }
        __syncthreads();
      }
      if (k0 + 3 < nk) {
#pragma unroll
        for (int i = 0; i < 4; ++i) {
          ra1[i] = *(const u32x4*)(Ab + (long)(32 * i) * lda + (k0 + 3) * 64);
          rb1[i] = *(const u32x4*)(Bb + (long)(32 * i) * K + (k0 + 3) * 64);
        }
      }
      {
        const u16* cA = sAB + STG;
        const u16* cB = cA + 128 * 72;
#pragma unroll
        for (int ks = 0; ks < 4; ++ks) {
          bf16x8 af[2], bfr[2];
#pragma unroll
          for (int i = 0; i < 2; ++i) {
            af[i] = *(const bf16x8*)(cA + (wm * 64 + i * 32 + r) * 72 + ks * 16 + h * 8);
            bfr[i] = *(const bf16x8*)(cB + (wn * 64 + i * 32 + r) * 72 + ks * 16 + h * 8);
          }
#pragma unroll
          for (int i = 0; i < 2; ++i)
#pragma unroll
            for (int j = 0; j < 2; ++j) acc[i][j] = MFMA(af[i], bfr[j], acc[i][j]);
        }
      }
      if (k0 + 2 < nk) {
        u16* nA = sAB;
#pragma unroll
        for (int i = 0; i < 4; ++i) {
          *(u32x4*)(nA + (lrow + 32 * i) * 72 + lkc * 8) = ra0[i];
          *(u32x4*)(nA + 128 * 72 + (lrow + 32 * i) * 72 + lkc * 8) = rb0[i];
        }
        __syncthreads();
      }
    }
#pragma unroll
    for (int i = 0; i < 2; ++i)
#pragma unroll
      for (int j = 0; j < 2; ++j) {
        const int n = nt * 128 + wn * 64 + j * 32 + r;
        if (n < ea.N) {
#pragma unroll
          for (int reg = 0; reg < 16; ++reg) {
            const int m = mt * 128 + wm * 64 + i * 32 + crow(reg, h);
            const float v = acc[i][j][reg];
            if (EPI == 0) {
              ((u16*)ea.C)[(long)m * ea.ldc + n] = f2bf(v);
            } else if (EPI == 1) {
              ((float*)ea.C)[(long)m * ea.ldc + n] = v;
            } else {
              const int bi = (m < TL) ? (m >> 11) : 8;
              const float g = ea.g[bi * 6144 + n];
              float* dst = (float*)ea.C + (long)m * 1024 + n;
              float base;
              if (EPI == 2) base = (m < TL) ? ea.xin_lat[(long)m * 1024 + n] : ea.xin_ctx[(long)(m - TL) * 1024 + n];
              else base = *dst;
              *dst = base + g * v;
            }
          }
        }
      }
  }
}

DI void gemm_pq_scores(char* smem, const u16* __restrict__ A, const u16* __restrict__ Wt, const u16* __restrict__ KEYS, float* __restrict__ SC, int MT) {
  constexpr int lda = 1024, acs = 0, K = 1024, NT = 16, rot = 0;
  u16* sAB = (u16*)smem;
  constexpr int STG = 2 * 128 * 72;
  const int tid = threadIdx.x, lane = tid & 63, w = tid >> 6, r = lane & 31, h = lane >> 5;
  const int wm = w >> 1, wn = w & 1;
  const int nslot = gridDim.x >> 3, xcd = blockIdx.x & 7;
  int first = ((int)(blockIdx.x >> 3) - rot) % nslot;
  if (first < 0) first += nslot;
  const int lrow = tid >> 3, lkc = tid & 7;
  const int per_xcd = (MT >> 3) * NT;
  for (int t = first; t < per_xcd; t += nslot) {
    const int mt = xcd + 8 * (t / NT), nt = t % NT;
    const u16* Ab = A + (long)(mt * 128 + lrow) * lda + nt * acs + lkc * 8;
    const u16* Bb = Wt + (long)(nt * 128 + lrow) * K + lkc * 8;
    f32x16 acc[2][2];
#pragma unroll
    for (int i = 0; i < 2; ++i)
#pragma unroll
      for (int j = 0; j < 2; ++j) acc[i][j] = zero16();
    u32x4 ra0[4], rb0[4], ra1[4], rb1[4];
    const int nk = K >> 6;
#pragma unroll
    for (int i = 0; i < 4; ++i) {
      ra0[i] = *(const u32x4*)(Ab + (long)(32 * i) * lda);
      rb0[i] = *(const u32x4*)(Bb + (long)(32 * i) * K);
    }
#pragma unroll
    for (int i = 0; i < 4; ++i) {
      ra1[i] = *(const u32x4*)(Ab + (long)(32 * i) * lda + 64);
      rb1[i] = *(const u32x4*)(Bb + (long)(32 * i) * K + 64);
    }
    __syncthreads();
#pragma unroll
    for (int i = 0; i < 4; ++i) {
      *(u32x4*)(sAB + (lrow + 32 * i) * 72 + lkc * 8) = ra0[i];
      *(u32x4*)(sAB + 128 * 72 + (lrow + 32 * i) * 72 + lkc * 8) = rb0[i];
    }
    __syncthreads();
    for (int k0 = 0; k0 < nk; k0 += 2) {
      if (k0 + 2 < nk) {
#pragma unroll
        for (int i = 0; i < 4; ++i) {
          ra0[i] = *(const u32x4*)(Ab + (long)(32 * i) * lda + (k0 + 2) * 64);
          rb0[i] = *(const u32x4*)(Bb + (long)(32 * i) * K + (k0 + 2) * 64);
        }
      }
      {
        const u16* cA = sAB;
        const u16* cB = cA + 128 * 72;
#pragma unroll
        for (int ks = 0; ks < 4; ++ks) {
          bf16x8 af[2], bfr[2];
#pragma unroll
          for (int i = 0; i < 2; ++i) {
            af[i] = *(const bf16x8*)(cA + (wm * 64 + i * 32 + r) * 72 + ks * 16 + h * 8);
            bfr[i] = *(const bf16x8*)(cB + (wn * 64 + i * 32 + r) * 72 + ks * 16 + h * 8);
          }
#pragma unroll
          for (int i = 0; i < 2; ++i)
#pragma unroll
            for (int j = 0; j < 2; ++j) acc[i][j] = MFMA(bfr[j], af[i], acc[i][j]);
        }
      }
      {
        u16* nA = sAB + STG;
#pragma unroll
        for (int i = 0; i < 4; ++i) {
          *(u32x4*)(nA + (lrow + 32 * i) * 72 + lkc * 8) = ra1[i];
          *(u32x4*)(nA + 128 * 72 + (lrow + 32 * i) * 72 + lkc * 8) = rb1[i];
        }
        __syncthreads();
      }
      if (k0 + 3 < nk) {
#pragma unroll
        for (int i = 0; i < 4; ++i) {
          ra1[i] = *(const u32x4*)(Ab + (long)(32 * i) * lda + (k0 + 3) * 64);
          rb1[i] = *(const u32x4*)(Bb + (long)(32 * i) * K + (k0 + 3) * 64);
        }
      }
      {
        const u16* cA = sAB + STG;
        const u16* cB = cA + 128 * 72;
#pragma unroll
        for (int ks = 0; ks < 4; ++ks) {
          bf16x8 af[2], bfr[2];
#pragma unroll
          for (int i = 0; i < 2; ++i) {
            af[i] = *(const bf16x8*)(cA + (wm * 64 + i * 32 + r) * 72 + ks * 16 + h * 8);
            bfr[i] = *(const bf16x8*)(cB + (wn * 64 + i * 32 + r) * 72 + ks * 16 + h * 8);
          }
#pragma unroll
          for (int i = 0; i < 2; ++i)
#pragma unroll
            for (int j = 0; j < 2; ++j) acc[i][j] = MFMA(bfr[j], af[i], acc[i][j]);
        }
      }
      if (k0 + 2 < nk) {
        u16* nA = sAB;
#pragma unroll
        for (int i = 0; i < 4; ++i) {
          *(u32x4*)(nA + (lrow + 32 * i) * 72 + lkc * 8) = ra0[i];
          *(u32x4*)(nA + 128 * 72 + (lrow + 32 * i) * 72 + lkc * 8) = rb0[i];
        }
        __syncthreads();
      }
    }
    u16* sQ = (u16*)smem;
    u16* sKy = sQ + 128 * 136;
    u32x4 kreg[8];
    {
      const u16* kp = KEYS + (long)nt * 128 * 128;
#pragma unroll
      for (int i = 0; i < 8; ++i) { const int c = tid + i * 256; kreg[i] = *(const u32x4*)(kp + (long)(c >> 4) * 128 + (c & 15) * 8); }
    }
    __syncthreads();
#pragma unroll
    for (int i = 0; i < 2; ++i)
#pragma unroll
      for (int j = 0; j < 2; ++j)
#pragma unroll
        for (int g = 0; g < 4; ++g) {
          u32x2 o = {pack2(acc[i][j][4 * g], acc[i][j][4 * g + 1]), pack2(acc[i][j][4 * g + 2], acc[i][j][4 * g + 3])};
          *(u32x2*)(sQ + (wm * 64 + i * 32 + r) * 136 + wn * 64 + j * 32 + 8 * g + 4 * h) = o;
        }
#pragma unroll
    for (int i = 0; i < 8; ++i) { const int c = tid + i * 256; *(u32x4*)(sKy + (c >> 4) * 136 + (c & 15) * 8) = kreg[i]; }
    __syncthreads();
#pragma unroll
    for (int i = 0; i < 2; ++i)
#pragma unroll
      for (int j = 0; j < 2; ++j) acc[i][j] = zero16();
#pragma unroll
    for (int ks = 0; ks < 8; ++ks) {
      bf16x8 af[2], bfr[2];
#pragma unroll
      for (int i = 0; i < 2; ++i) {
        af[i] = *(const bf16x8*)(sQ + (wm * 64 + i * 32 + r) * 136 + ks * 16 + h * 8);
        bfr[i] = *(const bf16x8*)(sKy + (wn * 64 + i * 32 + r) * 136 + ks * 16 + h * 8);
      }
#pragma unroll
      for (int i = 0; i < 2; ++i)
#pragma unroll
        for (int j = 0; j < 2; ++j) acc[i][j] = MFMA(af[i], bfr[j], acc[i][j]);
    }
#pragma unroll
    for (int i = 0; i < 2; ++i)
#pragma unroll
      for (int j = 0; j < 2; ++j) {
        const int n = nt * 128 + wn * 64 + j * 32 + r;
#pragma unroll
        for (int reg = 0; reg < 16; ++reg) {
          const int m = mt * 128 + wm * 64 + i * 32 + crow(reg, h);
          SC[(long)m * 2048 + n] = acc[i][j][reg];
        }
      }
  }
}

DI float rope64(float y, int lane, int prow, int pcol, const float* __restrict__ R16) {
  const float partner = __shfl_xor(y, 16);
  const int pos = (lane < 32) ? prow : pcol;
  const f32x2 cs = *(const f32x2*)(R16 + (pos * 16 + (lane & 15)) * 2);
  return (lane & 16) ? (y * cs.x + partner * cs.y) : (y * cs.x - partner * cs.y);
}
DI float rope32(float y, int lane, int prow, int pcol, const float* __restrict__ R8) {
  const float partner = __shfl_xor(y, 8);
  const int pp = lane & 31;
  const int pos = (pp < 16) ? prow : pcol;
  const f32x2 cs = *(const f32x2*)(R8 + (pos * 8 + (pp & 7)) * 2);
  return (pp & 8) ? (y * cs.x + partner * cs.y) : (y * cs.x - partner * cs.y);
}

template <int CTRL>
DI float dppf(float v) { return __builtin_bit_cast(float, __builtin_amdgcn_update_dpp(0, __builtin_bit_cast(int, v), CTRL, 0xf, 0xf, false)); }
DI void unpack8(u32x4 r, float* x) {
#pragma unroll
  for (int q = 0; q < 4; ++q) { x[2 * q] = bflo(r[q]); x[2 * q + 1] = bfhi(r[q]); }
}
DI u32x4 pack8f(const float* y) { u32x4 o = {pack2(y[0], y[1]), pack2(y[2], y[3]), pack2(y[4], y[5]), pack2(y[6], y[7])}; return o; }
DI float sumsq8(const float* x) { float s = 0.f;
#pragma unroll
  for (int j = 0; j < 8; ++j) s += x[j] * x[j];
  return s; }
DI float sum_group8(float v) { v += dppf<0xB1>(v); v += dppf<0x4E>(v); v += dppf<0x141>(v); return v; }
DI void rope_head64(float* y, int cc8, const float* cs) {
  const bool second = (cc8 & 2) != 0;
#pragma unroll
  for (int j = 0; j < 8; ++j) {
    const float pr = dppf<0x4E>(y[j]);
    y[j] = second ? (y[j] * cs[2 * j] + pr * cs[2 * j + 1]) : (y[j] * cs[2 * j] - pr * cs[2 * j + 1]);
  }
}
DI void load_cs8(const float* tab, float* cs) {
#pragma unroll
  for (int q = 0; q < 4; ++q) { const f32x4 t = *(const f32x4*)(tab + q * 4); cs[4 * q] = t.x; cs[4 * q + 1] = t.y; cs[4 * q + 2] = t.z; cs[4 * q + 3] = t.w; }
}
DI void load_w8(const float* wsrc, float* wv) {
  const f32x4 a = *(const f32x4*)wsrc, b = *(const f32x4*)(wsrc + 4);
  wv[0] = a.x; wv[1] = a.y; wv[2] = a.z; wv[3] = a.w; wv[4] = b.x; wv[5] = b.y; wv[6] = b.z; wv[7] = b.w;
}
DI void phase_post0a(const Params& p) {
  const int lane = threadIdx.x & 63, w = threadIdx.x >> 6, cc8 = lane & 7;
  float wq[8], wk[8], wl[8];
  load_w8(p.a_q_norm + cc8 * 8, wq);
  load_w8(p.a_k_norm + cc8 * 8, wk);
  load_w8((lane < 32 ? p.b_kv_lora_norm : p.b_q_lora_norm) + (lane & 31) * 8, wl);
  const int offB = (lane < 32) ? 512 + (lane & 15) * 8 : 768 + (lane - 32) * 8;
  const int stride = gridDim.x * 4;
  int m = blockIdx.x * 4 + w;
  u32x4 rA, rB, rC, nA, nB, nC;
  if (m < TA) {
    const u16* z0 = p.Z + (long)m * 1312;
    rA = *(const u32x4*)(z0 + lane * 8); rB = *(const u32x4*)(z0 + offB); rC = *(const u32x4*)(z0 + 1024 + (lane & 31) * 8);
  }
  for (; m < TA; m += stride) {
    u16* z = p.Z + (long)m * 1312;
    const bool lat = m < TL;
    const int s = m & 2047, prow = s >> 6, pcol = s & 63;
    if (m + stride < TA) {
      const u16* zn = p.Z + (long)(m + stride) * 1312;
      nA = *(const u32x4*)(zn + lane * 8); nB = *(const u32x4*)(zn + offB); nC = *(const u32x4*)(zn + 1024 + (lane & 31) * 8);
    }
    float cs[16];
    load_cs8(p.ROPE16 + ((((cc8 < 4) ? prow : pcol) * 16 + (cc8 & 1) * 8) * 2), cs);
    float x[8];
    {
      unpack8(rA, x);
      const float rstd = rsqrtf(sum_group8(sumsq8(x)) * (1.f / 64.f) + EPSF);
#pragma unroll
      for (int j = 0; j < 8; ++j) x[j] *= rstd * wq[j] * (0.125f * LOG2E);
      if (lat) rope_head64(x, cc8, cs);
      *(u32x4*)(z + lane * 8) = pack8f(x);
    }
    {
      unpack8(rB, x);
      const float ssq = sumsq8(x);
      const float g8 = sum_group8(ssq);
      const float r16 = rowsum16(ssq);
      const int ir = __builtin_bit_cast(int, r16);
      const float t256 = __builtin_bit_cast(float, __builtin_amdgcn_readlane(ir, 32)) + __builtin_bit_cast(float, __builtin_amdgcn_readlane(ir, 48));
      if (lane < 32) {
        const float rstd = rsqrtf(g8 * (1.f / 64.f) + EPSF);
#pragma unroll
        for (int j = 0; j < 8; ++j) x[j] *= rstd * wk[j];
      } else {
        const float rstd = rsqrtf(t256 * (1.f / 256.f) + EPSF);
#pragma unroll
        for (int j = 0; j < 8; ++j) x[j] *= rstd * wl[j];
      }
      float xr[8];
#pragma unroll
      for (int j = 0; j < 8; ++j) xr[j] = x[j];
      rope_head64(xr, cc8, cs);
      if (lat && lane < 16) {
#pragma unroll
        for (int j = 0; j < 8; ++j) x[j] = xr[j];
      }
      if (lane < 16 || lane >= 32) *(u32x4*)(z + offB) = pack8f(x);
    }
    {
      unpack8(rC, x);
      const float r16 = rowsum16(sumsq8(x));
      const int ir = __builtin_bit_cast(int, r16);
      const float t256 = __builtin_bit_cast(float, __builtin_amdgcn_readlane(ir, 0)) + __builtin_bit_cast(float, __builtin_amdgcn_readlane(ir, 16));
      const float rstd = rsqrtf(t256 * (1.f / 256.f) + EPSF);
#pragma unroll
      for (int j = 0; j < 8; ++j) x[j] *= rstd * wl[j];
      if (lane < 32) *(u32x4*)(z + 1024 + lane * 8) = pack8f(x);
    }
    rA = nA; rB = nB; rC = nC;
  }
}
DI void rope_tail96(float* y, int c16, const float* cs) {
  const bool second = (c16 & 1) != 0;
#pragma unroll
  for (int j = 0; j < 8; ++j) {
    const float pr = dppf<0xB1>(y[j]);
    const float rz = second ? (y[j] * cs[2 * j] + pr * cs[2 * j + 1]) : (y[j] * cs[2 * j] - pr * cs[2 * j + 1]);
    y[j] = (c16 >= 8) ? rz : y[j];
  }
}
DI void phase_post0b(const Params& p) {
  const int lane = threadIdx.x & 63, w = threadIdx.x >> 6, c16 = lane & 15, hr = lane >> 4;
  const bool act = c16 < 12;
  float wq[8], wk[8];
  load_w8(p.b_q_norm + (act ? c16 : 0) * 8, wq);
  load_w8(p.b_k_norm + (act ? c16 : 0) * 8, wk);
  for (int m = blockIdx.x * 4 + w; m < TA; m += gridDim.x * 4) {
    const bool lat = m < TL;
    const int s = m & 2047, prow = s >> 6, pcol = s & 63;
    u16* q = p.QB + (long)m * 768;
    const u16* kv = p.KVR + (long)m * 1024;
    u16* kb = p.KB + (long)m * 768;
    u16* vb = p.VB + (long)m * 512;
    const u16* kr = p.Z + (long)m * 1312 + 1280;
    const u32x4 zero4 = {0u, 0u, 0u, 0u};
    u32x4 rq[2], rk[2];
#pragma unroll
    for (int ps = 0; ps < 2; ++ps) {
      const int hd = ps * 4 + hr;
      rq[ps] = act ? *(const u32x4*)(q + hd * 96 + c16 * 8) : zero4;
      rk[ps] = act ? ((c16 < 8) ? *(const u32x4*)(kv + hd * 128 + c16 * 8) : *(const u32x4*)(kr + (c16 - 8) * 8)) : zero4;
    }
    const u32x4 rv = *(const u32x4*)(kv + (lane >> 3) * 128 + 64 + (lane & 7) * 8);
    float cs[16];
    load_cs8(p.ROPE8 + ((((c16 < 10) ? prow : pcol) * 8) * 2), cs);
    float x[8];
#pragma unroll
    for (int ps = 0; ps < 2; ++ps) {
      const int hd = ps * 4 + hr;
      unpack8(rq[ps], x);
      float rstd = rsqrtf(rowsum16(sumsq8(x)) * (1.f / 96.f) + EPSF);
#pragma unroll
      for (int j = 0; j < 8; ++j) x[j] *= rstd * wq[j] * (0.10206207261596575f * LOG2E);
      if (lat) rope_tail96(x, c16, cs);
      if (act) *(u32x4*)(q + hd * 96 + c16 * 8) = pack8f(x);
      unpack8(rk[ps], x);
      rstd = rsqrtf(rowsum16(sumsq8(x)) * (1.f / 96.f) + EPSF);
#pragma unroll
      for (int j = 0; j < 8; ++j) x[j] *= rstd * wk[j];
      if (lat) rope_tail96(x, c16, cs);
      if (act) *(u32x4*)(kb + hd * 96 + c16 * 8) = pack8f(x);
    }
    *(u32x4*)(vb + lane * 8) = rv;
  }
}
DI void phase_post1(const Params& p) {
  const int lane = threadIdx.x & 63, w = threadIdx.x >> 6, cc8 = lane & 7;
  float wq[8], wk[8];
  load_w8(p.d_q_norm + cc8 * 8, wq);
  load_w8(p.d_k_norm + cc8 * 8, wk);
  const int stride = gridDim.x * 4;
  int m = blockIdx.x * 4 + w;
  u32x4 rA, rB, rC, nA, nB, nC;
  if (m < TA) {
    const u16* z0 = p.Z + (long)m * 2304;
    rA = *(const u32x4*)(z0 + lane * 8); rB = *(const u32x4*)(z0 + 1536 + lane * 8); rC = *(const u32x4*)(z0 + 2048 + (lane & 15) * 8);
  }
  for (; m < TA; m += stride) {
    u16* z = p.Z + (long)m * 2304;
    const bool lat = m < TL;
    const int s = m & 2047, prow = s >> 6, pcol = s & 63;
    if (m + stride < TA) {
      const u16* zn = p.Z + (long)(m + stride) * 2304;
      nA = *(const u32x4*)(zn + lane * 8); nB = *(const u32x4*)(zn + 1536 + lane * 8); nC = *(const u32x4*)(zn + 2048 + (lane & 15) * 8);
    }
    float cs[16];
    load_cs8(p.ROPE16 + ((((cc8 < 4) ? prow : pcol) * 16 + (cc8 & 1) * 8) * 2), cs);
    float x[8];
    {
      unpack8(rA, x);
      const float sc = (lane >= 32) ? 0.125f : 1.f;
#pragma unroll
      for (int j = 0; j < 8; ++j) x[j] *= sc;
      if (lat) rope_head64(x, cc8, cs);
      if (lat || lane >= 32) *(u32x4*)(z + lane * 8) = pack8f(x);
    }
    {
      unpack8(rB, x);
      const float rstd = rsqrtf(sum_group8(sumsq8(x)) * (1.f / 64.f) + EPSF);
#pragma unroll
      for (int j = 0; j < 8; ++j) x[j] *= rstd * wq[j] * (0.125f * LOG2E);
      if (lat) rope_head64(x, cc8, cs);
      *(u32x4*)(z + 1536 + lane * 8) = pack8f(x);
    }
    {
      unpack8(rC, x);
      const float rstd = rsqrtf(sum_group8(sumsq8(x)) * (1.f / 64.f) + EPSF);
#pragma unroll
      for (int j = 0; j < 8; ++j) x[j] *= rstd * wk[j];
      if (lat) rope_head64(x, cc8, cs);
      if (lane < 16) *(u32x4*)(z + 2048 + lane * 8) = pack8f(x);
    }
    rA = nA; rB = nB; rC = nC;
  }
}

template <int DQK>
DI void attn_item(char* smem, const u16* __restrict__ Qp, int qs, const u16* __restrict__ K0, const u16* __restrict__ V0,
                  int ks0, int vs0, int n0, const u16* __restrict__ K1, const u16* __restrict__ V1, int ks1, int vs1, int kbeg,
                  int kend, bool band, int qpos0, float scale, bool has_sink, float sink, u16* __restrict__ Op, int os) {
  constexpr int KSTR = DQK + 8, VROW = 96, KCH = DQK / 8, NKL = (64 * KCH) / 256;
  constexpr int NKS = DQK / 16;
  u16* sK = (u16*)smem;
  u16* sV = sK + 64 * KSTR;
  const int tid = threadIdx.x, lane = tid & 63, w = tid >> 6, r = lane & 31, h = lane >> 5;
  bf16x8 qf[NKS];
#pragma unroll
  for (int ks = 0; ks < NKS; ++ks) qf[ks] = *(const bf16x8*)(Qp + (long)(w * 32 + r) * qs + ks * 16 + h * 8);
  f32x16 oT[2];
  oT[0] = zero16(); oT[1] = zero16();
  (void)scale;
  float mrun = has_sink ? sink * LOG2E : -1e30f;
  float lrun = (has_sink && h == 0) ? 1.f : 0.f;
  const int nt0 = n0 >> 6, nt1 = (kend - kbeg) >> 6, ntot = nt0 + nt1;
  const int qpos = qpos0 + w * 32 + r;
  u32x4 rk[NKL], rv[2];
  auto tile_ptrs = [&](int t, const u16*& kp, const u16*& vp, int& kst, int& vst) {
    if (t < nt0) { kp = K0 + (long)(t * 64) * ks0; vp = V0 + (long)(t * 64) * vs0; kst = ks0; vst = vs0; }
    else { const int k0 = kbeg + (t - nt0) * 64; kp = K1 + (long)k0 * ks1; vp = V1 + (long)k0 * vs1; kst = ks1; vst = vs1; }
  };
  {
    const u16 *kp, *vp; int kst, vst;
    tile_ptrs(0, kp, vp, kst, vst);
#pragma unroll
    for (int i = 0; i < NKL; ++i) { const int c = tid + i * 256, key = c / KCH, kc = c % KCH; rk[i] = *(const u32x4*)(kp + (long)key * kst + kc * 8); }
#pragma unroll
    for (int i = 0; i < 2; ++i) { const int c = tid + i * 256, key = c >> 3, dc = c & 7; rv[i] = *(const u32x4*)(vp + (long)key * vst + dc * 8); }
  }
  for (int t = 0; t < ntot; ++t) {
    __syncthreads();
#pragma unroll
    for (int i = 0; i < NKL; ++i) { const int c = tid + i * 256, key = c / KCH, kc = c % KCH; *(u32x4*)(sK + key * KSTR + kc * 8) = rk[i]; }
#pragma unroll
    for (int i = 0; i < 2; ++i) { const int c = tid + i * 256, key = c >> 3, dc = c & 7; *(u32x4*)(sV + key * VROW + dc * 8) = rv[i]; }
    __syncthreads();
    if (t + 1 < ntot) {
      const u16 *kp, *vp; int kst, vst;
      tile_ptrs(t + 1, kp, vp, kst, vst);
#pragma unroll
      for (int i = 0; i < NKL; ++i) { const int c = tid + i * 256, key = c / KCH, kc = c % KCH; rk[i] = *(const u32x4*)(kp + (long)key * kst + kc * 8); }
#pragma unroll
      for (int i = 0; i < 2; ++i) { const int c = tid + i * 256, key = c >> 3, dc = c & 7; rv[i] = *(const u32x4*)(vp + (long)key * vst + dc * 8); }
    }
    f32x16 sT[2];
    sT[0] = zero16(); sT[1] = zero16();
#pragma unroll
    for (int kt = 0; kt < 2; ++kt)
#pragma unroll
      for (int ks = 0; ks < NKS; ++ks) {
        const bf16x8 kf = *(const bf16x8*)(sK + (kt * 32 + r) * KSTR + ks * 16 + h * 8);
        sT[kt] = MFMA(kf, qf[ks], sT[kt]);
      }
    const bool masked = band && (t >= nt0);
    const int kbase = kbeg + (t - nt0) * 64;
    float mx = -1e30f;
#pragma unroll
    for (int kt = 0; kt < 2; ++kt)
#pragma unroll
      for (int reg = 0; reg < 16; ++reg) {
        float sv = sT[kt][reg];
        if (masked) {
          const int kpos = kbase + kt * 32 + crow(reg, h);
          const int d = qpos - kpos;
          if (d > 128 || d < -128) sv = -1e30f;
        }
        sT[kt][reg] = sv;
        mx = fmaxf(mx, sv);
      }
    mx = fmaxf(mx, __shfl_xor(mx, 32));
    const float mnew = fmaxf(mrun, mx);
    const float alpha = ex2(mrun - mnew);
    mrun = mnew;
    float ps = 0.f;
#pragma unroll
    for (int kt = 0; kt < 2; ++kt)
#pragma unroll
      for (int reg = 0; reg < 16; ++reg) {
        const float pv = ex2(sT[kt][reg] - mnew);
        sT[kt][reg] = pv;
        ps += pv;
      }
    lrun = lrun * alpha + ps;
#pragma unroll
    for (int dt = 0; dt < 2; ++dt)
#pragma unroll
      for (int reg = 0; reg < 16; ++reg) oT[dt][reg] *= alpha;
#pragma unroll
    for (int kt = 0; kt < 2; ++kt)
#pragma unroll
      for (int s = 0; s < 2; ++s) {
        const bf16x8 pf = pack8(sT[kt], s);
#pragma unroll
        for (int dt = 0; dt < 2; ++dt) {
          const u16* vb0 = sV + (kt * 32 + s * 16 + 4 * h + ((lane & 15) >> 2)) * VROW + dt * 32 + ((lane >> 4) & 1) * 16 + (lane & 3) * 4;
          const s16x4 lo4 = __builtin_amdgcn_ds_read_tr16_b64_v4i16((LDS3 s16x4*)vb0);
          const s16x4 hi4 = __builtin_amdgcn_ds_read_tr16_b64_v4i16((LDS3 s16x4*)(vb0 + 8 * VROW));
          const bf16x8 vf = __builtin_shufflevector(lo4, hi4, 0, 1, 2, 3, 4, 5, 6, 7);
          oT[dt] = MFMA(vf, pf, oT[dt]);
        }
      }
  }
  const float ltot = lrun + __shfl_xor(lrun, 32);
  const float inv = 1.f / ltot;
#pragma unroll
  for (int dt = 0; dt < 2; ++dt)
#pragma unroll
    for (int g = 0; g < 4; ++g) {
      u32x2 o = {pack2(oT[dt][4 * g] * inv, oT[dt][4 * g + 1] * inv), pack2(oT[dt][4 * g + 2] * inv, oT[dt][4 * g + 3] * inv)};
      *(u32x2*)(Op + (long)(w * 32 + r) * os + dt * 32 + 8 * g + 4 * h) = o;
    }
}

DI void phase_attn0(const Params& p, char* smem) {
  const float sc96 = 0.10206207261596575f;
  for (int id = blockIdx.x; id < 2304; id += gridDim.x) {
    if (id < 1024) {
      const int b = id >> 7, hd = (id >> 4) & 7, qb = id & 15;
      const long qrow = (long)b * 2048 + qb * 128, crw = (long)TL + b * 256, lrow = (long)b * 2048;
      attn_item<96>(smem, p.QB + qrow * 768 + hd * 96, 768, p.KB + crw * 768 + hd * 96, p.VB + crw * 512 + hd * 64, 768, 512, 256,
                    p.KB + lrow * 768 + hd * 96, p.VB + lrow * 512 + hd * 64, 768, 512, 0, 2048, false, 0, sc96, false, 0.f,
                    p.AO + qrow * 1024 + 512 + hd * 64, 1024);
    } else if (id < 2048) {
      const int i2 = id - 1024;
      const int b = i2 >> 7, hd = (i2 >> 4) & 7, qb = i2 & 15, kvh = hd >> 2;
      const long qrow = (long)b * 2048 + qb * 128, crw = (long)TL + b * 256, lrow = (long)b * 2048;
      const int kbeg = (qb * 128 - 128) < 0 ? 0 : (qb * 128 - 128);
      const int kend = (qb * 128 + 256) > 2048 ? 2048 : (qb * 128 + 256);
      attn_item<64>(smem, p.Z + qrow * 1312 + hd * 64, 1312, p.Z + crw * 1312 + 512 + kvh * 64, p.Z + crw * 1312 + 640 + kvh * 64, 1312,
                    1312, 256, p.Z + lrow * 1312 + 512 + kvh * 64, p.Z + lrow * 1312 + 640 + kvh * 64, 1312, 1312, kbeg, kend, true,
                    qb * 128, 0.125f, true, p.a_sink[hd], p.AO + qrow * 1024 + hd * 64, 1024);
    } else if (id < 2176) {
      const int i2 = id - 2048;
      const int b = i2 >> 4, hd = (i2 >> 1) & 7, qb = i2 & 1, kvh = hd >> 2;
      const long qrow = (long)TL + b * 256 + qb * 128, crw = (long)TL + b * 256;
      attn_item<64>(smem, p.Z + qrow * 1312 + hd * 64, 1312, p.Z + crw * 1312 + 512 + kvh * 64, p.Z + crw * 1312 + 640 + kvh * 64, 1312,
                    1312, 256, p.Z, p.Z, 1312, 1312, 0, 0, false, 0, 0.125f, true, p.a_sink[hd], p.AO + qrow * 1024 + hd * 64, 1024);
    } else {
      const int i2 = id - 2176;
      const int b = i2 >> 4, hd = (i2 >> 1) & 7, qb = i2 & 1;
      const long qrow = (long)TL + b * 256 + qb * 128, crw = (long)TL + b * 256;
      attn_item<96>(smem, p.QB + qrow * 768 + hd * 96, 768, p.KB + crw * 768 + hd * 96, p.VB + crw * 512 + hd * 64, 768, 512, 256,
                    p.KB, p.VB, 768, 512, 0, 0, false, 0, sc96, false, 0.f, p.AO + qrow * 1024 + 512 + hd * 64, 1024);
    }
  }
}

DI long ret_row(int b, int dir, int c, int pp) {
  const int q = (c < 2) ? c * 128 + pp : (c - 2) * 128 + pp;
  if (c < 2) return (long)TL + b * 256 + (dir ? 255 - q : q);
  return (long)b * 2048 + (dir ? 2047 - q : q);
}
DI void ret_local_item(const Params& p, char* smem, int id) {
  const int c = id % 18, dir = (id / 18) & 1, hh = (id / 36) & 3, b = id / 144;
  u16* sK = (u16*)smem;
  u16* sV = sK + 128 * 64;
  float* sW = (float*)(sV + 128 * 128);
  const int tid = threadIdx.x;
  const float lg = log_sigmoid((dir ? p.c_decay_bwd : p.c_decay_fwd)[hh]);
  __syncthreads();
  for (int i = tid; i < 128 * 8; i += 256) {
    const int pp = i >> 3, ch = i & 7;
    const long row = ret_row(b, dir, c, pp);
    *(u32x4*)(sK + pp * 64 + ch * 8) = *(const u32x4*)(p.Z + row * 2304 + 256 + hh * 64 + ch * 8);
  }
  for (int i = tid; i < 128 * 16; i += 256) {
    const int pp = i >> 4, ch = i & 15;
    const long row = ret_row(b, dir, c, pp);
    *(u32x4*)(sV + pp * 128 + ch * 8) = *(const u32x4*)(p.Z + row * 2304 + 512 + hh * 128 + ch * 8);
  }
  if (tid < 128) sW[tid] = __expf(lg * (float)(127 - tid));
  __syncthreads();
  const int d = tid >> 2, vq = tid & 3;
  float acc[32];
#pragma unroll
  for (int j = 0; j < 32; ++j) acc[j] = 0.f;
  for (int pp = 0; pp < 128; ++pp) {
    const float kv = bf2f(sK[pp * 64 + d]) * sW[pp];
#pragma unroll
    for (int q = 0; q < 4; ++q) {
      const u32x4 vv = *(const u32x4*)(sV + pp * 128 + vq * 32 + q * 8);
      acc[q * 8 + 0] += kv * bflo(vv.x); acc[q * 8 + 1] += kv * bfhi(vv.x);
      acc[q * 8 + 2] += kv * bflo(vv.y); acc[q * 8 + 3] += kv * bfhi(vv.y);
      acc[q * 8 + 4] += kv * bflo(vv.z); acc[q * 8 + 5] += kv * bfhi(vv.z);
      acc[q * 8 + 6] += kv * bflo(vv.w); acc[q * 8 + 7] += kv * bfhi(vv.w);
    }
  }
  u16* dst = (u16*)p.LST + (long)id * 8192 + d * 128 + vq * 32;
#pragma unroll
  for (int q = 0; q < 4; ++q) *(u32x4*)(dst + q * 8) = pack8f(acc + q * 8);
}

DI void phase_attn1(const Params& p, char* smem) {
  for (int id = blockIdx.x; id < 1024 + 1152; id += gridDim.x) {
    if (id < 1024) {
      const int b = id >> 7, hd = (id >> 4) & 7, qb = id & 15, kvh = hd >> 2;
      const long qrow = (long)b * 2048 + qb * 128, crw = (long)TL + b * 256, lrow = (long)b * 2048;
      attn_item<64>(smem, p.Z + qrow * 2304 + 1536 + hd * 64, 2304, p.Z + crw * 2304 + 2048 + kvh * 64, p.Z + crw * 2304 + 2176 + kvh * 64,
                    2304, 2304, 256, p.Z + lrow * 2304 + 2048 + kvh * 64, p.Z + lrow * 2304 + 2176 + kvh * 64, 2304, 2304, 0, 2048, false, 0,
                    0.125f, false, 0.f, p.AO + qrow * 1024 + 512 + hd * 64, 1024);
    } else {
      ret_local_item(p, smem, id - 1024);
    }
  }
}

DI void ret_out_item(const Params& p, char* smem, int id) {
  const int c = id & 15, hh = (id >> 4) & 3, b = id >> 6;
  const int tid = threadIdx.x, lane = tid & 63, w = tid >> 6, r = lane & 31, h = lane >> 5;
  const float lgf = log_sigmoid(p.c_decay_fwd[hh]), lgb = log_sigmoid(p.c_decay_bwd[hh]);
  u16* sS = (u16*)smem;
  __syncthreads();
  {
    const int d = tid >> 2, vq = tid & 3;
#pragma unroll
    for (int dir = 0; dir < 2; ++dir) {
      const int cc = dir ? (17 - c) : (c + 2);
      const float lgG = (dir ? lgb : lgf) * 128.f;
      float acc[32];
#pragma unroll
      for (int j = 0; j < 32; ++j) acc[j] = 0.f;
#pragma unroll 8
      for (int c2 = 0; c2 < cc; ++c2) {
        const float coef = __expf(lgG * (float)(cc - 1 - c2));
        const u16* src = (const u16*)p.LST + ((long)(((b * 4 + hh) * 2 + dir) * 18 + c2)) * 8192 + d * 128 + vq * 32;
#pragma unroll
        for (int q = 0; q < 4; ++q) {
          const u32x4 v = *(const u32x4*)(src + q * 8);
          acc[q * 8] += coef * bflo(v.x); acc[q * 8 + 1] += coef * bfhi(v.x); acc[q * 8 + 2] += coef * bflo(v.y); acc[q * 8 + 3] += coef * bfhi(v.y);
          acc[q * 8 + 4] += coef * bflo(v.z); acc[q * 8 + 5] += coef * bfhi(v.z); acc[q * 8 + 6] += coef * bflo(v.w); acc[q * 8 + 7] += coef * bfhi(v.w);
        }
      }
#pragma unroll
      for (int j = 0; j < 32; ++j) sS[dir * 128 * 72 + (vq * 32 + j) * 72 + d] = f2bf(acc[j]);
    }
  }
  __syncthreads();
  const long qrow = (long)b * 2048 + c * 128 + w * 32 + r;
  const int qi = w * 32 + r;
  u32x4 qraw[4];
#pragma unroll
  for (int ks = 0; ks < 4; ++ks) qraw[ks] = *(const u32x4*)(p.Z + qrow * 2304 + hh * 64 + ks * 16 + h * 8);
  f32x16 oT[4];
#pragma unroll
  for (int vt = 0; vt < 4; ++vt) oT[vt] = zero16();
#pragma unroll 1
  for (int dir = 0; dir < 2; ++dir) {
    const float qd = dir ? __expf(lgb * (float)(128 - qi)) : __expf(lgf * (float)(qi + 1));
#pragma unroll
    for (int ks = 0; ks < 4; ++ks) {
      u32x4 sq;
      sq.x = pack2(bflo(qraw[ks].x) * qd, bfhi(qraw[ks].x) * qd);
      sq.y = pack2(bflo(qraw[ks].y) * qd, bfhi(qraw[ks].y) * qd);
      sq.z = pack2(bflo(qraw[ks].z) * qd, bfhi(qraw[ks].z) * qd);
      sq.w = pack2(bflo(qraw[ks].w) * qd, bfhi(qraw[ks].w) * qd);
      const bf16x8 qs8 = as_bf16x8(sq);
#pragma unroll
      for (int vt = 0; vt < 4; ++vt) {
        const bf16x8 sf = *(const bf16x8*)(sS + dir * 128 * 72 + (vt * 32 + r) * 72 + ks * 16 + h * 8);
        oT[vt] = MFMA(sf, qs8, oT[vt]);
      }
    }
  }
  __syncthreads();
  u16* sK = (u16*)smem;
  u16* sVt = sK + 128 * 72;
  const long crow0 = (long)b * 2048 + c * 128;
  for (int i = tid; i < 128 * 8; i += 256) {
    const int j = i >> 3, ch = i & 7;
    *(u32x4*)(sK + j * 72 + ch * 8) = *(const u32x4*)(p.Z + (crow0 + j) * 2304 + 256 + hh * 64 + ch * 8);
  }
  for (int i = tid; i < 128 * 16; i += 256) {
    const int j = i & 127, ch = i >> 7;
    const u32x4 vv = *(const u32x4*)(p.Z + (crow0 + j) * 2304 + 512 + hh * 128 + ch * 8);
    const unsigned ve[4] = {vv.x, vv.y, vv.z, vv.w};
#pragma unroll
    for (int q = 0; q < 4; ++q) {
      sVt[(ch * 8 + 2 * q) * 132 + j] = (u16)(ve[q] & 0xffffu);
      sVt[(ch * 8 + 2 * q + 1) * 132 + j] = (u16)(ve[q] >> 16);
    }
  }
  __syncthreads();
  const float l2f = lgf * LOG2E, l2b = lgb * LOG2E;
#pragma unroll 1
  for (int jt = 0; jt < 4; ++jt) {
    f32x16 sT = zero16();
#pragma unroll
    for (int ks = 0; ks < 4; ++ks) {
      const bf16x8 kf = *(const bf16x8*)(sK + (jt * 32 + r) * 72 + ks * 16 + h * 8);
      sT = MFMA(kf, as_bf16x8(qraw[ks]), sT);
    }
#pragma unroll
    for (int reg = 0; reg < 16; ++reg) {
      const int j = jt * 32 + crow(reg, h);
      const int df = qi - j;
      const float dec = (df > 0) ? ex2(l2f * (float)df) : ((df < 0) ? ex2(l2b * (float)(-df)) : 2.f);
      sT[reg] *= dec;
    }
#pragma unroll
    for (int s = 0; s < 2; ++s) {
      const bf16x8 pf = pack8(sT, s);
#pragma unroll
      for (int vt = 0; vt < 4; ++vt) {
        const u16* vr = sVt + (vt * 32 + r) * 132 + jt * 32 + s * 16 + h * 4;
        const bf16x8 vf = join8(*(const u32x2*)vr, *(const u32x2*)(vr + 8));
        oT[vt] = MFMA(vf, pf, oT[vt]);
      }
    }
  }
  float sm = 0.f;
#pragma unroll
  for (int vt = 0; vt < 4; ++vt)
#pragma unroll
    for (int reg = 0; reg < 16; ++reg) sm += oT[vt][reg];
  sm += __shfl_xor(sm, 32);
  const float mu = sm * (1.f / 128.f);
  float sv = 0.f;
#pragma unroll
  for (int vt = 0; vt < 4; ++vt)
#pragma unroll
    for (int reg = 0; reg < 16; ++reg) { const float dd = oT[vt][reg] - mu; sv += dd * dd; }
  sv += __shfl_xor(sv, 32);
  const float rstd = rsqrtf(sv * (1.f / 128.f) + EPSF);
#pragma unroll
  for (int vt = 0; vt < 4; ++vt) {
    __builtin_amdgcn_sched_barrier(0);
#pragma unroll
    for (int g = 0; g < 4; ++g) {
      const int v0 = vt * 32 + 8 * g + 4 * h;
      const u32x2 graw = *(const u32x2*)(p.Z + qrow * 2304 + 1024 + hh * 128 + v0);
      const f32x4 gw = *(const f32x4*)(p.c_gn_w + hh * 128 + v0);
      const float y0 = silu(bflo(graw.x)) * (oT[vt][4 * g] - mu) * rstd * gw.x;
      const float y1 = silu(bfhi(graw.x)) * (oT[vt][4 * g + 1] - mu) * rstd * gw.y;
      const float y2 = silu(bflo(graw.y)) * (oT[vt][4 * g + 2] - mu) * rstd * gw.z;
      const float y3 = silu(bfhi(graw.y)) * (oT[vt][4 * g + 3] - mu) * rstd * gw.w;
      u32x2 o = {pack2(y0, y1), pack2(y2, y3)};
      *(u32x2*)(p.AO + qrow * 1024 + hh * 128 + v0) = o;
    }
  }
}

DI unsigned fkey(float f) {
  const unsigned u = __float_as_uint(f);
  return u ^ ((unsigned)((int)u >> 31) | 0x80000000u);
}
DI unsigned wmax_u32_fast(unsigned v) {
  unsigned t;
  t = (unsigned)__builtin_amdgcn_update_dpp(0, (int)v, 0x128, 0xf, 0xf, false); v = v > t ? v : t;
  t = (unsigned)__builtin_amdgcn_update_dpp(0, (int)v, 0x124, 0xf, 0xf, false); v = v > t ? v : t;
  t = (unsigned)__builtin_amdgcn_update_dpp(0, (int)v, 0x122, 0xf, 0xf, false); v = v > t ? v : t;
  t = (unsigned)__builtin_amdgcn_update_dpp(0, (int)v, 0x121, 0xf, 0xf, false); v = v > t ? v : t;
  const unsigned a = (unsigned)__builtin_amdgcn_readlane((int)v, 0), b = (unsigned)__builtin_amdgcn_readlane((int)v, 16);
  const unsigned c = (unsigned)__builtin_amdgcn_readlane((int)v, 32), d = (unsigned)__builtin_amdgcn_readlane((int)v, 48);
  const unsigned ab = a > b ? a : b, cd = c > d ? c : d;
  return ab > cd ? ab : cd;
}
DI float fkey_inv(unsigned k) { return __uint_as_float((k & 0x80000000u) ? (k ^ 0x80000000u) : ~k); }
DI int lane_rank(unsigned long long m) {
  return __builtin_amdgcn_mbcnt_hi((unsigned)(m >> 32), __builtin_amdgcn_mbcnt_lo((unsigned)m, 0u));
}
template <int G>
DI void topk_group(const float (&vin)[G][4], float* wbase, int* oidx, float* ogate) {
  const int lane = threadIdx.x & 63;
  {
    unsigned k[G][4];
    float v[G][4];
#pragma unroll
    for (int g = 0; g < G; ++g) {
#pragma unroll
      for (int q = 0; q < 4; ++q) { v[g][q] = vin[g][q]; k[g][q] = fkey(v[g][q]); }
    }
    unsigned T[G][2], Mk[G][2];
    int n[G][2];
#pragma unroll
    for (int g = 0; g < G; ++g)
#pragma unroll
      for (int part = 0; part < 2; ++part) {
        const unsigned ka = k[g][2 * part], kb = k[g][2 * part + 1];
        const unsigned M = wmax_u32_fast(ka > kb ? ka : kb);
        Mk[g][part] = M;
        unsigned P = M >> 23;
        unsigned Tc; int c;
        for (;;) {
          Tc = P << 23;
          c = __popcll(__ballot(ka >= Tc)) + __popcll(__ballot(kb >= Tc));
          if (c >= 16 || P == 0u) break;
          --P;
        }
        T[g][part] = Tc; n[g][part] = c;
      }
#pragma unroll 1
    for (int bit = 22; bit >= 0; --bit) {
      bool done = true;
#pragma unroll
      for (int g = 0; g < G; ++g) done = done && (n[g][0] == 16) && (n[g][1] == 16);
      if (done) break;
      const unsigned bm = 1u << bit;
#pragma unroll
      for (int g = 0; g < G; ++g) {
        const unsigned t0 = T[g][0] | bm, t1 = T[g][1] | bm;
        const int c0 = __popcll(__ballot(k[g][0] >= t0)) + __popcll(__ballot(k[g][1] >= t0));
        const int c1 = __popcll(__ballot(k[g][2] >= t1)) + __popcll(__ballot(k[g][3] >= t1));
        if (c0 >= 16) { T[g][0] = t0; n[g][0] = c0; }
        if (c1 >= 16) { T[g][1] = t1; n[g][1] = c1; }
      }
    }
    unsigned ck[G][4];
    float cv[G][4];
#pragma unroll
    for (int g = 0; g < G; ++g) {
      float* sv = wbase + g * 128;
      int* si = (int*)(sv + 32);
#pragma unroll
      for (int part = 0; part < 2; ++part) {
        const unsigned Tp = T[g][part];
        const unsigned long long m0 = __ballot(k[g][2 * part] >= Tp), m1 = __ballot(k[g][2 * part + 1] >= Tp);
        const int r0 = lane_rank(m0), r1 = __popcll(m0) + lane_rank(m1);
        if (k[g][2 * part] >= Tp && r0 < 16) { sv[part * 16 + r0] = v[g][2 * part]; si[part * 16 + r0] = lane; }
        if (k[g][2 * part + 1] >= Tp && r1 < 16) { sv[part * 16 + r1] = v[g][2 * part + 1]; si[part * 16 + r1] = 64 + lane; }
      }
    }
#pragma unroll
    for (int g = 0; g < G; ++g) {
      const float* sv = wbase + g * 128;
      const float a = sv[lane >> 2];
#pragma unroll
      for (int q = 0; q < 4; ++q) { cv[g][q] = a + sv[16 + (lane & 3) * 4 + q]; ck[g][q] = fkey(cv[g][q]); }
    }
    unsigned T2[G];
    int n2[G];
#pragma unroll
    for (int g = 0; g < G; ++g) {
      const unsigned M = fkey(fkey_inv(Mk[g][0]) + fkey_inv(Mk[g][1]));
      unsigned P = M >> 23;
      unsigned Tc; int c;
      for (;;) {
        Tc = P << 23;
        c = __popcll(__ballot(ck[g][0] >= Tc)) + __popcll(__ballot(ck[g][1] >= Tc)) + __popcll(__ballot(ck[g][2] >= Tc)) + __popcll(__ballot(ck[g][3] >= Tc));
        if (c >= 16 || P == 0u) break;
        --P;
      }
      T2[g] = Tc; n2[g] = c;
    }
#pragma unroll 1
    for (int bit = 22; bit >= 0; --bit) {
      bool done = true;
#pragma unroll
      for (int g = 0; g < G; ++g) done = done && (n2[g] == 16);
      if (done) break;
      const unsigned bm = 1u << bit;
#pragma unroll
      for (int g = 0; g < G; ++g) {
        const unsigned t2 = T2[g] | bm;
        const int c = __popcll(__ballot(ck[g][0] >= t2)) + __popcll(__ballot(ck[g][1] >= t2)) + __popcll(__ballot(ck[g][2] >= t2)) + __popcll(__ballot(ck[g][3] >= t2));
        if (c >= 16) { T2[g] = t2; n2[g] = c; }
      }
    }
#pragma unroll
    for (int g = 0; g < G; ++g) {
      float* sv = wbase + g * 128;
      float* s2v = sv + 64;
      int* s2c = (int*)(sv + 80);
      int base = 0;
#pragma unroll
      for (int q = 0; q < 4; ++q) {
        const unsigned long long m = __ballot(ck[g][q] >= T2[g]);
        const int r = base + lane_rank(m);
        if (ck[g][q] >= T2[g] && r < 16) { s2v[r] = cv[g][q]; s2c[r] = lane * 4 + q; }
        base += __popcll(m);
      }
    }
    {
      const int g = (lane >> 4) % G, kk = lane & 15;
      const float* sv = wbase + g * 128;
      const int* si = (const int*)(sv + 32);
      const float* s2v = sv + 64;
      const int* s2c = (const int*)(sv + 80);
      const float val = s2v[kk];
      const float mx = rowmax16(val);
      const float ev = __expf(val - mx);
      const float ssum = rowsum16(ev);
      if (lane < 16 * G) {
        const int bc = s2c[kk];
        const int i0 = si[bc >> 4], i1 = si[16 + (bc & 15)];
        oidx[g * 16 + kk] = i0 * 128 + i1;
        ogate[g * 16 + kk] = ev / ssum;
      }
    }
  }
}
DI float dot16(const f32x2* hp, u32x4 u) {
  f32x2 d0 = {0.f, 0.f}, d1 = {0.f, 0.f};
#pragma unroll
  for (int q = 0; q < 4; ++q) {
    const int wq = (int)u[q];
    const f32x2 lo = __builtin_amdgcn_cvt_pk_f32_fp8(wq, false), hi = __builtin_amdgcn_cvt_pk_f32_fp8(wq, true);
    d0 = __builtin_elementwise_fma(hp[2 * q], lo, d0);
    d1 = __builtin_elementwise_fma(hp[2 * q + 1], hi, d1);
  }
  const f32x2 d = d0 + d1;
  return d.x + d.y;
}
DI float dot16_fp4(const f32x2* hp, u32x2 u) {
  f32x2 d0 = {0.f, 0.f}, d1 = {0.f, 0.f};
#pragma unroll
  for (int d = 0; d < 2; ++d) {
    const unsigned wq = u[d];
    d0 = __builtin_elementwise_fma(hp[4 * d], __builtin_amdgcn_cvt_scalef32_pk_f32_fp4(wq, 1.0f, 0), d0);
    d1 = __builtin_elementwise_fma(hp[4 * d + 1], __builtin_amdgcn_cvt_scalef32_pk_f32_fp4(wq, 1.0f, 1), d1);
    d0 = __builtin_elementwise_fma(hp[4 * d + 2], __builtin_amdgcn_cvt_scalef32_pk_f32_fp4(wq, 1.0f, 2), d0);
    d1 = __builtin_elementwise_fma(hp[4 * d + 3], __builtin_amdgcn_cvt_scalef32_pk_f32_fp4(wq, 1.0f, 3), d1);
  }
  const f32x2 dd = d0 + d1;
  return dd.x + dd.y;
}
DI void axpy16_fp4(f32x2* acc, float wgt, u32x2 v) {
  const f32x2 w2 = {wgt, wgt};
#pragma unroll
  for (int d = 0; d < 2; ++d) {
    const unsigned wq = v[d];
    acc[4 * d] = __builtin_elementwise_fma(w2, __builtin_amdgcn_cvt_scalef32_pk_f32_fp4(wq, 1.0f, 0), acc[4 * d]);
    acc[4 * d + 1] = __builtin_elementwise_fma(w2, __builtin_amdgcn_cvt_scalef32_pk_f32_fp4(wq, 1.0f, 1), acc[4 * d + 1]);
    acc[4 * d + 2] = __builtin_elementwise_fma(w2, __builtin_amdgcn_cvt_scalef32_pk_f32_fp4(wq, 1.0f, 2), acc[4 * d + 2]);
    acc[4 * d + 3] = __builtin_elementwise_fma(w2, __builtin_amdgcn_cvt_scalef32_pk_f32_fp4(wq, 1.0f, 3), acc[4 * d + 3]);
  }
}
DI void phase_peer(const Params& p, int layer, int ntok, float* dstbase, char* smem) {
  const int lane = threadIdx.x & 63;
  const int w = __builtin_amdgcn_readfirstlane(threadIdx.x >> 6);
  const unsigned char* U = p.U8 + (long)layer * 16384 * 512;
  const unsigned char* V = p.V8 + (long)layer * 16384 * 512;
  const float* SU = p.SCU + layer * 16384;
  const float* SV = p.SCV + layer * 16384;
  const float* modl = p.MOD + (long)layer * 9 * 6144;
  float* wtk = (float*)smem + w * 768;
  int* eidx_s = (int*)(wtk + 512);
  float* gate_s = wtk + 640;
  for (int t = blockIdx.x * 4 + w; t < ntok; t += gridDim.x * 4) {
    f32x2 hp[8];
    {
      const u32x4 ha = *(const u32x4*)(p.HB + (long)t * 1024 + lane * 16);
      const u32x4 hb = *(const u32x4*)(p.HB + (long)t * 1024 + lane * 16 + 8);
#pragma unroll
      for (int q = 0; q < 4; ++q) { hp[q].x = bflo(ha[q]); hp[q].y = bfhi(ha[q]); hp[4 + q].x = bflo(hb[q]); hp[4 + q].y = bfhi(hb[q]); }
    }
    {
      float sva[4][4], svb[4][4];
      const float* scp = p.SC + (long)t * 2048 + lane;
#pragma unroll
      for (int g = 0; g < 4; ++g)
#pragma unroll
        for (int q = 0; q < 4; ++q) { sva[g][q] = scp[g * 256 + q * 64]; svb[g][q] = scp[1024 + g * 256 + q * 64]; }
      topk_group<4>(sva, wtk, eidx_s, gate_s);
      topk_group<4>(svb, wtk, eidx_s + 64, gate_s + 64);
    }
    const int idxA = eidx_s[lane], idxB = eidx_s[64 + lane];
    const float gA = gate_s[lane], gB = gate_s[64 + lane];
    const float suA = SU[idxA], suB = SU[idxB];
    const float gvA = gA * SV[idxA], gvB = gB * SV[idxB];
    f32x2 acc2[8];
#pragma unroll
    for (int j = 0; j < 8; ++j) { acc2[j].x = 0.f; acc2[j].y = 0.f; }
    constexpr int NB = 16;
    u32x2 un[NB], vn[NB];
#pragma unroll
    for (int j = 0; j < NB; ++j) {
      const int idx = __builtin_amdgcn_readlane(idxA, j);
      un[j] = *(const u32x2*)(U + (long)idx * 512 + lane * 8);
      vn[j] = *(const u32x2*)(V + (long)idx * 512 + lane * 8);
    }
#pragma unroll 1
    for (int b = 0; b < 128 / NB; ++b) {
      const int l0 = (b * NB) & 63;
      const bool hiHalf = b * NB >= 64;
      u32x2 uc[NB];
      u32x2 vc[NB];
#pragma unroll
      for (int j = 0; j < NB; ++j) {
        uc[j] = un[j];
        vc[j] = vn[j];
      }
      if (b + 1 < 128 / NB) {
        const int l1 = ((b + 1) * NB) & 63;
        const bool hi1 = (b + 1) * NB >= 64;
#pragma unroll
        for (int j = 0; j < NB; ++j) {
          const int idx = hi1 ? __builtin_amdgcn_readlane(idxB, l1 + j) : __builtin_amdgcn_readlane(idxA, l1 + j);
          un[j] = *(const u32x2*)(U + (long)idx * 512 + lane * 8);
          vn[j] = *(const u32x2*)(V + (long)idx * 512 + lane * 8);
        }
      }
      float dsel = 0.f;
#pragma unroll
      for (int j = 0; j < NB; ++j) {
        const float d = rowsum16(dot16_fp4(hp, uc[j]));
        if ((lane & (NB - 1)) == j) dsel = d;
      }
      dsel += __shfl_xor(dsel, 16);
      dsel += __shfl_xor(dsel, 32);
      const float wv = hiHalf ? gvB * gelu_tanh(dsel * suB) : gvA * gelu_tanh(dsel * suA);
      const int wvi = __builtin_bit_cast(int, wv);
#pragma unroll
      for (int j = 0; j < NB; ++j) {
        const float wj = __builtin_bit_cast(float, __builtin_amdgcn_readlane(wvi, l0 + j));
        axpy16_fp4(acc2, wj, vc[j]);
      }
    }
    float acc[16];
#pragma unroll
    for (int j = 0; j < 8; ++j) { acc[2 * j] = acc2[j].x; acc[2 * j + 1] = acc2[j].y; }
    const int bi = (t < TL) ? (t >> 11) : 8;
    const float* g2 = modl + bi * 6144 + 5120 + lane * 16;
    const float* xr = p.XRES + (long)t * 1024 + lane * 16;
    float* dst = dstbase + (long)t * 1024 + lane * 16;
    float ssq = 0.f;
#pragma unroll
    for (int q = 0; q < 4; ++q) {
      const f32x4 x0 = *(const f32x4*)(xr + q * 4);
      const f32x4 ga = *(const f32x4*)(g2 + q * 4);
      f32x4 o = {x0.x + ga.x * acc[q * 4], x0.y + ga.y * acc[q * 4 + 1], x0.z + ga.z * acc[q * 4 + 2], x0.w + ga.w * acc[q * 4 + 3]};
      *(f32x4*)(dst + q * 4) = o;
      acc[q * 4] = o.x; acc[q * 4 + 1] = o.y; acc[q * 4 + 2] = o.z; acc[q * 4 + 3] = o.w;
      ssq += o.x * o.x + o.y * o.y + o.z * o.z + o.w * o.w;
    }
    if (layer == 0) {
      const float rstd = rsqrtf(wsum_fast(ssq) * (1.f / 1024.f) + EPSF);
      const float* md1 = p.MOD + (long)(9 + bi) * 6144 + lane * 16;
      const float* nw1 = p.norm1_w + 1024 + lane * 16;
      float y[16];
#pragma unroll
      for (int q = 0; q < 4; ++q) {
        const f32x4 nw = *(const f32x4*)(nw1 + q * 4);
        const f32x4 sh = *(const f32x4*)(md1 + q * 4);
        const f32x4 sc = *(const f32x4*)(md1 + 1024 + q * 4);
        y[q * 4] = acc[q * 4] * rstd * nw.x * (1.f + sc.x) + sh.x;
        y[q * 4 + 1] = acc[q * 4 + 1] * rstd * nw.y * (1.f + sc.y) + sh.y;
        y[q * 4 + 2] = acc[q * 4 + 2] * rstd * nw.z * (1.f + sc.z) + sh.z;
        y[q * 4 + 3] = acc[q * 4 + 3] * rstd * nw.w * (1.f + sc.w) + sh.w;
      }
      *(u32x4*)(p.HB + (long)t * 1024 + lane * 16) = pack8f(y);
      *(u32x4*)(p.HB + (long)t * 1024 + lane * 16 + 8) = pack8f(y + 8);
    }
  }
}

#ifdef EXPERIMENT
#define REPL(k) for (int rep_ = 0; rep_ < p.rep[k]; ++rep_)
#else
#define REPL(k)
#endif
DI void run_phase(const Params& p, int ph, char* smem) {
  const float* mod0 = p.MOD;
  const float* mod1 = p.MOD + 9 * 6144;
  EpiArgs ea;
  ea.C = nullptr; ea.ldc = 0; ea.N = 0; ea.xin_lat = nullptr; ea.xin_ctx = nullptr; ea.g = nullptr;
  switch (ph) {
    case 0: REPL(5) phase_prep(p, smem); break;
    case 1: REPL(1) phase_modulate(p, p.x, p.ctx, TA, p.norm1_w, mod0, 0, 1024); break;
    case 2: ea.C = p.Z; ea.ldc = 1312; ea.N = 1312; gemm_phase<0>(smem, p.HB, 1024, 0, p.WT_ABIN, 1024, 144, 11, 0, ea);
      {
        const int nslot = gridDim.x >> 3, slot = blockIdx.x >> 3, busy = 198 % nslot;
        const int nidle = nslot - busy;
        if (slot >= busy) {
          const int wi = (slot - busy) * 8 + (blockIdx.x & 7), nwk = nidle * 8;
          convert_fp4_rows(p.peer_u, p.U8, p.SCU, 2 * 16384, wi, nwk);
        }
      }
      break;
    case 3: phase_post0a(p); break;
    case 4:
      ea.C = p.QB; ea.ldc = 768; ea.N = 768; gemm_phase<0>(smem, p.Z + 768, 1312, 0, p.WT_UQ, 256, 144, 6, 0, ea);
      ea.C = p.KVR; ea.ldc = 1024; ea.N = 1024; gemm_phase<0>(smem, p.Z + 1024, 1312, 0, p.WT_UKV, 256, 144, 8, 108, ea);
      break;
    case 5: phase_post0b(p); break;
    case 6: REPL(3) phase_attn0(p, smem); break;
    case 7: ea.C = p.XRES; ea.N = 1024; ea.xin_lat = p.x; ea.xin_ctx = p.ctx; ea.g = mod0 + 2048;
      gemm_phase<2>(smem, p.AO, 1024, 0, p.WT_ABO, 1024, 144, 8, 0, ea);
      {
        const int nslot = gridDim.x >> 3, slot = blockIdx.x >> 3, busy = 144 % nslot;
        if (slot >= busy) convert_fp4_rows(p.peer_v, p.V8, p.SCV, 2 * 16384, (slot - busy) * 8 + (blockIdx.x & 7), (nslot - busy) * 8);
      }
      break;
    case 8: REPL(1) phase_modulate(p, p.XRES, p.XRES + (long)TL * 1024, TA, p.norm2_w, mod0, 3072, 4096); break;
    case 9: gemm_pq_scores(smem, p.HB, p.WT_PQ, p.KEYS16, p.SC, 144); break;
    case 10: phase_peer(p, 0, TA, p.XRES, smem); break;
    case 11: ea.C = p.Z; ea.ldc = 2304; ea.N = 2304; gemm_phase<0>(smem, p.HB, 1024, 0, p.WT_CDIN, 1024, 144, 18, 0, ea); break;
    case 12: phase_post1(p); break;
    case 13: REPL(4) phase_attn1(p, smem); break;
    case 14: REPL(2) for (int id = blockIdx.x; id < 512; id += gridDim.x) ret_out_item(p, smem, id); break;
    case 15: ea.C = p.XRES; ea.N = 1024; ea.g = mod1 + 2048; gemm_phase<3>(smem, p.AO, 1024, 0, p.WT_CDO, 1024, 128, 8, 0, ea); break;
    case 16: REPL(1) phase_modulate(p, p.XRES, p.XRES + (long)TL * 1024, TL, p.norm2_w + 1024, mod1, 3072, 4096); break;
    case 17: gemm_pq_scores(smem, p.HB, p.WT_PQ + 2048L * 1024, p.KEYS16 + 16L * 128 * 128, p.SC, 128); break;
    case 18: phase_peer(p, 1, TL, p.out, smem); break;
    default: break;
  }
}


#define XB_TMO      128
#define XB_XCNT(j)  (256  + 64 * (j))
#define XB_XSUB(j)  (1280 + 64 * (j))
#define XB_XGEN(j)  (2304 + 64 * (j))
#define XB_TOP      3328
#define XB_TOPGEN   3392
#define XCD_BAR_WORDS 3456
#define XB_SPIN_CAP (1u << 20)
#define LAS __attribute__((address_space(3)))
DI unsigned xb_ld(unsigned* p) { return __hip_atomic_load(p, __ATOMIC_RELAXED, __HIP_MEMORY_SCOPE_AGENT); }
DI unsigned xb_add(unsigned* p, unsigned v) { return __hip_atomic_fetch_add(p, v, __ATOMIC_RELAXED, __HIP_MEMORY_SCOPE_AGENT); }
DI unsigned xb_xcc_id() { return (unsigned)__builtin_amdgcn_s_getreg((3 << 11) | 20) & 0xFu; }
#define XB_SPIN(cond, bar) do { unsigned _sp = 0; while (cond) { __builtin_amdgcn_s_sleep(1); \
    if ((++_sp & 255u) == 0u) { if (xb_ld(&(bar)[XB_TMO])) break; if (_sp > XB_SPIN_CAP) { atomicAdd(&(bar)[XB_TMO], 1u); break; } } } } while (0)
struct XcdBarrier { unsigned* bar; unsigned x; volatile LAS unsigned* st; };
DI XcdBarrier xcd_barrier_post(unsigned* bar, volatile LAS unsigned* st) {
  XcdBarrier b; b.bar = bar; b.x = xb_xcc_id(); b.st = st;
  if (threadIdx.x == 0) (void)xb_add(&bar[XB_XCNT(b.x)], 1u);
  return b;
}
DI void xcd_barrier_complete(unsigned* bar, unsigned x, unsigned& nloc, unsigned& nx) {
  const unsigned G = gridDim.x * gridDim.y * gridDim.z;
  unsigned sum, cnt, mine, sp = 0u;
  for (;;) {
    sum = 0u; cnt = 0u; mine = 0u;
#pragma unroll
    for (unsigned j = 0; j < 16; ++j) { const unsigned c = xb_ld(&bar[XB_XCNT(j)]); sum += c; cnt += (c > 0u) ? 1u : 0u; mine = (j == x) ? c : mine; }
    if (sum == G) break;
    __builtin_amdgcn_s_sleep(1);
    if ((++sp & 255u) == 0u) { if (xb_ld(&bar[XB_TMO])) break; if (sp > XB_SPIN_CAP) { atomicAdd(&bar[XB_TMO], 1u); break; } }
  }
  nloc = mine > 0u ? mine : 1u; nx = cnt > 0u ? cnt : 1u;
}
DI void xcd_barrier(const XcdBarrier& b) {
  asm volatile("s_waitcnt vmcnt(0)" ::: "memory");
  __syncthreads();
  if (threadIdx.x == 0) {
    unsigned* bar = b.bar;
    __builtin_amdgcn_s_waitcnt(0);
    unsigned nloc = b.st[0], nx = b.st[1];
    if (nloc == 0u) { xcd_barrier_complete(bar, b.x, nloc, nx); b.st[0] = nloc; b.st[1] = nx; }
    const unsigned old = xb_add(&bar[XB_XSUB(b.x)], 1u);
    const unsigned gen = old / nloc;
    if (old + 1u == (gen + 1u) * nloc) {
      __builtin_amdgcn_fence(__ATOMIC_RELEASE, "agent");
      asm volatile("s_waitcnt vmcnt(0)" ::: "memory");
      const unsigned og = xb_add(&bar[XB_TOP], 1u);
      const unsigned tg = og / nx;
      if (og + 1u == (tg + 1u) * nx) xb_add(&bar[XB_TOPGEN], 1u);
      else XB_SPIN(xb_ld(&bar[XB_TOPGEN]) == tg, bar);
      __builtin_amdgcn_fence(__ATOMIC_ACQUIRE, "agent");
      xb_add(&bar[XB_XGEN(b.x)], 1u);
      asm volatile("s_waitcnt vmcnt(0)" ::: "memory");
    } else {
      XB_SPIN(xb_ld(&bar[XB_XGEN(b.x)]) == gen, bar);
      __builtin_amdgcn_fence(__ATOMIC_ACQUIRE, "agent");
      asm volatile("s_waitcnt vmcnt(0)" ::: "memory");
    }
  }
  __syncthreads();
}

#if MULTI_LAUNCH
template <int PH>
__global__ void __launch_bounds__(256, 2) phase_kernel(KArgs a) {
  __shared__ __attribute__((aligned(16))) char smem[73728];
  const Params p = make_params(a);
  run_phase(p, PH, smem);
}
template <int PH>
static void launch_all(const KArgs& a, hipStream_t stream) {
  hipLaunchKernelGGL(phase_kernel<PH>, dim3(512), dim3(256), 0, stream, a);
  if constexpr (PH + 1 < NPHASE) launch_all<PH + 1>(a, stream);
}
#else
template <int PH>
DI void run_from(const Params& p, char* smem, cg::grid_group& grid, const XcdBarrier& xb) {
  run_phase(p, PH, smem);
  if constexpr (PH + 1 < NPHASE) {
    if constexpr (PH == 0) { if (p.out == nullptr) grid.sync(); }
    xcd_barrier(xb);
    run_from<PH + 1>(p, smem, grid, xb);
  }
}
__global__ void __launch_bounds__(256, 2) mega_kernel(KArgs a) {
  __shared__ __attribute__((aligned(16))) char smem[73728];
  __shared__ __attribute__((aligned(16))) unsigned xb_words[4];
  if (threadIdx.x < 4) xb_words[threadIdx.x] = 0u;
  __syncthreads();
  const Params p = make_params(a);
  const XcdBarrier xb = xcd_barrier_post(p.BAR, (volatile LAS unsigned*)xb_words);
  cg::grid_group grid = cg::this_grid();
  run_from<0>(p, smem, grid, xb);
}
#endif

extern "C" void kernel_launch(void* const* d_in, const int* in_sizes, int n_in, void* d_out, int out_size, void* d_ws, size_t ws_size,
                              hipStream_t stream) {
  KArgs a;
  memset(&a, 0, sizeof(a));
  for (int i = 0; i < 30; ++i) a.in[i] = (const float*)d_in[i];
  a.out = (float*)d_out;
  a.ws = (char*)d_ws;
#ifdef EXPERIMENT
  { const int r[8] = {EXPERIMENT}; for (int i = 0; i < 8; ++i) a.rep[i] = r[i]; }
#endif
  (void)hipMemsetAsync((char*)d_ws + OFF_MOD, 0, (OFF_BAR - OFF_MOD) + 4096 * 4, stream);
#if MULTI_LAUNCH
  launch_all<0>(a, stream);
#else
  static int grid_blocks = 0;
  if (!grid_blocks) {
    int dev = 0, cus = 0, per_cu = 0;
    (void)hipGetDevice(&dev);
    (void)hipDeviceGetAttribute(&cus, hipDeviceAttributeMultiprocessorCount, dev);
    (void)hipOccupancyMaxActiveBlocksPerMultiprocessor(&per_cu, mega_kernel, 256, 0);
    if (per_cu > 2) per_cu = 2;
    if (per_cu < 1) per_cu = 1;
    grid_blocks = (cus * per_cu) & ~7;
  }
  void* args[] = {&a};
  hipError_t e = hipLaunchCooperativeKernel((void*)mega_kernel, dim3(grid_blocks), dim3(256), args, 0, stream);
  if (e != hipSuccess) fprintf(stderr, "cooperative launch failed: %s (grid %d)\n", hipGetErrorString(e), grid_blocks);
#endif
}
```

```cpp
#include <hip/hip_runtime.h>
#include <hip/hip_cooperative_groups.h>
#include <cstdio>
#include <cstring>
namespace cg = cooperative_groups;

#ifndef MULTI_LAUNCH
#define MULTI_LAUNCH 0
#endif

typedef unsigned short u16;
typedef short bf16x8 __attribute__((ext_vector_type(8)));
typedef float f32x16 __attribute__((ext_vector_type(16)));
typedef short s16x4 __attribute__((ext_vector_type(4)));
#define LDS3 __attribute__((address_space(3)))
typedef __bf16 bf2_t __attribute__((ext_vector_type(2)));
typedef float f2_t __attribute__((ext_vector_type(2)));
typedef unsigned int u32x4 __attribute__((ext_vector_type(4)));
typedef unsigned int u32x2 __attribute__((ext_vector_type(2)));
typedef float f32x4 __attribute__((ext_vector_type(4)));
typedef float f32x2 __attribute__((ext_vector_type(2)));
#define DI __device__ __forceinline__
#define MFMA(a, b, c) __builtin_amdgcn_mfma_f32_32x32x16_bf16((a), (b), (c), 0, 0, 0)

constexpr int TL = 16384;
constexpr int TC = 2048;
constexpr int TA = 18432;
constexpr int NPHASE = 19;
constexpr float EPSF = 1e-6f;
constexpr float LOG2E = 1.4426950408889634f;

struct KArgs {
  const float* in[30];
  float* out;
  char* ws;
#ifdef EXPERIMENT
  int rep[8];
#endif
};
struct Params {
  const float *x, *c, *ctx, *c_ctx, *ada_w, *ada_b, *norm1_w, *norm2_w, *ab_w_in, *ab_w_o, *a_q_norm, *a_k_norm, *a_sink,
      *b_q_lora_norm, *b_kv_lora_norm, *b_w_uq, *b_w_ukv, *b_q_norm, *b_k_norm, *cd_w_in, *cd_w_o, *c_decay_fwd, *c_decay_bwd,
      *c_gn_w, *d_q_norm, *d_k_norm, *peer_w_q, *peer_keys, *peer_u, *peer_v;
  float* out;
  u16 *U16, *V16, *WT_ABIN, *WT_ABO, *WT_UQ, *WT_UKV, *WT_CDIN, *WT_CDO, *WT_PQ, *KEYS16;
  float *MOD, *ROPE16, *ROPE8, *XRES;
  u16 *HB, *AO, *Z, *QB, *KVR, *KB, *VB;
  float* LST;
  float* SC;
  u16* PQ;
  int* EIDX;
  float* GATE;
  unsigned* BAR;
  unsigned char *U8, *V8;
  float *SCU, *SCV;
#ifdef EXPERIMENT
  int rep[8];
#endif
};
constexpr size_t al256(size_t x) { return (x + 255) & ~(size_t)255; }
constexpr size_t OFF_U16 = 0;
constexpr size_t OFF_V16 = OFF_U16 + al256(2UL * 16384 * 1024 * 2);
constexpr size_t OFF_WT_ABIN = OFF_V16 + al256(2UL * 16384 * 1024 * 2);
constexpr size_t OFF_WT_ABO = OFF_WT_ABIN + al256(1408UL * 1024 * 2);
constexpr size_t OFF_WT_UQ = OFF_WT_ABO + al256(1024UL * 1024 * 2);
constexpr size_t OFF_WT_UKV = OFF_WT_UQ + al256(768UL * 256 * 2);
constexpr size_t OFF_WT_CDIN = OFF_WT_UKV + al256(1024UL * 256 * 2);
constexpr size_t OFF_WT_CDO = OFF_WT_CDIN + al256(2304UL * 1024 * 2);
constexpr size_t OFF_WT_PQ = OFF_WT_CDO + al256(1024UL * 1024 * 2);
constexpr size_t OFF_KEYS16 = OFF_WT_PQ + al256(2UL * 2048 * 1024 * 2);
constexpr size_t OFF_MOD = OFF_KEYS16 + al256(2UL * 16 * 128 * 128 * 2);
constexpr size_t OFF_ROPE16 = OFF_MOD + al256(2UL * 9 * 6144 * 4);
constexpr size_t OFF_ROPE8 = OFF_ROPE16 + al256(64UL * 16 * 2 * 4);
constexpr size_t OFF_BAR = OFF_ROPE8 + al256(64UL * 8 * 2 * 4);
constexpr size_t OFF_SCU = OFF_BAR + al256(4096UL * 4);
constexpr size_t OFF_SCV = OFF_SCU + al256(2UL * 16384 * 4);
constexpr size_t OFF_XRES = OFF_SCV + al256(2UL * 16384 * 4);
constexpr size_t OFF_HB = OFF_XRES + al256((size_t)TA * 1024 * 4);
constexpr size_t OFF_R = OFF_HB + al256((size_t)TA * 1024 * 2);
constexpr size_t OFF_AO = OFF_R;
constexpr size_t OFF_Z = OFF_AO + (size_t)TA * 1024 * 2;
constexpr size_t OFF_QB = OFF_Z + (size_t)TA * 2304 * 2;
constexpr size_t OFF_KVR = OFF_QB + (size_t)TA * 768 * 2;
constexpr size_t OFF_KB = OFF_KVR + (size_t)TA * 1024 * 2;
constexpr size_t OFF_VB = OFF_KB + (size_t)TA * 768 * 2;
constexpr size_t OFF_SC = OFF_R;
constexpr size_t OFF_PQ = OFF_SC + (size_t)TA * 2048 * 4;
constexpr size_t OFF_EIDX = OFF_PQ + (size_t)TA * 2048 * 2;
constexpr size_t OFF_GATE = OFF_EIDX + (size_t)TA * 128 * 4;
constexpr size_t WS_END = OFF_GATE + (size_t)TA * 128 * 4;
static_assert(WS_END <= 536870912UL, "workspace map exceeds 512 MiB");
static_assert(OFF_VB + (size_t)TA * 512 * 2 <= 536870912UL, "workspace map exceeds 512 MiB");

DI Params make_params(const KArgs& a) {
  Params p;
  p.x = a.in[0]; p.c = a.in[1]; p.ctx = a.in[2]; p.c_ctx = a.in[3]; p.ada_w = a.in[4]; p.ada_b = a.in[5]; p.norm1_w = a.in[6];
  p.norm2_w = a.in[7]; p.ab_w_in = a.in[8]; p.ab_w_o = a.in[9]; p.a_q_norm = a.in[10]; p.a_k_norm = a.in[11]; p.a_sink = a.in[12];
  p.b_q_lora_norm = a.in[13]; p.b_kv_lora_norm = a.in[14]; p.b_w_uq = a.in[15]; p.b_w_ukv = a.in[16]; p.b_q_norm = a.in[17];
  p.b_k_norm = a.in[18]; p.cd_w_in = a.in[19]; p.cd_w_o = a.in[20]; p.c_decay_fwd = a.in[21]; p.c_decay_bwd = a.in[22];
  p.c_gn_w = a.in[23]; p.d_q_norm = a.in[24]; p.d_k_norm = a.in[25]; p.peer_w_q = a.in[26]; p.peer_keys = a.in[27];
  p.peer_u = a.in[28]; p.peer_v = a.in[29];
  p.out = a.out;
#ifdef EXPERIMENT
  for (int i = 0; i < 8; ++i) p.rep[i] = a.rep[i];
#endif
  char* ws = a.ws;
  p.U16 = (u16*)(ws + OFF_U16); p.V16 = (u16*)(ws + OFF_V16); p.WT_ABIN = (u16*)(ws + OFF_WT_ABIN); p.WT_ABO = (u16*)(ws + OFF_WT_ABO);
  p.WT_UQ = (u16*)(ws + OFF_WT_UQ); p.WT_UKV = (u16*)(ws + OFF_WT_UKV); p.WT_CDIN = (u16*)(ws + OFF_WT_CDIN); p.WT_CDO = (u16*)(ws + OFF_WT_CDO);
  p.WT_PQ = (u16*)(ws + OFF_WT_PQ); p.KEYS16 = (u16*)(ws + OFF_KEYS16); p.MOD = (float*)(ws + OFF_MOD); p.ROPE16 = (float*)(ws + OFF_ROPE16);
  p.ROPE8 = (float*)(ws + OFF_ROPE8); p.BAR = (unsigned*)(ws + OFF_BAR); p.XRES = (float*)(ws + OFF_XRES); p.HB = (u16*)(ws + OFF_HB);
  p.AO = (u16*)(ws + OFF_AO); p.Z = (u16*)(ws + OFF_Z); p.QB = (u16*)(ws + OFF_QB); p.LST = (float*)(ws + OFF_QB); p.KVR = (u16*)(ws + OFF_KVR);
  p.KB = (u16*)(ws + OFF_KB); p.VB = (u16*)(ws + OFF_VB); p.SC = (float*)(ws + OFF_SC); p.PQ = (u16*)(ws + OFF_PQ);
  p.EIDX = (int*)(ws + OFF_EIDX); p.GATE = (float*)(ws + OFF_GATE);
  p.U8 = (unsigned char*)(ws + OFF_U16); p.V8 = (unsigned char*)(ws + OFF_V16); p.SCU = (float*)(ws + OFF_SCU); p.SCV = (float*)(ws + OFF_SCV);
  return p;
}

DI unsigned pack2(float a, float b) {
  f2_t v = {a, b};
  return __builtin_bit_cast(unsigned, __builtin_convertvector(v, bf2_t));
}
DI u16 f2bf(float a) { return (u16)(pack2(a, 0.f) & 0xffffu); }
DI float bf2f(u16 v) { return __uint_as_float(((unsigned)v) << 16); }
DI float bflo(unsigned v) { return __uint_as_float(v << 16); }
DI float bfhi(unsigned v) { return __uint_as_float(v & 0xffff0000u); }
DI float wsum(float v) {
#pragma unroll
  for (int o = 32; o >= 1; o >>= 1) v += __shfl_xor(v, o);
  return v;
}
DI float wmax(float v) {
#pragma unroll
  for (int o = 32; o >= 1; o >>= 1) v = fmaxf(v, __shfl_xor(v, o));
  return v;
}
DI int crow(int reg, int h) { return (reg & 3) + 8 * (reg >> 2) + 4 * h; }
DI float ex2(float x) { return __builtin_amdgcn_exp2f(x); }
DI bf16x8 as_bf16x8(u32x4 v) { return __builtin_bit_cast(bf16x8, v); }
DI bf16x8 join8(u32x2 a, u32x2 b) { u32x4 v = {a.x, a.y, b.x, b.y}; return __builtin_bit_cast(bf16x8, v); }
DI bf16x8 pack8(const f32x16& x, int s) {
  u32x4 v;
  v.x = pack2(x[8 * s + 0], x[8 * s + 1]);
  v.y = pack2(x[8 * s + 2], x[8 * s + 3]);
  v.z = pack2(x[8 * s + 4], x[8 * s + 5]);
  v.w = pack2(x[8 * s + 6], x[8 * s + 7]);
  return __builtin_bit_cast(bf16x8, v);
}
DI f32x16 zero16() {
  f32x16 z;
#pragma unroll
  for (int i = 0; i < 16; ++i) z[i] = 0.f;
  return z;
}
DI float log_sigmoid(float x) { return -log1pf(__expf(-x)); }
DI float silu(float x) { return x / (1.f + __expf(-x)); }
DI float gelu_tanh(float x) {
  float u = 0.7978845608028654f * (x + 0.044715f * x * x * x);
  float t = 1.f - 2.f / (__expf(2.f * u) + 1.f);
  return 0.5f * x * (1.f + t);
}

DI float rowsum16(float v) {
  v += __builtin_bit_cast(float, __builtin_amdgcn_update_dpp(0, __builtin_bit_cast(int, v), 0x128, 0xf, 0xf, false));
  v += __builtin_bit_cast(float, __builtin_amdgcn_update_dpp(0, __builtin_bit_cast(int, v), 0x124, 0xf, 0xf, false));
  v += __builtin_bit_cast(float, __builtin_amdgcn_update_dpp(0, __builtin_bit_cast(int, v), 0x122, 0xf, 0xf, false));
  v += __builtin_bit_cast(float, __builtin_amdgcn_update_dpp(0, __builtin_bit_cast(int, v), 0x121, 0xf, 0xf, false));
  return v;
}
DI float wsum_fast(float v) {
  v = rowsum16(v);
  const int iv = __builtin_bit_cast(int, v);
  const float a = __builtin_bit_cast(float, __builtin_amdgcn_readlane(iv, 0));
  const float b = __builtin_bit_cast(float, __builtin_amdgcn_readlane(iv, 16));
  const float c = __builtin_bit_cast(float, __builtin_amdgcn_readlane(iv, 32));
  const float d = __builtin_bit_cast(float, __builtin_amdgcn_readlane(iv, 48));
  return (a + b) + (c + d);
}
DI float rowmax16(float v) {
  v = fmaxf(v, __builtin_bit_cast(float, __builtin_amdgcn_update_dpp(0, __builtin_bit_cast(int, v), 0x128, 0xf, 0xf, false)));
  v = fmaxf(v, __builtin_bit_cast(float, __builtin_amdgcn_update_dpp(0, __builtin_bit_cast(int, v), 0x124, 0xf, 0xf, false)));
  v = fmaxf(v, __builtin_bit_cast(float, __builtin_amdgcn_update_dpp(0, __builtin_bit_cast(int, v), 0x122, 0xf, 0xf, false)));
  v = fmaxf(v, __builtin_bit_cast(float, __builtin_amdgcn_update_dpp(0, __builtin_bit_cast(int, v), 0x121, 0xf, 0xf, false)));
  return v;
}
DI float wmax_fast(float v) {
  v = rowmax16(v);
  const int iv = __builtin_bit_cast(int, v);
  const float a = __builtin_bit_cast(float, __builtin_amdgcn_readlane(iv, 0));
  const float b = __builtin_bit_cast(float, __builtin_amdgcn_readlane(iv, 16));
  const float c = __builtin_bit_cast(float, __builtin_amdgcn_readlane(iv, 32));
  const float d = __builtin_bit_cast(float, __builtin_amdgcn_readlane(iv, 48));
  return fmaxf(fmaxf(a, b), fmaxf(c, d));
}
DI void convert_fp8_rows(const float* __restrict__ src, unsigned char* __restrict__ dst, float* __restrict__ scl, int nrows, int wi, int nwk) {
  const int lane = threadIdx.x & 63, w = threadIdx.x >> 6;
  for (int row0 = (wi * 4 + w) * 4; row0 < nrows; row0 += nwk * 16) {
    f32x4 v[4][4];
#pragma unroll
    for (int rr = 0; rr < 4; ++rr) {
      const float* sp = src + (long)(row0 + rr) * 1024 + lane * 16;
#pragma unroll
      for (int q = 0; q < 4; ++q) v[rr][q] = *(const f32x4*)(sp + q * 4);
    }
#pragma unroll
    for (int rr = 0; rr < 4; ++rr) {
      float am = 0.f;
#pragma unroll
      for (int q = 0; q < 4; ++q)
        am = fmaxf(am, fmaxf(fmaxf(fabsf(v[rr][q].x), fabsf(v[rr][q].y)), fmaxf(fabsf(v[rr][q].z), fabsf(v[rr][q].w))));
      am = wmax_fast(am);
      const float inv = am > 0.f ? 224.f / am : 0.f;
      u32x4 o;
#pragma unroll
      for (int q = 0; q < 4; ++q) {
        int pk = 0;
        pk = __builtin_amdgcn_cvt_pk_fp8_f32(v[rr][q].x * inv, v[rr][q].y * inv, pk, false);
        pk = __builtin_amdgcn_cvt_pk_fp8_f32(v[rr][q].z * inv, v[rr][q].w * inv, pk, true);
        o[q] = (unsigned)pk;
      }
      *(u32x4*)(dst + (long)(row0 + rr) * 1024 + lane * 16) = o;
      if (lane == 0) scl[row0 + rr] = am * (1.f / 224.f);
    }
  }
}

DI void convert_fp4_rows(const float* __restrict__ src, unsigned char* __restrict__ dst, float* __restrict__ scl, int nrows, int wi, int nwk) {
  const int lane = threadIdx.x & 63, w = threadIdx.x >> 6;
  for (int row0 = (wi * 4 + w) * 4; row0 < nrows; row0 += nwk * 16) {
    f32x4 v[4][4];
#pragma unroll
    for (int rr = 0; rr < 4; ++rr) {
      const float* sp = src + (long)(row0 + rr) * 1024 + lane * 16;
#pragma unroll
      for (int q = 0; q < 4; ++q) v[rr][q] = *(const f32x4*)(sp + q * 4);
    }
#pragma unroll
    for (int rr = 0; rr < 4; ++rr) {
      float am = 0.f;
#pragma unroll
      for (int q = 0; q < 4; ++q)
        am = fmaxf(am, fmaxf(fmaxf(fabsf(v[rr][q].x), fabsf(v[rr][q].y)), fmaxf(fabsf(v[rr][q].z), fabsf(v[rr][q].w))));
      am = wmax_fast(am);
      const float inv = am > 0.f ? 6.f / am : 0.f;
      u32x2 o;
#pragma unroll
      for (int d = 0; d < 2; ++d) {
        unsigned pk = 0u;
        pk = __builtin_amdgcn_cvt_scalef32_pk_fp4_f32(pk, v[rr][2 * d].x * inv, v[rr][2 * d].y * inv, 1.0f, 0);
        pk = __builtin_amdgcn_cvt_scalef32_pk_fp4_f32(pk, v[rr][2 * d].z * inv, v[rr][2 * d].w * inv, 1.0f, 1);
        pk = __builtin_amdgcn_cvt_scalef32_pk_fp4_f32(pk, v[rr][2 * d + 1].x * inv, v[rr][2 * d + 1].y * inv, 1.0f, 2);
        pk = __builtin_amdgcn_cvt_scalef32_pk_fp4_f32(pk, v[rr][2 * d + 1].z * inv, v[rr][2 * d + 1].w * inv, 1.0f, 3);
        o[d] = pk;
      }
      *(u32x2*)(dst + (long)(row0 + rr) * 512 + lane * 8) = o;
      if (lane == 0) scl[row0 + rr] = am * (1.f / 6.f);
    }
  }
}

DI void transpose_w(const float* __restrict__ W, int K, int N, int Npad, u16* __restrict__ Wt, long gtid, long gsz) {
  const long items = (long)Npad * (K / 8);
  for (long id0 = gtid; id0 < items; id0 += 2 * gsz) {
    u32x4 o[2];
    long idv[2];
#pragma unroll
    for (int u = 0; u < 2; ++u) {
      const long id = id0 + u * gsz;
      idv[u] = id;
      u32x4 oo = {0u, 0u, 0u, 0u};
      if (id < items) {
        const int n = (int)(id % Npad), k8 = (int)(id / Npad);
        if (n < N) {
          const float* sp = W + (long)(k8 * 8) * N + n;
          oo.x = pack2(sp[0], sp[(long)N]);
          oo.y = pack2(sp[2L * N], sp[3L * N]);
          oo.z = pack2(sp[4L * N], sp[5L * N]);
          oo.w = pack2(sp[6L * N], sp[7L * N]);
        }
      }
      o[u] = oo;
    }
#pragma unroll
    for (int u = 0; u < 2; ++u) {
      const long id = idv[u];
      if (id < items) {
        const int n = (int)(id % Npad), k8 = (int)(id / Npad);
        *(u32x4*)(Wt + (long)n * K + k8 * 8) = o[u];
      }
    }
  }
}
DI void convert8(const float* __restrict__ src, u16* __restrict__ dst, long n8, long gtid, long gsz) {
  for (long i = gtid; i < n8; i += gsz) {
    const f32x4 a = ((const f32x4*)src)[2 * i], b = ((const f32x4*)src)[2 * i + 1];
    u32x4 o;
    o.x = pack2(a.x, a.y); o.y = pack2(a.z, a.w); o.z = pack2(b.x, b.y); o.w = pack2(b.z, b.w);
    ((u32x4*)dst)[i] = o;
  }
}

DI void phase_prep(const Params& p, char* smem) {
  const int tid = threadIdx.x;
  const long gtid = (long)blockIdx.x * 256 + tid, gsz = (long)gridDim.x * 256;
  {
    float* sS = (float*)smem;
    float* sR = sS + 9 * 256;
    for (int it = blockIdx.x; it < 768; it += gridDim.x) {
      const int kq = it & 3, cb = (it >> 2) % 96, l = it / 384;
      __syncthreads();
      for (int i = tid; i < 9 * 256; i += 256) {
        const int bi = i >> 8, k = kq * 256 + (i & 255);
        const float v = (bi < 8) ? p.c[bi * 1024 + k] : p.c_ctx[k];
        sS[i] = silu(v);
      }
      __syncthreads();
      const int col = cb * 64 + (tid & 63), kg = tid >> 6;
      const float* wp = p.ada_w + (long)l * 1024 * 6144 + (long)(kq * 256 + kg * 64) * 6144 + col;
      float acc[9];
#pragma unroll
      for (int i = 0; i < 9; ++i) acc[i] = 0.f;
#pragma unroll 8
      for (int k = 0; k < 64; ++k) {
        const float wv = wp[(long)k * 6144];
#pragma unroll
        for (int i = 0; i < 9; ++i) acc[i] += sS[i * 256 + kg * 64 + k] * wv;
      }
#pragma unroll
      for (int i = 0; i < 9; ++i) sR[(kg * 9 + i) * 64 + (tid & 63)] = acc[i];
      __syncthreads();
      for (int i = tid; i < 9 * 64; i += 256) {
        const int bi = i >> 6, cc = i & 63;
        float sm = sR[(0 * 9 + bi) * 64 + cc] + sR[(1 * 9 + bi) * 64 + cc] + sR[(2 * 9 + bi) * 64 + cc] + sR[(3 * 9 + bi) * 64 + cc];
        if (kq == 0) sm += p.ada_b[l * 6144 + cb * 64 + cc];
        atomicAdd(&p.MOD[((long)l * 9 + bi) * 6144 + cb * 64 + cc], sm);
      }
    }
    __syncthreads();
  }
  for (long i = gtid; i < 64 * 16; i += gsz) {
    const int pos = (int)(i >> 4), f = (int)(i & 15);
    const float ang = (float)pos * exp2f(-(float)f * (13.287712379549449f / 16.f));
    p.ROPE16[2 * i] = __cosf(ang); p.ROPE16[2 * i + 1] = __sinf(ang);
  }
  for (long i = gtid; i < 64 * 8; i += gsz) {
    const int pos = (int)(i >> 3), f = (int)(i & 7);
    const float ang = (float)pos * exp2f(-(float)f * (13.287712379549449f / 8.f));
    p.ROPE8[2 * i] = __cosf(ang); p.ROPE8[2 * i + 1] = __sinf(ang);
  }
  transpose_w(p.ab_w_in, 1024, 1312, 1408, p.WT_ABIN, gtid, gsz);
  transpose_w(p.ab_w_o, 1024, 1024, 1024, p.WT_ABO, gtid, gsz);
  transpose_w(p.b_w_uq, 256, 768, 768, p.WT_UQ, gtid, gsz);
  transpose_w(p.b_w_ukv, 256, 1024, 1024, p.WT_UKV, gtid, gsz);
  transpose_w(p.cd_w_in, 1024, 2304, 2304, p.WT_CDIN, gtid, gsz);
  transpose_w(p.cd_w_o, 1024, 1024, 1024, p.WT_CDO, gtid, gsz);
  transpose_w(p.peer_w_q, 1024, 2048, 2048, p.WT_PQ, gtid, gsz);
  transpose_w(p.peer_w_q + 1024L * 2048, 1024, 2048, 2048, p.WT_PQ + 2048L * 1024, gtid, gsz);
  convert8(p.peer_keys, p.KEYS16, 2L * 16 * 128 * 128 / 8, gtid, gsz);
}

DI void phase_modulate(const Params& p, const float* src_lat, const float* src_ctx, int nrows, const float* normw,
                       const float* modl, int sh_off, int sc_off) {
  const int lane = threadIdx.x & 63, w = threadIdx.x >> 6;
  const int stride = gridDim.x * 4;
  int m = blockIdx.x * 4 + w;
  f32x4 v[4], vn[4];
  f32x4 nw[4];
#pragma unroll
  for (int i = 0; i < 4; ++i) nw[i] = *(const f32x4*)(normw + i * 256 + lane * 4);
  if (m < nrows) {
    const float* src = (m < TL) ? src_lat + (long)m * 1024 : src_ctx + (long)(m - TL) * 1024;
#pragma unroll
    for (int i = 0; i < 4; ++i) v[i] = *(const f32x4*)(src + i * 256 + lane * 4);
  }
  while (m < nrows) {
    const int mn = m + stride;
    if (mn < nrows) {
      const float* src = (mn < TL) ? src_lat + (long)mn * 1024 : src_ctx + (long)(mn - TL) * 1024;
#pragma unroll
      for (int i = 0; i < 4; ++i) vn[i] = *(const f32x4*)(src + i * 256 + lane * 4);
    }
    const int bi = (m < TL) ? (m >> 11) : 8;
    const float* md = modl + bi * 6144;
    f32x4 sc[4], sh[4];
#pragma unroll
    for (int i = 0; i < 4; ++i) {
      sc[i] = *(const f32x4*)(md + sc_off + i * 256 + lane * 4);
      sh[i] = *(const f32x4*)(md + sh_off + i * 256 + lane * 4);
    }
    float ss = 0.f;
#pragma unroll
    for (int i = 0; i < 4; ++i) ss += v[i].x * v[i].x + v[i].y * v[i].y + v[i].z * v[i].z + v[i].w * v[i].w;
    ss = wsum_fast(ss);
    const float rstd = rsqrtf(ss * (1.f / 1024.f) + EPSF);
#pragma unroll
    for (int i = 0; i < 4; ++i) {
      const int col = i * 256 + lane * 4;
      const float y0 = v[i].x * rstd * nw[i].x * (1.f + sc[i].x) + sh[i].x;
      const float y1 = v[i].y * rstd * nw[i].y * (1.f + sc[i].y) + sh[i].y;
      const float y2 = v[i].z * rstd * nw[i].z * (1.f + sc[i].z) + sh[i].z;
      const float y3 = v[i].w * rstd * nw[i].w * (1.f + sc[i].w) + sh[i].w;
      u32x2 o = {pack2(y0, y1), pack2(y2, y3)};
      *(u32x2*)(p.HB + (long)m * 1024 + col) = o;
    }
#pragma unroll
    for (int i = 0; i < 4; ++i) v[i] = vn[i];
    m = mn;
  }
}

struct EpiArgs {
  void* C; int ldc; int N;
  const float* xin_lat; const float* xin_ctx; const float* g;
};
template <int EPI>
DI void gemm_phase(char* smem, const u16* __restrict__ A, int lda, int acs, const u16* __restrict__ Wt, int K, int MT, int NT,
                   int rot, const EpiArgs& ea) {
  u16* sAB = (u16*)smem;
  constexpr int STG = 2 * 128 * 72;
  const int tid = threadIdx.x, lane = tid & 63, w = tid >> 6, r = lane & 31, h = lane >> 5;
  const int wm = w >> 1, wn = w & 1;
  const int nslot = gridDim.x >> 3, xcd = blockIdx.x & 7;
  int first = ((int)(blockIdx.x >> 3) - rot) % nslot;
  if (first < 0) first += nslot;
  const int lrow = tid >> 3, lkc = tid & 7;
  const int per_xcd = (MT >> 3) * NT;
  for (int t = first; t < per_xcd; t += nslot) {
    const int mt = xcd + 8 * (t / NT), nt = t % NT;
    const u16* Ab = A + (long)(mt * 128 + lrow) * lda + nt * acs + lkc * 8;
    const u16* Bb = Wt + (long)(nt * 128 + lrow) * K + lkc * 8;
    f32x16 acc[2][2];
#pragma unroll
    for (int i = 0; i < 2; ++i)
#pragma unroll
      for (int j = 0; j < 2; ++j) acc[i][j] = zero16();
    u32x4 ra0[4], rb0[4], ra1[4], rb1[4];
    const int nk = K >> 6;
#pragma unroll
    for (int i = 0; i < 4; ++i) {
      ra0[i] = *(const u32x4*)(Ab + (long)(32 * i) * lda);
      rb0[i] = *(const u32x4*)(Bb + (long)(32 * i) * K);
    }
#pragma unroll
    for (int i = 0; i < 4; ++i) {
      ra1[i] = *(const u32x4*)(Ab + (long)(32 * i) * lda + 64);
      rb1[i] = *(const u32x4*)(Bb + (long)(32 * i) * K + 64);
    }
    __syncthreads();
#pragma unroll
    for (int i = 0; i < 4; ++i) {
      *(u32x4*)(sAB + (lrow + 32 * i) * 72 + lkc * 8) = ra0[i];
      *(u32x4*)(sAB + 128 * 72 + (lrow + 32 * i) * 72 + lkc * 8) = rb0[i];
    }
    __syncthreads();
    for (int k0 = 0; k0 < nk; k0 += 2) {
      if (k0 + 2 < nk) {
#pragma unroll
        for (int i = 0; i < 4; ++i) {
          ra0[i] = *(const u32x4*)(Ab + (long)(32 * i) * lda + (k0 + 2) * 64);
          rb0[i] = *(const u32x4*)(Bb + (long)(32 * i) * K + (k0 + 2) * 64);
        }
      }
      {
        const u16* cA = sAB;
        const u16* cB = cA + 128 * 72;
#pragma unroll
        for (int ks = 0; ks < 4; ++ks) {
          bf16x8 af[2], bfr[2];
#pragma unroll
          for (int i = 0; i < 2; ++i) {
            af[i] = *(const bf16x8*)(cA + (wm * 64 + i * 32 + r) * 72 + ks * 16 + h * 8);
            bfr[i] = *(const bf16x8*)(cB + (wn * 64 + i * 32 + r) * 72 + ks * 16 + h * 8);
          }
#pragma unroll
          for (int i = 0; i < 2; ++i)
#pragma unroll
            for (int j = 0; j < 2; ++j) acc[i][j] = MFMA(af[i], bfr[j], acc[i][j]);
        }
      }
      {
        u16* nA = sAB + STG;
#pragma unroll
        for (int i = 0; i < 4; ++i) {
          *(u32x4*)(nA + (lrow + 32 * i) * 72 + lkc * 8) = ra1[i];
          *(u32x4*)(nA + 128 * 72 + (lrow + 32 * i) * 72 + lkc * 8) = rb1[i];
        }
        __syncthreads();
      }
      if (k0 + 3 < nk) {
#pragma unroll
        for (int i = 0; i < 4; ++i) {
          ra1[i] = *(const u32x4*)(Ab + (long)(32 * i) * lda + (k0 + 3) * 64);
          rb1[i] = *(const u32x4*)(Bb + (long)(32 * i) * K + (k0 + 3) * 64);
        }
      }
      {
        const u16* cA = sAB + STG;
        const u16* cB = cA + 128 * 72;
#pragma unroll
        for (int ks = 0; ks < 4; ++ks) {
          bf16x8 af[2], bfr[2];
#pragma unroll
          for (int i = 0; i < 2; ++i) {
            af[i] = *(const bf16x8*)(cA + (wm * 64 + i * 32 + r) * 72 + ks * 16 + h * 8);
            bfr[i] = *(const bf16x8*)(cB + (wn * 64 + i * 32 + r) * 72 + ks * 16 + h * 8);
          }
#pragma unroll
          for (int i = 0; i < 2; ++i)
#pragma unroll
            for (int j = 0; j < 2; ++j) acc[i][j] = MFMA(af[i], bfr[j], acc[i][j]);
        }
      }
      if (k0 + 2 < nk) {
        u16* nA = sAB;
#pragma unroll
        for (int i = 0; i < 4; ++i) {
          *(u32x4*)(nA + (lrow + 32 * i) * 72 + lkc * 8) = ra0[i];
          *(u32x4*)(nA + 128 * 72 + (lrow + 32 * i) * 72 + lkc * 8) = rb0[i];
        }
        __syncthreads();
      }
    }
#pragma unroll
    for (int i = 0; i < 2; ++i)
#pragma unroll
      for (int j = 0; j < 2; ++j) {
        const int n = nt * 128 + wn * 64 + j * 32 + r;
        if (n < ea.N) {
#pragma unroll
          for (int reg = 0; reg < 16; ++reg) {
            const int m = mt * 128 + wm * 64 + i * 32 + crow(reg, h);
            const float v = acc[i][j][reg];
            if (EPI == 0) {
              ((u16*)ea.C)[(long)m * ea.ldc + n] = f2bf(v);
            } else if (EPI == 1) {
              ((float*)ea.C)[(long)m * ea.ldc + n] = v;
            } else {
              const int bi = (m < TL) ? (m >> 11) : 8;
              const float g = ea.g[bi * 6144 + n];
              float* dst = (float*)ea.C + (long)m * 1024 + n;
              float base;
              if (EPI == 2) base = (m < TL) ? ea.xin_lat[(long)m * 1024 + n] : ea.xin_ctx[(long)(m - TL) * 1024 + n];
              else base = *dst;
              *dst = base + g * v;
            }
          }
        }
      }
  }
}

DI void gemm_pq_scores(char* smem, const u16* __restrict__ A, const u16* __restrict__ Wt, const u16* __restrict__ KEYS, float* __restrict__ SC, int MT) {
  constexpr int lda = 1024, acs = 0, K = 1024, NT = 16, rot = 0;
  u16* sAB = (u16*)smem;
  constexpr int STG = 2 * 128 * 72;
  const int tid = threadIdx.x, lane = tid & 63, w = tid >> 6, r = lane & 31, h = lane >> 5;
  const int wm = w >> 1, wn = w & 1;
  const int nslot = gridDim.x >> 3, xcd = blockIdx.x & 7;
  int first = ((int)(blockIdx.x >> 3) - rot) % nslot;
  if (first < 0) first += nslot;
  const int lrow = tid >> 3, lkc = tid & 7;
  const int per_xcd = (MT >> 3) * NT;
  for (int t = first; t < per_xcd; t += nslot) {
    const int mt = xcd + 8 * (t / NT), nt = t % NT;
    const u16* Ab = A + (long)(mt * 128 + lrow) * lda + nt * acs + lkc * 8;
    const u16* Bb = Wt + (long)(nt * 128 + lrow) * K + lkc * 8;
    f32x16 acc[2][2];
#pragma unroll
    for (int i = 0; i < 2; ++i)
#pragma unroll
      for (int j = 0; j < 2; ++j) acc[i][j] = zero16();
    u32x4 ra0[4], rb0[4], ra1[4], rb1[4];
    const int nk = K >> 6;
#pragma unroll
    for (int i = 0; i < 4; ++i) {
      ra0[i] = *(const u32x4*)(Ab + (long)(32 * i) * lda);
      rb0[i] = *(const u32x4*)(Bb + (long)(32 * i) * K);
    }
#pragma unroll
    for (int i = 0; i < 4; ++i) {
      ra1[i] = *(const u32x4*)(Ab + (long)(32 * i) * lda + 64);
      rb1[i] = *(const u32x4*)(Bb + (long)(32 * i) * K + 64);
    }
    __syncthreads();
#pragma unroll
    for (int i = 0; i < 4; ++i) {
      *(u32x4*)(sAB + (lrow + 32 * i) * 72 + lkc * 8) = ra0[i];
      *(u32x4*)(sAB + 128 * 72 + (lrow + 32 * i) * 72 + lkc * 8) = rb0[i];
    }
    __syncthreads();
    for (int k0 = 0; k0 < nk; k0 += 2) {
      if (k0 + 2 < nk) {
#pragma unroll
        for (int i = 0; i < 4; ++i) {
          ra0[i] = *(const u32x4*)(Ab + (long)(32 * i) * lda + (k0 + 2) * 64);
          rb0[i] = *(const u32x4*)(Bb + (long)(32 * i) * K + (k0 + 2) * 64);
        }
      }
      {
        const u16* cA = sAB;
        const u16* cB = cA + 128 * 72;
#pragma unroll
        for (int ks = 0; ks < 4; ++ks) {
          bf16x8 af[2], bfr[2];
#pragma unroll
          for (int i = 0; i < 2; ++i) {
            af[i] = *(const bf16x8*)(cA + (wm * 64 + i * 32 + r) * 72 + ks * 16 + h * 8);
            bfr[i] = *(const bf16x8*)(cB + (wn * 64 + i * 32 + r) * 72 + ks * 16 + h * 8);
          }
#pragma unroll
          for (int i = 0; i < 2; ++i)
#pragma unroll
            for (int j = 0; j < 2; ++j) acc[i][j] = MFMA(bfr[j], af[i], acc[i][j]);
        }
      }
      {
        u16* nA = sAB + STG;
#pragma unroll
        for (int i = 0; i < 4; ++i) {
          *(u32x4*)(nA + (lrow + 32 * i) * 72 + lkc * 8) = ra1[i];
          *(u32x4*)(nA + 128 * 72 + (lrow + 32 * i) * 72 + lkc * 8) = rb1[i];
        }
        __syncthreads();
      }
      if (k0 + 3 < nk) {
#pragma unroll
        for (int i = 0; i < 4; ++i) {
          ra1[i] = *(const u32x4*)(Ab + (long)(32 * i) * lda + (k0 + 3) * 64);
          rb1[i] = *(const u32x4*)(Bb + (long)(32 * i) * K + (k0 + 3) * 64);
        }
      }
      {
        const u16* cA = sAB + STG;
        const u16* cB = cA + 128 * 72;
#pragma unroll
        for (int ks = 0; ks < 4; ++ks) {
          bf16x8 af[2], bfr[2];
#pragma unroll
          for (int i = 0; i < 2; ++i) {
            af[i] = *(const bf16x8*)(cA + (wm * 64 + i * 32 + r) * 72 + ks * 16 + h * 8);
            bfr[i] = *(const bf16x8*)(cB + (wn * 64 + i * 32 + r) * 72 + ks * 16 + h * 8);
          }
#pragma unroll
          for (int i = 0; i < 2; ++i)
#pragma unroll
            for (int j = 0; j < 2; ++j) acc[i][j] = MFMA(bfr[j], af[i], acc[i][j]);
        }
      }
      if (k0 + 2 < nk) {
        u16* nA = sAB;
#pragma unroll
        for (int i = 0; i < 4; ++i) {
          *(u32x4*)(nA + (lrow + 32 * i) * 72 + lkc * 8) = ra0[i];
          *(u32x4*)(nA + 128 * 72 + (lrow + 32 * i) * 72 + lkc * 8) = rb0[i];
        }
        __syncthreads();
      }
    }
    u16* sQ = (u16*)smem;
    u16* sKy = sQ + 128 * 136;
    u32x4 kreg[8];
    {
      const u16* kp = KEYS + (long)nt * 128 * 128;
#pragma unroll
      for (int i = 0; i < 8; ++i) { const int c = tid + i * 256; kreg[i] = *(const u32x4*)(kp + (long)(c >> 4) * 128 + (c & 15) * 8); }
    }
    __syncthreads();
#pragma unroll
    for (int i = 0; i < 2; ++i)
#pragma unroll
      for (int j = 0; j < 2; ++j)
#pragma unroll
        for (int g = 0; g < 4; ++g) {
          u32x2 o = {pack2(acc[i][j][4 * g], acc[i][j][4 * g + 1]), pack2(acc[i][j][4 * g + 2], acc[i][j][4 * g + 3])};
          *(u32x2*)(sQ + (wm * 64 + i * 32 + r) * 136 + wn * 64 + j * 32 + 8 * g + 4 * h) = o;
        }
#pragma unroll
    for (int i = 0; i < 8; ++i) { const int c = tid + i * 256; *(u32x4*)(sKy + (c >> 4) * 136 + (c & 15) * 8) = kreg[i]; }
    __syncthreads();
#pragma unroll
    for (int i = 0; i < 2; ++i)
#pragma unroll
      for (int j = 0; j < 2; ++j) acc[i][j] = zero16();
#pragma unroll
    for (int ks = 0; ks < 8; ++ks) {
      bf16x8 af[2], bfr[2];
#pragma unroll
      for (int i = 0; i < 2; ++i) {
        af[i] = *(const bf16x8*)(sQ + (wm * 64 + i * 32 + r) * 136 + ks * 16 + h * 8);
        bfr[i] = *(const bf16x8*)(sKy + (wn * 64 + i * 32 + r) * 136 + ks * 16 + h * 8);
      }
#pragma unroll
      for (int i = 0; i < 2; ++i)
#pragma unroll
        for (int j = 0; j < 2; ++j) acc[i][j] = MFMA(af[i], bfr[j], acc[i][j]);
    }
#pragma unroll
    for (int i = 0; i < 2; ++i)
#pragma unroll
      for (int j = 0; j < 2; ++j) {
        const int n = nt * 128 + wn * 64 + j * 32 + r;
#pragma unroll
        for (int reg = 0; reg < 16; ++reg) {
          const int m = mt * 128 + wm * 64 + i * 32 + crow(reg, h);
          SC[(long)m * 2048 + n] = acc[i][j][reg];
        }
      }
  }
}

DI float rope64(float y, int lane, int prow, int pcol, const float* __restrict__ R16) {
  const float partner = __shfl_xor(y, 16);
  const int pos = (lane < 32) ? prow : pcol;
  const f32x2 cs = *(const f32x2*)(R16 + (pos * 16 + (lane & 15)) * 2);
  return (lane & 16) ? (y * cs.x + partner * cs.y) : (y * cs.x - partner * cs.y);
}
DI float rope32(float y, int lane, int prow, int pcol, const float* __restrict__ R8) {
  const float partner = __shfl_xor(y, 8);
  const int pp = lane & 31;
  const int pos = (pp < 16) ? prow : pcol;
  const f32x2 cs = *(const f32x2*)(R8 + (pos * 8 + (pp & 7)) * 2);
  return (pp & 8) ? (y * cs.x + partner * cs.y) : (y * cs.x - partner * cs.y);
}

template <int CTRL>
DI float dppf(float v) { return __builtin_bit_cast(float, __builtin_amdgcn_update_dpp(0, __builtin_bit_cast(int, v), CTRL, 0xf, 0xf, false)); }
DI void unpack8(u32x4 r, float* x) {
#pragma unroll
  for (int q = 0; q < 4; ++q) { x[2 * q] = bflo(r[q]); x[2 * q + 1] = bfhi(r[q]); }
}
DI u32x4 pack8f(const float* y) { u32x4 o = {pack2(y[0], y[1]), pack2(y[2], y[3]), pack2(y[4], y[5]), pack2(y[6], y[7])}; return o; }
DI float sumsq8(const float* x) { float s = 0.f;
#pragma unroll
  for (int j = 0; j < 8; ++j) s += x[j] * x[j];
  return s; }
DI float sum_group8(float v) { v += dppf<0xB1>(v); v += dppf<0x4E>(v); v += dppf<0x141>(v); return v; }
DI void rope_head64(float* y, int cc8, const float* cs) {
  const bool second = (cc8 & 2) != 0;
#pragma unroll
  for (int j = 0; j < 8; ++j) {
    const float pr = dppf<0x4E>(y[j]);
    y[j] = second ? (y[j] * cs[2 * j] + pr * cs[2 * j + 1]) : (y[j] * cs[2 * j] - pr * cs[2 * j + 1]);
  }
}
DI void load_cs8(const float* tab, float* cs) {
#pragma unroll
  for (int q = 0; q < 4; ++q) { const f32x4 t = *(const f32x4*)(tab + q * 4); cs[4 * q] = t.x; cs[4 * q + 1] = t.y; cs[4 * q + 2] = t.z; cs[4 * q + 3] = t.w; }
}
DI void load_w8(const float* wsrc, float* wv) {
  const f32x4 a = *(const f32x4*)wsrc, b = *(const f32x4*)(wsrc + 4);
  wv[0] = a.x; wv[1] = a.y; wv[2] = a.z; wv[3] = a.w; wv[4] = b.x; wv[5] = b.y; wv[6] = b.z; wv[7] = b.w;
}
DI void phase_post0a(const Params& p) {
  const int lane = threadIdx.x & 63, w = threadIdx.x >> 6, cc8 = lane & 7;
  float wq[8], wk[8], wl[8];
  load_w8(p.a_q_norm + cc8 * 8, wq);
  load_w8(p.a_k_norm + cc8 * 8, wk);
  load_w8((lane < 32 ? p.b_kv_lora_norm : p.b_q_lora_norm) + (lane & 31) * 8, wl);
  const int offB = (lane < 32) ? 512 + (lane & 15) * 8 : 768 + (lane - 32) * 8;
  const int stride = gridDim.x * 4;
  int m = blockIdx.x * 4 + w;
  u32x4 rA, rB, rC, nA, nB, nC;
  if (m < TA) {
    const u16* z0 = p.Z + (long)m * 1312;
    rA = *(const u32x4*)(z0 + lane * 8); rB = *(const u32x4*)(z0 + offB); rC = *(const u32x4*)(z0 + 1024 + (lane & 31) * 8);
  }
  for (; m < TA; m += stride) {
    u16* z = p.Z + (long)m * 1312;
    const bool lat = m < TL;
    const int s = m & 2047, prow = s >> 6, pcol = s & 63;
    if (m + stride < TA) {
      const u16* zn = p.Z + (long)(m + stride) * 1312;
      nA = *(const u32x4*)(zn + lane * 8); nB = *(const u32x4*)(zn + offB); nC = *(const u32x4*)(zn + 1024 + (lane & 31) * 8);
    }
    float cs[16];
    load_cs8(p.ROPE16 + ((((cc8 < 4) ? prow : pcol) * 16 + (cc8 & 1) * 8) * 2), cs);
    float x[8];
    {
      unpack8(rA, x);
      const float rstd = rsqrtf(sum_group8(sumsq8(x)) * (1.f / 64.f) + EPSF);
#pragma unroll
      for (int j = 0; j < 8; ++j) x[j] *= rstd * wq[j] * (0.125f * LOG2E);
      if (lat) rope_head64(x, cc8, cs);
      *(u32x4*)(z + lane * 8) = pack8f(x);
    }
    {
      unpack8(rB, x);
      const float ssq = sumsq8(x);
      const float g8 = sum_group8(ssq);
      const float r16 = rowsum16(ssq);
      const int ir = __builtin_bit_cast(int, r16);
      const float t256 = __builtin_bit_cast(float, __builtin_amdgcn_readlane(ir, 32)) + __builtin_bit_cast(float, __builtin_amdgcn_readlane(ir, 48));
      if (lane < 32) {
        const float rstd = rsqrtf(g8 * (1.f / 64.f) + EPSF);
#pragma unroll
        for (int j = 0; j < 8; ++j) x[j] *= rstd * wk[j];
      } else {
        const float rstd = rsqrtf(t256 * (1.f / 256.f) + EPSF);
#pragma unroll
        for (int j = 0; j < 8; ++j) x[j] *= rstd * wl[j];
      }
      float xr[8];
#pragma unroll
      for (int j = 0; j < 8; ++j) xr[j] = x[j];
      rope_head64(xr, cc8, cs);
      if (lat && lane < 16) {
#pragma unroll
        for (int j = 0; j < 8; ++j) x[j] = xr[j];
      }
      if (lane < 16 || lane >= 32) *(u32x4*)(z + offB) = pack8f(x);
    }
    {
      unpack8(rC, x);
      const float r16 = rowsum16(sumsq8(x));
      const int ir = __builtin_bit_cast(int, r16);
      const float t256 = __builtin_bit_cast(float, __builtin_amdgcn_readlane(ir, 0)) + __builtin_bit_cast(float, __builtin_amdgcn_readlane(ir, 16));
      const float rstd = rsqrtf(t256 * (1.f / 256.f) + EPSF);
#pragma unroll
      for (int j = 0; j < 8; ++j) x[j] *= rstd * wl[j];
      if (lane < 32) *(u32x4*)(z + 1024 + lane * 8) = pack8f(x);
    }
    rA = nA; rB = nB; rC = nC;
  }
}
DI void rope_tail96(float* y, int c16, const float* cs) {
  const bool second = (c16 & 1) != 0;
#pragma unroll
  for (int j = 0; j < 8; ++j) {
    const float pr = dppf<0xB1>(y[j]);
    const float rz = second ? (y[j] * cs[2 * j] + pr * cs[2 * j + 1]) : (y[j] * cs[2 * j] - pr * cs[2 * j + 1]);
    y[j] = (c16 >= 8) ? rz : y[j];
  }
}
DI void phase_post0b(const Params& p) {
  const int lane = threadIdx.x & 63, w = threadIdx.x >> 6, c16 = lane & 15, hr = lane >> 4;
  const bool act = c16 < 12;
  float wq[8], wk[8];
  load_w8(p.b_q_norm + (act ? c16 : 0) * 8, wq);
  load_w8(p.b_k_norm + (act ? c16 : 0) * 8, wk);
  for (int m = blockIdx.x * 4 + w; m < TA; m += gridDim.x * 4) {
    const bool lat = m < TL;
    const int s = m & 2047, prow = s >> 6, pcol = s & 63;
    u16* q = p.QB + (long)m * 768;
    const u16* kv = p.KVR + (long)m * 1024;
    u16* kb = p.KB + (long)m * 768;
    u16* vb = p.VB + (long)m * 512;
    const u16* kr = p.Z + (long)m * 1312 + 1280;
    const u32x4 zero4 = {0u, 0u, 0u, 0u};
    u32x4 rq[2], rk[2];
#pragma unroll
    for (int ps = 0; ps < 2; ++ps) {
      const int hd = ps * 4 + hr;
      rq[ps] = act ? *(const u32x4*)(q + hd * 96 + c16 * 8) : zero4;
      rk[ps] = act ? ((c16 < 8) ? *(const u32x4*)(kv + hd * 128 + c16 * 8) : *(const u32x4*)(kr + (c16 - 8) * 8)) : zero4;
    }
    const u32x4 rv = *(const u32x4*)(kv + (lane >> 3) * 128 + 64 + (lane & 7) * 8);
    float cs[16];
    load_cs8(p.ROPE8 + ((((c16 < 10) ? prow : pcol) * 8) * 2), cs);
    float x[8];
#pragma unroll
    for (int ps = 0; ps < 2; ++ps) {
      const int hd = ps * 4 + hr;
      unpack8(rq[ps], x);
      float rstd = rsqrtf(rowsum16(sumsq8(x)) * (1.f / 96.f) + EPSF);
#pragma unroll
      for (int j = 0; j < 8; ++j) x[j] *= rstd * wq[j] * (0.10206207261596575f * LOG2E);
      if (lat) rope_tail96(x, c16, cs);
      if (act) *(u32x4*)(q + hd * 96 + c16 * 8) = pack8f(x);
      unpack8(rk[ps], x);
      rstd = rsqrtf(rowsum16(sumsq8(x)) * (1.f / 96.f) + EPSF);
#pragma unroll
      for (int j = 0; j < 8; ++j) x[j] *= rstd * wk[j];
      if (lat) rope_tail96(x, c16, cs);
      if (act) *(u32x4*)(kb + hd * 96 + c16 * 8) = pack8f(x);
    }
    *(u32x4*)(vb + lane * 8) = rv;
  }
}
DI void phase_post1(const Params& p) {
  const int lane = threadIdx.x & 63, w = threadIdx.x >> 6, cc8 = lane & 7;
  float wq[8], wk[8];
  load_w8(p.d_q_norm + cc8 * 8, wq);
  load_w8(p.d_k_norm + cc8 * 8, wk);
  const int stride = gridDim.x * 4;
  int m = blockIdx.x * 4 + w;
  u32x4 rA, rB, rC, nA, nB, nC;
  if (m < TA) {
    const u16* z0 = p.Z + (long)m * 2304;
    rA = *(const u32x4*)(z0 + lane * 8); rB = *(const u32x4*)(z0 + 1536 + lane * 8); rC = *(const u32x4*)(z0 + 2048 + (lane & 15) * 8);
  }
  for (; m < TA; m += stride) {
    u16* z = p.Z + (long)m * 2304;
    const bool lat = m < TL;
    const int s = m & 2047, prow = s >> 6, pcol = s & 63;
    if (m + stride < TA) {
      const u16* zn = p.Z + (long)(m + stride) * 2304;
      nA = *(const u32x4*)(zn + lane * 8); nB = *(const u32x4*)(zn + 1536 + lane * 8); nC = *(const u32x4*)(zn + 2048 + (lane & 15) * 8);
    }
    float cs[16];
    load_cs8(p.ROPE16 + ((((cc8 < 4) ? prow : pcol) * 16 + (cc8 & 1) * 8) * 2), cs);
    float x[8];
    {
      unpack8(rA, x);
      const float sc = (lane >= 32) ? 0.125f : 1.f;
#pragma unroll
      for (int j = 0; j < 8; ++j) x[j] *= sc;
      if (lat) rope_head64(x, cc8, cs);
      if (lat || lane >= 32) *(u32x4*)(z + lane * 8) = pack8f(x);
    }
    {
      unpack8(rB, x);
      const float rstd = rsqrtf(sum_group8(sumsq8(x)) * (1.f / 64.f) + EPSF);
#pragma unroll
      for (int j = 0; j < 8; ++j) x[j] *= rstd * wq[j] * (0.125f * LOG2E);
      if (lat) rope_head64(x, cc8, cs);
      *(u32x4*)(z + 1536 + lane * 8) = pack8f(x);
    }
    {
      unpack8(rC, x);
      const float rstd = rsqrtf(sum_group8(sumsq8(x)) * (1.f / 64.f) + EPSF);
#pragma unroll
      for (int j = 0; j < 8; ++j) x[j] *= rstd * wk[j];
      if (lat) rope_head64(x, cc8, cs);
      if (lane < 16) *(u32x4*)(z + 2048 + lane * 8) = pack8f(x);
    }
    rA = nA; rB = nB; rC = nC;
  }
}

template <int DQK>
DI void attn_item(char* smem, const u16* __restrict__ Qp, int qs, const u16* __restrict__ K0, const u16* __restrict__ V0,
                  int ks0, int vs0, int n0, const u16* __restrict__ K1, const u16* __restrict__ V1, int ks1, int vs1, int kbeg,
                  int kend, bool band, int qpos0, float scale, bool has_sink, float sink, u16* __restrict__ Op, int os) {
  constexpr int KSTR = DQK + 8, VROW = 96, KCH = DQK / 8, NKL = (64 * KCH) / 256;
  constexpr int NKS = DQK / 16;
  u16* sK = (u16*)smem;
  u16* sV = sK + 64 * KSTR;
  const int tid = threadIdx.x, lane = tid & 63, w = tid >> 6, r = lane & 31, h = lane >> 5;
  bf16x8 qf[NKS];
#pragma unroll
  for (int ks = 0; ks < NKS; ++ks) qf[ks] = *(const bf16x8*)(Qp + (long)(w * 32 + r) * qs + ks * 16 + h * 8);
  f32x16 oT[2];
  oT[0] = zero16(); oT[1] = zero16();
  (void)scale;
  float mrun = has_sink ? sink * LOG2E : -1e30f;
  float lrun = (has_sink && h == 0) ? 1.f : 0.f;
  const int nt0 = n0 >> 6, nt1 = (kend - kbeg) >> 6, ntot = nt0 + nt1;
  const int qpos = qpos0 + w * 32 + r;
  u32x4 rk[NKL], rv[2];
  auto tile_ptrs = [&](int t, const u16*& kp, const u16*& vp, int& kst, int& vst) {
    if (t < nt0) { kp = K0 + (long)(t * 64) * ks0; vp = V0 + (long)(t * 64) * vs0; kst = ks0; vst = vs0; }
    else { const int k0 = kbeg + (t - nt0) * 64; kp = K1 + (long)k0 * ks1; vp = V1 + (long)k0 * vs1; kst = ks1; vst = vs1; }
  };
  {
    const u16 *kp, *vp; int kst, vst;
    tile_ptrs(0, kp, vp, kst, vst);
#pragma unroll
    for (int i = 0; i < NKL; ++i) { const int c = tid + i * 256, key = c / KCH, kc = c % KCH; rk[i] = *(const u32x4*)(kp + (long)key * kst + kc * 8); }
#pragma unroll
    for (int i = 0; i < 2; ++i) { const int c = tid + i * 256, key = c >> 3, dc = c & 7; rv[i] = *(const u32x4*)(vp + (long)key * vst + dc * 8); }
  }
  for (int t = 0; t < ntot; ++t) {
    __syncthreads();
#pragma unroll
    for (int i = 0; i < NKL; ++i) { const int c = tid + i * 256, key = c / KCH, kc = c % KCH; *(u32x4*)(sK + key * KSTR + kc * 8) = rk[i]; }
#pragma unroll
    for (int i = 0; i < 2; ++i) { const int c = tid + i * 256, key = c >> 3, dc = c & 7; *(u32x4*)(sV + key * VROW + dc * 8) = rv[i]; }
    __syncthreads();
    if (t + 1 < ntot) {
      const u16 *kp, *vp; int kst, vst;
      tile_ptrs(t + 1, kp, vp, kst, vst);
#pragma unroll
      for (int i = 0; i < NKL; ++i) { const int c = tid + i * 256, key = c / KCH, kc = c % KCH; rk[i] = *(const u32x4*)(kp + (long)key * kst + kc * 8); }
#pragma unroll
      for (int i = 0; i < 2; ++i) { const int c = tid + i * 256, key = c >> 3, dc = c & 7; rv[i] = *(const u32x4*)(vp + (long)key * vst + dc * 8); }
    }
    f32x16 sT[2];
    sT[0] = zero16(); sT[1] = zero16();
#pragma unroll
    for (int kt = 0; kt < 2; ++kt)
#pragma unroll
      for (int ks = 0; ks < NKS; ++ks) {
        const bf16x8 kf = *(const bf16x8*)(sK + (kt * 32 + r) * KSTR + ks * 16 + h * 8);
        sT[kt] = MFMA(kf, qf[ks], sT[kt]);
      }
    const bool masked = band && (t >= nt0);
    const int kbase = kbeg + (t - nt0) * 64;
    float mx = -1e30f;
#pragma unroll
    for (int kt = 0; kt < 2; ++kt)
#pragma unroll
      for (int reg = 0; reg < 16; ++reg) {
        float sv = sT[kt][reg];
        if (masked) {
          const int kpos = kbase + kt * 32 + crow(reg, h);
          const int d = qpos - kpos;
          if (d > 128 || d < -128) sv = -1e30f;
        }
        sT[kt][reg] = sv;
        mx = fmaxf(mx, sv);
      }
    mx = fmaxf(mx, __shfl_xor(mx, 32));
    const float mnew = fmaxf(mrun, mx);
    const float alpha = ex2(mrun - mnew);
    mrun = mnew;
    float ps = 0.f;
#pragma unroll
    for (int kt = 0; kt < 2; ++kt)
#pragma unroll
      for (int reg = 0; reg < 16; ++reg) {
        const float pv = ex2(sT[kt][reg] - mnew);
        sT[kt][reg] = pv;
        ps += pv;
      }
    lrun = lrun * alpha + ps;
#pragma unroll
    for (int dt = 0; dt < 2; ++dt)
#pragma unroll
      for (int reg = 0; reg < 16; ++reg) oT[dt][reg] *= alpha;
#pragma unroll
    for (int kt = 0; kt < 2; ++kt)
#pragma unroll
      for (int s = 0; s < 2; ++s) {
        const bf16x8 pf = pack8(sT[kt], s);
#pragma unroll
        for (int dt = 0; dt < 2; ++dt) {
          const u16* vb0 = sV + (kt * 32 + s * 16 + 4 * h + ((lane & 15) >> 2)) * VROW + dt * 32 + ((lane >> 4) & 1) * 16 + (lane & 3) * 4;
          const s16x4 lo4 = __builtin_amdgcn_ds_read_tr16_b64_v4i16((LDS3 s16x4*)vb0);
          const s16x4 hi4 = __builtin_amdgcn_ds_read_tr16_b64_v4i16((LDS3 s16x4*)(vb0 + 8 * VROW));
          const bf16x8 vf = __builtin_shufflevector(lo4, hi4, 0, 1, 2, 3, 4, 5, 6, 7);
          oT[dt] = MFMA(vf, pf, oT[dt]);
        }
      }
  }
  const float ltot = lrun + __shfl_xor(lrun, 32);
  const float inv = 1.f / ltot;
#pragma unroll
  for (int dt = 0; dt < 2; ++dt)
#pragma unroll
    for (int g = 0; g < 4; ++g) {
      u32x2 o = {pack2(oT[dt][4 * g] * inv, oT[dt][4 * g + 1] * inv), pack2(oT[dt][4 * g + 2] * inv, oT[dt][4 * g + 3] * inv)};
      *(u32x2*)(Op + (long)(w * 32 + r) * os + dt * 32 + 8 * g + 4 * h) = o;
    }
}

DI void phase_attn0(const Params& p, char* smem) {
  const float sc96 = 0.10206207261596575f;
  for (int id = blockIdx.x; id < 2304; id += gridDim.x) {
    if (id < 1024) {
      const int b = id >> 7, hd = (id >> 4) & 7, qb = id & 15;
      const long qrow = (long)b * 2048 + qb * 128, crw = (long)TL + b * 256, lrow = (long)b * 2048;
      attn_item<96>(smem, p.QB + qrow * 768 + hd * 96, 768, p.KB + crw * 768 + hd * 96, p.VB + crw * 512 + hd * 64, 768, 512, 256,
                    p.KB + lrow * 768 + hd * 96, p.VB + lrow * 512 + hd * 64, 768, 512, 0, 2048, false, 0, sc96, false, 0.f,
                    p.AO + qrow * 1024 + 512 + hd * 64, 1024);
    } else if (id < 2048) {
      const int i2 = id - 1024;
      const int b = i2 >> 7, hd = (i2 >> 4) & 7, qb = i2 & 15, kvh = hd >> 2;
      const long qrow = (long)b * 2048 + qb * 128, crw = (long)TL + b * 256, lrow = (long)b * 2048;
      const int kbeg = (qb * 128 - 128) < 0 ? 0 : (qb * 128 - 128);
      const int kend = (qb * 128 + 256) > 2048 ? 2048 : (qb * 128 + 256);
      attn_item<64>(smem, p.Z + qrow * 1312 + hd * 64, 1312, p.Z + crw * 1312 + 512 + kvh * 64, p.Z + crw * 1312 + 640 + kvh * 64, 1312,
                    1312, 256, p.Z + lrow * 1312 + 512 + kvh * 64, p.Z + lrow * 1312 + 640 + kvh * 64, 1312, 1312, kbeg, kend, true,
                    qb * 128, 0.125f, true, p.a_sink[hd], p.AO + qrow * 1024 + hd * 64, 1024);
    } else if (id < 2176) {
      const int i2 = id - 2048;
      const int b = i2 >> 4, hd = (i2 >> 1) & 7, qb = i2 & 1, kvh = hd >> 2;
      const long qrow = (long)TL + b * 256 + qb * 128, crw = (long)TL + b * 256;
      attn_item<64>(smem, p.Z + qrow * 1312 + hd * 64, 1312, p.Z + crw * 1312 + 512 + kvh * 64, p.Z + crw * 1312 + 640 + kvh * 64, 1312,
                    1312, 256, p.Z, p.Z, 1312, 1312, 0, 0, false, 0, 0.125f, true, p.a_sink[hd], p.AO + qrow * 1024 + hd * 64, 1024);
    } else {
      const int i2 = id - 2176;
      const int b = i2 >> 4, hd = (i2 >> 1) & 7, qb = i2 & 1;
      const long qrow = (long)TL + b * 256 + qb * 128, crw = (long)TL + b * 256;
      attn_item<96>(smem, p.QB + qrow * 768 + hd * 96, 768, p.KB + crw * 768 + hd * 96, p.VB + crw * 512 + hd * 64, 768, 512, 256,
                    p.KB, p.VB, 768, 512, 0, 0, false, 0, sc96, false, 0.f, p.AO + qrow * 1024 + 512 + hd * 64, 1024);
    }
  }
}

DI long ret_row(int b, int dir, int c, int pp) {
  const int q = (c < 2) ? c * 128 + pp : (c - 2) * 128 + pp;
  if (c < 2) return (long)TL + b * 256 + (dir ? 255 - q : q);
  return (long)b * 2048 + (dir ? 2047 - q : q);
}
DI void ret_local_item(const Params& p, char* smem, int id) {
  const int c = id % 18, dir = (id / 18) & 1, hh = (id / 36) & 3, b = id / 144;
  u16* sK = (u16*)smem;
  u16* sV = sK + 128 * 64;
  float* sW = (float*)(sV + 128 * 128);
  const int tid = threadIdx.x;
  const float lg = log_sigmoid((dir ? p.c_decay_bwd : p.c_decay_fwd)[hh]);
  __syncthreads();
  for (int i = tid; i < 128 * 8; i += 256) {
    const int pp = i >> 3, ch = i & 7;
    const long row = ret_row(b, dir, c, pp);
    *(u32x4*)(sK + pp * 64 + ch * 8) = *(const u32x4*)(p.Z + row * 2304 + 256 + hh * 64 + ch * 8);
  }
  for (int i = tid; i < 128 * 16; i += 256) {
    const int pp = i >> 4, ch = i & 15;
    const long row = ret_row(b, dir, c, pp);
    *(u32x4*)(sV + pp * 128 + ch * 8) = *(const u32x4*)(p.Z + row * 2304 + 512 + hh * 128 + ch * 8);
  }
  if (tid < 128) sW[tid] = __expf(lg * (float)(127 - tid));
  __syncthreads();
  const int d = tid >> 2, vq = tid & 3;
  float acc[32];
#pragma unroll
  for (int j = 0; j < 32; ++j) acc[j] = 0.f;
  for (int pp = 0; pp < 128; ++pp) {
    const float kv = bf2f(sK[pp * 64 + d]) * sW[pp];
#pragma unroll
    for (int q = 0; q < 4; ++q) {
      const u32x4 vv = *(const u32x4*)(sV + pp * 128 + vq * 32 + q * 8);
      acc[q * 8 + 0] += kv * bflo(vv.x); acc[q * 8 + 1] += kv * bfhi(vv.x);
      acc[q * 8 + 2] += kv * bflo(vv.y); acc[q * 8 + 3] += kv * bfhi(vv.y);
      acc[q * 8 + 4] += kv * bflo(vv.z); acc[q * 8 + 5] += kv * bfhi(vv.z);
      acc[q * 8 + 6] += kv * bflo(vv.w); acc[q * 8 + 7] += kv * bfhi(vv.w);
    }
  }
  u16* dst = (u16*)p.LST + (long)id * 8192 + d * 128 + vq * 32;
#pragma unroll
  for (int q = 0; q < 4; ++q) *(u32x4*)(dst + q * 8) = pack8f(acc + q * 8);
}

DI void phase_attn1(const Params& p, char* smem) {
  for (int id = blockIdx.x; id < 1024 + 1152; id += gridDim.x) {
    if (id < 1024) {
      const int b = id >> 7, hd = (id >> 4) & 7, qb = id & 15, kvh = hd >> 2;
      const long qrow = (long)b * 2048 + qb * 128, crw = (long)TL + b * 256, lrow = (long)b * 2048;
      attn_item<64>(smem, p.Z + qrow * 2304 + 1536 + hd * 64, 2304, p.Z + crw * 2304 + 2048 + kvh * 64, p.Z + crw * 2304 + 2176 + kvh * 64,
                    2304, 2304, 256, p.Z + lrow * 2304 + 2048 + kvh * 64, p.Z + lrow * 2304 + 2176 + kvh * 64, 2304, 2304, 0, 2048, false, 0,
                    0.125f, false, 0.f, p.AO + qrow * 1024 + 512 + hd * 64, 1024);
    } else {
      ret_local_item(p, smem, id - 1024);
    }
  }
}

DI void ret_out_item(const Params& p, char* smem, int id) {
  const int c = id & 15, hh = (id >> 4) & 3, b = id >> 6;
  const int tid = threadIdx.x, lane = tid & 63, w = tid >> 6, r = lane & 31, h = lane >> 5;
  const float lgf = log_sigmoid(p.c_decay_fwd[hh]), lgb = log_sigmoid(p.c_decay_bwd[hh]);
  u16* sS = (u16*)smem;
  __syncthreads();
  {
    const int d = tid >> 2, vq = tid & 3;
#pragma unroll 1
    for (int dir = 0; dir < 2; ++dir) {
      const int cc = dir ? (17 - c) : (c + 2);
      const float lgG = (dir ? lgb : lgf) * 128.f;
      float acc[32];
#pragma unroll
      for (int j = 0; j < 32; ++j) acc[j] = 0.f;
#pragma unroll 8
      for (int c2 = 0; c2 < cc; ++c2) {
        const float coef = __expf(lgG * (float)(cc - 1 - c2));
        const u16* src = (const u16*)p.LST + ((long)(((b * 4 + hh) * 2 + dir) * 18 + c2)) * 8192 + d * 128 + vq * 32;
#pragma unroll
        for (int q = 0; q < 4; ++q) {
          const u32x4 v = *(const u32x4*)(src + q * 8);
          acc[q * 8] += coef * bflo(v.x); acc[q * 8 + 1] += coef * bfhi(v.x); acc[q * 8 + 2] += coef * bflo(v.y); acc[q * 8 + 3] += coef * bfhi(v.y);
          acc[q * 8 + 4] += coef * bflo(v.z); acc[q * 8 + 5] += coef * bfhi(v.z); acc[q * 8 + 6] += coef * bflo(v.w); acc[q * 8 + 7] += coef * bfhi(v.w);
        }
      }
#pragma unroll
      for (int j = 0; j < 32; ++j) sS[dir * 128 * 72 + (vq * 32 + j) * 72 + d] = f2bf(acc[j]);
    }
  }
  __syncthreads();
  const long qrow = (long)b * 2048 + c * 128 + w * 32 + r;
  const int qi = w * 32 + r;
  u32x4 qraw[4];
#pragma unroll
  for (int ks = 0; ks < 4; ++ks) qraw[ks] = *(const u32x4*)(p.Z + qrow * 2304 + hh * 64 + ks * 16 + h * 8);
  f32x16 oT[4];
#pragma unroll
  for (int vt = 0; vt < 4; ++vt) oT[vt] = zero16();
#pragma unroll 1
  for (int dir = 0; dir < 2; ++dir) {
    const float qd = dir ? __expf(lgb * (float)(128 - qi)) : __expf(lgf * (float)(qi + 1));
#pragma unroll
    for (int ks = 0; ks < 4; ++ks) {
      u32x4 sq;
      sq.x = pack2(bflo(qraw[ks].x) * qd, bfhi(qraw[ks].x) * qd);
      sq.y = pack2(bflo(qraw[ks].y) * qd, bfhi(qraw[ks].y) * qd);
      sq.z = pack2(bflo(qraw[ks].z) * qd, bfhi(qraw[ks].z) * qd);
      sq.w = pack2(bflo(qraw[ks].w) * qd, bfhi(qraw[ks].w) * qd);
      const bf16x8 qs8 = as_bf16x8(sq);
#pragma unroll
      for (int vt = 0; vt < 4; ++vt) {
        const bf16x8 sf = *(const bf16x8*)(sS + dir * 128 * 72 + (vt * 32 + r) * 72 + ks * 16 + h * 8);
        oT[vt] = MFMA(sf, qs8, oT[vt]);
      }
    }
  }
  __syncthreads();
  u16* sK = (u16*)smem;
  u16* sVt = sK + 128 * 72;
  const long crow0 = (long)b * 2048 + c * 128;
  for (int i = tid; i < 128 * 8; i += 256) {
    const int j = i >> 3, ch = i & 7;
    *(u32x4*)(sK + j * 72 + ch * 8) = *(const u32x4*)(p.Z + (crow0 + j) * 2304 + 256 + hh * 64 + ch * 8);
  }
  for (int i = tid; i < 128 * 16; i += 256) {
    const int j = i & 127, ch = i >> 7;
    const u32x4 vv = *(const u32x4*)(p.Z + (crow0 + j) * 2304 + 512 + hh * 128 + ch * 8);
    const unsigned ve[4] = {vv.x, vv.y, vv.z, vv.w};
#pragma unroll
    for (int q = 0; q < 4; ++q) {
      sVt[(ch * 8 + 2 * q) * 132 + j] = (u16)(ve[q] & 0xffffu);
      sVt[(ch * 8 + 2 * q + 1) * 132 + j] = (u16)(ve[q] >> 16);
    }
  }
  __syncthreads();
  const float l2f = lgf * LOG2E, l2b = lgb * LOG2E;
#pragma unroll 1
  for (int jt = 0; jt < 4; ++jt) {
    f32x16 sT = zero16();
#pragma unroll
    for (int ks = 0; ks < 4; ++ks) {
      const bf16x8 kf = *(const bf16x8*)(sK + (jt * 32 + r) * 72 + ks * 16 + h * 8);
      sT = MFMA(kf, as_bf16x8(qraw[ks]), sT);
    }
#pragma unroll
    for (int reg = 0; reg < 16; ++reg) {
      const int j = jt * 32 + crow(reg, h);
      const int df = qi - j;
      const float dec = (df > 0) ? ex2(l2f * (float)df) : ((df < 0) ? ex2(l2b * (float)(-df)) : 2.f);
      sT[reg] *= dec;
    }
#pragma unroll
    for (int s = 0; s < 2; ++s) {
      const bf16x8 pf = pack8(sT, s);
#pragma unroll
      for (int vt = 0; vt < 4; ++vt) {
        const u16* vr = sVt + (vt * 32 + r) * 132 + jt * 32 + s * 16 + h * 4;
        const bf16x8 vf = join8(*(const u32x2*)vr, *(const u32x2*)(vr + 8));
        oT[vt] = MFMA(vf, pf, oT[vt]);
      }
    }
  }
  float sm = 0.f;
#pragma unroll
  for (int vt = 0; vt < 4; ++vt)
#pragma unroll
    for (int reg = 0; reg < 16; ++reg) sm += oT[vt][reg];
  sm += __shfl_xor(sm, 32);
  const float mu = sm * (1.f / 128.f);
  float sv = 0.f;
#pragma unroll
  for (int vt = 0; vt < 4; ++vt)
#pragma unroll
    for (int reg = 0; reg < 16; ++reg) { const float dd = oT[vt][reg] - mu; sv += dd * dd; }
  sv += __shfl_xor(sv, 32);
  const float rstd = rsqrtf(sv * (1.f / 128.f) + EPSF);
#pragma unroll
  for (int vt = 0; vt < 4; ++vt) {
    __builtin_amdgcn_sched_barrier(0);
#pragma unroll
    for (int g = 0; g < 4; ++g) {
      const int v0 = vt * 32 + 8 * g + 4 * h;
      const u32x2 graw = *(const u32x2*)(p.Z + qrow * 2304 + 1024 + hh * 128 + v0);
      const f32x4 gw = *(const f32x4*)(p.c_gn_w + hh * 128 + v0);
      const float y0 = silu(bflo(graw.x)) * (oT[vt][4 * g] - mu) * rstd * gw.x;
      const float y1 = silu(bfhi(graw.x)) * (oT[vt][4 * g + 1] - mu) * rstd * gw.y;
      const float y2 = silu(bflo(graw.y)) * (oT[vt][4 * g + 2] - mu) * rstd * gw.z;
      const float y3 = silu(bfhi(graw.y)) * (oT[vt][4 * g + 3] - mu) * rstd * gw.w;
      u32x2 o = {pack2(y0, y1), pack2(y2, y3)};
      *(u32x2*)(p.AO + qrow * 1024 + hh * 128 + v0) = o;
    }
  }
}

DI unsigned fkey(float f) {
  const unsigned u = __float_as_uint(f);
  return u ^ ((unsigned)((int)u >> 31) | 0x80000000u);
}
DI unsigned wmax_u32_fast(unsigned v) {
  unsigned t;
  t = (unsigned)__builtin_amdgcn_update_dpp(0, (int)v, 0x128, 0xf, 0xf, false); v = v > t ? v : t;
  t = (unsigned)__builtin_amdgcn_update_dpp(0, (int)v, 0x124, 0xf, 0xf, false); v = v > t ? v : t;
  t = (unsigned)__builtin_amdgcn_update_dpp(0, (int)v, 0x122, 0xf, 0xf, false); v = v > t ? v : t;
  t = (unsigned)__builtin_amdgcn_update_dpp(0, (int)v, 0x121, 0xf, 0xf, false); v = v > t ? v : t;
  const unsigned a = (unsigned)__builtin_amdgcn_readlane((int)v, 0), b = (unsigned)__builtin_amdgcn_readlane((int)v, 16);
  const unsigned c = (unsigned)__builtin_amdgcn_readlane((int)v, 32), d = (unsigned)__builtin_amdgcn_readlane((int)v, 48);
  const unsigned ab = a > b ? a : b, cd = c > d ? c : d;
  return ab > cd ? ab : cd;
}
DI float fkey_inv(unsigned k) { return __uint_as_float((k & 0x80000000u) ? (k ^ 0x80000000u) : ~k); }
DI int lane_rank(unsigned long long m) {
  return __builtin_amdgcn_mbcnt_hi((unsigned)(m >> 32), __builtin_amdgcn_mbcnt_lo((unsigned)m, 0u));
}
template <int G>
DI void topk_group(const float (&vin)[G][4], float* wbase, int* oidx, float* ogate) {
  const int lane = threadIdx.x & 63;
  {
    unsigned k[G][4];
    float v[G][4];
#pragma unroll
    for (int g = 0; g < G; ++g) {
#pragma unroll
      for (int q = 0; q < 4; ++q) { v[g][q] = vin[g][q]; k[g][q] = fkey(v[g][q]); }
    }
    unsigned T[G][2], Mk[G][2];
    int n[G][2];
#pragma unroll
    for (int g = 0; g < G; ++g)
#pragma unroll
      for (int part = 0; part < 2; ++part) {
        const unsigned ka = k[g][2 * part], kb = k[g][2 * part + 1];
        const unsigned M = wmax_u32_fast(ka > kb ? ka : kb);
        Mk[g][part] = M;
        unsigned P = M >> 23;
        unsigned Tc; int c;
        for (;;) {
          Tc = P << 23;
          c = __popcll(__ballot(ka >= Tc)) + __popcll(__ballot(kb >= Tc));
          if (c >= 16 || P == 0u) break;
          --P;
        }
        T[g][part] = Tc; n[g][part] = c;
      }
#pragma unroll 1
    for (int bit = 22; bit >= 0; --bit) {
      bool done = true;
#pragma unroll
      for (int g = 0; g < G; ++g) done = done && (n[g][0] == 16) && (n[g][1] == 16);
      if (done) break;
      const unsigned bm = 1u << bit;
#pragma unroll
      for (int g = 0; g < G; ++g) {
        const unsigned t0 = T[g][0] | bm, t1 = T[g][1] | bm;
        const int c0 = __popcll(__ballot(k[g][0] >= t0)) + __popcll(__ballot(k[g][1] >= t0));
        const int c1 = __popcll(__ballot(k[g][2] >= t1)) + __popcll(__ballot(k[g][3] >= t1));
        if (c0 >= 16) { T[g][0] = t0; n[g][0] = c0; }
        if (c1 >= 16) { T[g][1] = t1; n[g][1] = c1; }
      }
    }
    unsigned ck[G][4];
    float cv[G][4];
#pragma unroll
    for (int g = 0; g < G; ++g) {
      float* sv = wbase + g * 128;
      int* si = (int*)(sv + 32);
#pragma unroll
      for (int part = 0; part < 2; ++part) {
        const unsigned Tp = T[g][part];
        const unsigned long long m0 = __ballot(k[g][2 * part] >= Tp), m1 = __ballot(k[g][2 * part + 1] >= Tp);
        const int r0 = lane_rank(m0), r1 = __popcll(m0) + lane_rank(m1);
        if (k[g][2 * part] >= Tp && r0 < 16) { sv[part * 16 + r0] = v[g][2 * part]; si[part * 16 + r0] = lane; }
        if (k[g][2 * part + 1] >= Tp && r1 < 16) { sv[part * 16 + r1] = v[g][2 * part + 1]; si[part * 16 + r1] = 64 + lane; }
      }
    }
#pragma unroll
    for (int g = 0; g < G; ++g) {
      const float* sv = wbase + g * 128;
      const float a = sv[lane >> 2];
#pragma unroll
      for (int q = 0; q < 4; ++q) { cv[g][q] = a + sv[16 + (lane & 3) * 4 + q]; ck[g][q] = fkey(cv[g][q]); }
    }
    unsigned T2[G];
    int n2[G];
#pragma unroll
    for (int g = 0; g < G; ++g) {
      const unsigned M = fkey(fkey_inv(Mk[g][0]) + fkey_inv(Mk[g][1]));
      unsigned P = M >> 23;
      unsigned Tc; int c;
      for (;;) {
        Tc = P << 23;
        c = __popcll(__ballot(ck[g][0] >= Tc)) + __popcll(__ballot(ck[g][1] >= Tc)) + __popcll(__ballot(ck[g][2] >= Tc)) + __popcll(__ballot(ck[g][3] >= Tc));
        if (c >= 16 || P == 0u) break;
        --P;
      }
      T2[g] = Tc; n2[g] = c;
    }
#pragma unroll 1
    for (int bit = 22; bit >= 0; --bit) {
      bool done = true;
#pragma unroll
      for (int g = 0; g < G; ++g) done = done && (n2[g] == 16);
      if (done) break;
      const unsigned bm = 1u << bit;
#pragma unroll
      for (int g = 0; g < G; ++g) {
        const unsigned t2 = T2[g] | bm;
        const int c = __popcll(__ballot(ck[g][0] >= t2)) + __popcll(__ballot(ck[g][1] >= t2)) + __popcll(__ballot(ck[g][2] >= t2)) + __popcll(__ballot(ck[g][3] >= t2));
        if (c >= 16) { T2[g] = t2; n2[g] = c; }
      }
    }
#pragma unroll
    for (int g = 0; g < G; ++g) {
      float* sv = wbase + g * 128;
      float* s2v = sv + 64;
      int* s2c = (int*)(sv + 80);
      int base = 0;
#pragma unroll
      for (int q = 0; q < 4; ++q) {
        const unsigned long long m = __ballot(ck[g][q] >= T2[g]);
        const int r = base + lane_rank(m);
        if (ck[g][q] >= T2[g] && r < 16) { s2v[r] = cv[g][q]; s2c[r] = lane * 4 + q; }
        base += __popcll(m);
      }
    }
    {
      const int g = (lane >> 4) % G, kk = lane & 15;
      const float* sv = wbase + g * 128;
      const int* si = (const int*)(sv + 32);
      const float* s2v = sv + 64;
      const int* s2c = (const int*)(sv + 80);
      const float val = s2v[kk];
      const float mx = rowmax16(val);
      const float ev = __expf(val - mx);
      const float ssum = rowsum16(ev);
      if (lane < 16 * G) {
        const int bc = s2c[kk];
        const int i0 = si[bc >> 4], i1 = si[16 + (bc & 15)];
        oidx[g * 16 + kk] = i0 * 128 + i1;
        ogate[g * 16 + kk] = ev / ssum;
      }
    }
  }
}
DI float dot16(const f32x2* hp, u32x4 u) {
  f32x2 d0 = {0.f, 0.f}, d1 = {0.f, 0.f};
#pragma unroll
  for (int q = 0; q < 4; ++q) {
    const int wq = (int)u[q];
    const f32x2 lo = __builtin_amdgcn_cvt_pk_f32_fp8(wq, false), hi = __builtin_amdgcn_cvt_pk_f32_fp8(wq, true);
    d0 = __builtin_elementwise_fma(hp[2 * q], lo, d0);
    d1 = __builtin_elementwise_fma(hp[2 * q + 1], hi, d1);
  }
  const f32x2 d = d0 + d1;
  return d.x + d.y;
}
DI float dot16_fp4(const f32x2* hp, u32x2 u) {
  f32x2 d0 = {0.f, 0.f}, d1 = {0.f, 0.f};
#pragma unroll
  for (int d = 0; d < 2; ++d) {
    const unsigned wq = u[d];
    d0 = __builtin_elementwise_fma(hp[4 * d], __builtin_amdgcn_cvt_scalef32_pk_f32_fp4(wq, 1.0f, 0), d0);
    d1 = __builtin_elementwise_fma(hp[4 * d + 1], __builtin_amdgcn_cvt_scalef32_pk_f32_fp4(wq, 1.0f, 1), d1);
    d0 = __builtin_elementwise_fma(hp[4 * d + 2], __builtin_amdgcn_cvt_scalef32_pk_f32_fp4(wq, 1.0f, 2), d0);
    d1 = __builtin_elementwise_fma(hp[4 * d + 3], __builtin_amdgcn_cvt_scalef32_pk_f32_fp4(wq, 1.0f, 3), d1);
  }
  const f32x2 dd = d0 + d1;
  return dd.x + dd.y;
}
DI void axpy16_fp4(f32x2* acc, float wgt, u32x2 v) {
  const f32x2 w2 = {wgt, wgt};
#pragma unroll
  for (int d = 0; d < 2; ++d) {
    const unsigned wq = v[d];
    acc[4 * d] = __builtin_elementwise_fma(w2, __builtin_amdgcn_cvt_scalef32_pk_f32_fp4(wq, 1.0f, 0), acc[4 * d]);
    acc[4 * d + 1] = __builtin_elementwise_fma(w2, __builtin_amdgcn_cvt_scalef32_pk_f32_fp4(wq, 1.0f, 1), acc[4 * d + 1]);
    acc[4 * d + 2] = __builtin_elementwise_fma(w2, __builtin_amdgcn_cvt_scalef32_pk_f32_fp4(wq, 1.0f, 2), acc[4 * d + 2]);
    acc[4 * d + 3] = __builtin_elementwise_fma(w2, __builtin_amdgcn_cvt_scalef32_pk_f32_fp4(wq, 1.0f, 3), acc[4 * d + 3]);
  }
}
DI void phase_peer(const Params& p, int layer, int ntok, float* dstbase, char* smem) {
  const int lane = threadIdx.x & 63;
  const int w = __builtin_amdgcn_readfirstlane(threadIdx.x >> 6);
  const unsigned char* U = p.U8 + (long)layer * 16384 * 512;
  const unsigned char* V = p.V8 + (long)layer * 16384 * 512;
  const float* SU = p.SCU + layer * 16384;
  const float* SV = p.SCV + layer * 16384;
  const float* modl = p.MOD + (long)layer * 9 * 6144;
  float* wtk = (float*)smem + w * 768;
  int* eidx_s = (int*)(wtk + 512);
  float* gate_s = wtk + 640;
  for (int t = blockIdx.x * 4 + w; t < ntok; t += gridDim.x * 4) {
    f32x2 hp[8];
    {
      const u32x4 ha = *(const u32x4*)(p.HB + (long)t * 1024 + lane * 16);
      const u32x4 hb = *(const u32x4*)(p.HB + (long)t * 1024 + lane * 16 + 8);
#pragma unroll
      for (int q = 0; q < 4; ++q) { hp[q].x = bflo(ha[q]); hp[q].y = bfhi(ha[q]); hp[4 + q].x = bflo(hb[q]); hp[4 + q].y = bfhi(hb[q]); }
    }
    {
      float sva[4][4], svb[4][4];
      const float* scp = p.SC + (long)t * 2048 + lane;
#pragma unroll
      for (int g = 0; g < 4; ++g)
#pragma unroll
        for (int q = 0; q < 4; ++q) { sva[g][q] = scp[g * 256 + q * 64]; svb[g][q] = scp[1024 + g * 256 + q * 64]; }
      topk_group<4>(sva, wtk, eidx_s, gate_s);
      topk_group<4>(svb, wtk, eidx_s + 64, gate_s + 64);
    }
    const int idxA = eidx_s[lane], idxB = eidx_s[64 + lane];
    const float gA = gate_s[lane], gB = gate_s[64 + lane];
    const float suA = SU[idxA], suB = SU[idxB];
    const float gvA = gA * SV[idxA], gvB = gB * SV[idxB];
    f32x2 acc2[8];
#pragma unroll
    for (int j = 0; j < 8; ++j) { acc2[j].x = 0.f; acc2[j].y = 0.f; }
    constexpr int NB = 16;
    u32x2 un[NB], vn[NB];
#pragma unroll
    for (int j = 0; j < NB; ++j) {
      const int idx = __builtin_amdgcn_readlane(idxA, j);
      un[j] = *(const u32x2*)(U + (long)idx * 512 + lane * 8);
      vn[j] = *(const u32x2*)(V + (long)idx * 512 + lane * 8);
    }
#pragma unroll 1
    for (int b = 0; b < 128 / NB; ++b) {
      const int l0 = (b * NB) & 63;
      const bool hiHalf = b * NB >= 64;
      u32x2 uc[NB];
      u32x2 vc[NB];
#pragma unroll
      for (int j = 0; j < NB; ++j) {
        uc[j] = un[j];
        vc[j] = vn[j];
      }
      if (b + 1 < 128 / NB) {
        const int l1 = ((b + 1) * NB) & 63;
        const bool hi1 = (b + 1) * NB >= 64;
#pragma unroll
        for (int j = 0; j < NB; ++j) {
          const int idx = hi1 ? __builtin_amdgcn_readlane(idxB, l1 + j) : __builtin_amdgcn_readlane(idxA, l1 + j);
          un[j] = *(const u32x2*)(U + (long)idx * 512 + lane * 8);
          vn[j] = *(const u32x2*)(V + (long)idx * 512 + lane * 8);
        }
      }
      float dsel = 0.f;
#pragma unroll
      for (int j = 0; j < NB; ++j) {
        const float d = rowsum16(dot16_fp4(hp, uc[j]));
        if ((lane & (NB - 1)) == j) dsel = d;
      }
      dsel += __shfl_xor(dsel, 16);
      dsel += __shfl_xor(dsel, 32);
      const float wv = hiHalf ? gvB * gelu_tanh(dsel * suB) : gvA * gelu_tanh(dsel * suA);
      const int wvi = __builtin_bit_cast(int, wv);
#pragma unroll
      for (int j = 0; j < NB; ++j) {
        const float wj = __builtin_bit_cast(float, __builtin_amdgcn_readlane(wvi, l0 + j));
        axpy16_fp4(acc2, wj, vc[j]);
      }
    }
    float acc[16];
#pragma unroll
    for (int j = 0; j < 8; ++j) { acc[2 * j] = acc2[j].x; acc[2 * j + 1] = acc2[j].y; }
    const int bi = (t < TL) ? (t >> 11) : 8;
    const float* g2 = modl + bi * 6144 + 5120 + lane * 16;
    const float* xr = p.XRES + (long)t * 1024 + lane * 16;
    float* dst = dstbase + (long)t * 1024 + lane * 16;
    float ssq = 0.f;
#pragma unroll
    for (int q = 0; q < 4; ++q) {
      const f32x4 x0 = *(const f32x4*)(xr + q * 4);
      const f32x4 ga = *(const f32x4*)(g2 + q * 4);
      f32x4 o = {x0.x + ga.x * acc[q * 4], x0.y + ga.y * acc[q * 4 + 1], x0.z + ga.z * acc[q * 4 + 2], x0.w + ga.w * acc[q * 4 + 3]};
      *(f32x4*)(dst + q * 4) = o;
      acc[q * 4] = o.x; acc[q * 4 + 1] = o.y; acc[q * 4 + 2] = o.z; acc[q * 4 + 3] = o.w;
      ssq += o.x * o.x + o.y * o.y + o.z * o.z + o.w * o.w;
    }
    if (layer == 0) {
      const float rstd = rsqrtf(wsum_fast(ssq) * (1.f / 1024.f) + EPSF);
      const float* md1 = p.MOD + (long)(9 + bi) * 6144 + lane * 16;
      const float* nw1 = p.norm1_w + 1024 + lane * 16;
      float y[16];
#pragma unroll
      for (int q = 0; q < 4; ++q) {
        const f32x4 nw = *(const f32x4*)(nw1 + q * 4);
        const f32x4 sh = *(const f32x4*)(md1 + q * 4);
        const f32x4 sc = *(const f32x4*)(md1 + 1024 + q * 4);
        y[q * 4] = acc[q * 4] * rstd * nw.x * (1.f + sc.x) + sh.x;
        y[q * 4 + 1] = acc[q * 4 + 1] * rstd * nw.y * (1.f + sc.y) + sh.y;
        y[q * 4 + 2] = acc[q * 4 + 2] * rstd * nw.z * (1.f + sc.z) + sh.z;
        y[q * 4 + 3] = acc[q * 4 + 3] * rstd * nw.w * (1.f + sc.w) + sh.w;
      }
      *(u32x4*)(p.HB + (long)t * 1024 + lane * 16) = pack8f(y);
      *(u32x4*)(p.HB + (long)t * 1024 + lane * 16 + 8) = pack8f(y + 8);
    }
  }
}

#ifdef EXPERIMENT
#define REPL(k) for (int rep_ = 0; rep_ < p.rep[k]; ++rep_)
#else
#define REPL(k)
#endif
DI void run_phase(const Params& p, int ph, char* smem) {
  const float* mod0 = p.MOD;
  const float* mod1 = p.MOD + 9 * 6144;
  EpiArgs ea;
  ea.C = nullptr; ea.ldc = 0; ea.N = 0; ea.xin_lat = nullptr; ea.xin_ctx = nullptr; ea.g = nullptr;
  switch (ph) {
    case 0: REPL(5) phase_prep(p, smem); break;
    case 1: REPL(1) phase_modulate(p, p.x, p.ctx, TA, p.norm1_w, mod0, 0, 1024); break;
    case 2: ea.C = p.Z; ea.ldc = 1312; ea.N = 1312; gemm_phase<0>(smem, p.HB, 1024, 0, p.WT_ABIN, 1024, 144, 11, 0, ea);
      {
        const int nslot = gridDim.x >> 3, slot = blockIdx.x >> 3, busy = 198 % nslot;
        const int nidle = nslot - busy;
        if (slot >= busy) {
          const int wi = (slot - busy) * 8 + (blockIdx.x & 7), nwk = nidle * 8;
          convert_fp4_rows(p.peer_u, p.U8, p.SCU, 2 * 16384, wi, nwk);
        }
      }
      break;
    case 3: phase_post0a(p); break;
    case 4:
      ea.C = p.QB; ea.ldc = 768; ea.N = 768; gemm_phase<0>(smem, p.Z + 768, 1312, 0, p.WT_UQ, 256, 144, 6, 0, ea);
      ea.C = p.KVR; ea.ldc = 1024; ea.N = 1024; gemm_phase<0>(smem, p.Z + 1024, 1312, 0, p.WT_UKV, 256, 144, 8, 108, ea);
      break;
    case 5: phase_post0b(p); break;
    case 6: REPL(3) phase_attn0(p, smem); break;
    case 7: ea.C = p.XRES; ea.N = 1024; ea.xin_lat = p.x; ea.xin_ctx = p.ctx; ea.g = mod0 + 2048;
      gemm_phase<2>(smem, p.AO, 1024, 0, p.WT_ABO, 1024, 144, 8, 0, ea);
      {
        const int nslot = gridDim.x >> 3, slot = blockIdx.x >> 3, busy = 144 % nslot;
        if (slot >= busy) convert_fp4_rows(p.peer_v, p.V8, p.SCV, 2 * 16384, (slot - busy) * 8 + (blockIdx.x & 7), (nslot - busy) * 8);
      }
      break;
    case 8: REPL(1) phase_modulate(p, p.XRES, p.XRES + (long)TL * 1024, TA, p.norm2_w, mod0, 3072, 4096); break;
    case 9: gemm_pq_scores(smem, p.HB, p.WT_PQ, p.KEYS16, p.SC, 144); break;
    case 10: phase_peer(p, 0, TA, p.XRES, smem); break;
    case 11: ea.C = p.Z; ea.ldc = 2304; ea.N = 2304; gemm_phase<0>(smem, p.HB, 1024, 0, p.WT_CDIN, 1024, 144, 18, 0, ea); break;
    case 12: phase_post1(p); break;
    case 13: REPL(4) phase_attn1(p, smem); break;
    case 14: REPL(2) for (int id = blockIdx.x; id < 512; id += gridDim.x) ret_out_item(p, smem, id); break;
    case 15: ea.C = p.XRES; ea.N = 1024; ea.g = mod1 + 2048; gemm_phase<3>(smem, p.AO, 1024, 0, p.WT_CDO, 1024, 128, 8, 0, ea); break;
    case 16: REPL(1) phase_modulate(p, p.XRES, p.XRES + (long)TL * 1024, TL, p.norm2_w + 1024, mod1, 3072, 4096); break;
    case 17: gemm_pq_scores(smem, p.HB, p.WT_PQ + 2048L * 1024, p.KEYS16 + 16L * 128 * 128, p.SC, 128); break;
    case 18: phase_peer(p, 1, TL, p.out, smem); break;
    default: break;
  }
}


#define XB_TMO      128
#define XB_XCNT(j)  (256  + 64 * (j))
#define XB_XSUB(j)  (1280 + 64 * (j))
#define XB_XGEN(j)  (2304 + 64 * (j))
#define XB_TOP      3328
#define XB_TOPGEN   3392
#define XCD_BAR_WORDS 3456
#define XB_SPIN_CAP (1u << 20)
#define LAS __attribute__((address_space(3)))
DI unsigned xb_ld(unsigned* p) { return __hip_atomic_load(p, __ATOMIC_RELAXED, __HIP_MEMORY_SCOPE_AGENT); }
DI unsigned xb_add(unsigned* p, unsigned v) { return __hip_atomic_fetch_add(p, v, __ATOMIC_RELAXED, __HIP_MEMORY_SCOPE_AGENT); }
DI unsigned xb_xcc_id() { return (unsigned)__builtin_amdgcn_s_getreg((3 << 11) | 20) & 0xFu; }
#define XB_SPIN(cond, bar) do { unsigned _sp = 0; while (cond) { \
    if ((++_sp & 255u) == 0u) { if (xb_ld(&(bar)[XB_TMO])) break; if (_sp > XB_SPIN_CAP) { atomicAdd(&(bar)[XB_TMO], 1u); break; } } } } while (0)
struct XcdBarrier { unsigned* bar; unsigned x; volatile LAS unsigned* st; };
DI XcdBarrier xcd_barrier_post(unsigned* bar, volatile LAS unsigned* st) {
  XcdBarrier b; b.bar = bar; b.x = xb_xcc_id(); b.st = st;
  if (threadIdx.x == 0) (void)xb_add(&bar[XB_XCNT(b.x)], 1u);
  return b;
}
DI void xcd_barrier_complete(unsigned* bar, unsigned x, unsigned& nloc, unsigned& nx) {
  const unsigned G = gridDim.x * gridDim.y * gridDim.z;
  unsigned sum, cnt, mine, sp = 0u;
  for (;;) {
    sum = 0u; cnt = 0u; mine = 0u;
#pragma unroll
    for (unsigned j = 0; j < 16; ++j) { const unsigned c = xb_ld(&bar[XB_XCNT(j)]); sum += c; cnt += (c > 0u) ? 1u : 0u; mine = (j == x) ? c : mine; }
    if (sum == G) break;
    __builtin_amdgcn_s_sleep(1);
    if ((++sp & 255u) == 0u) { if (xb_ld(&bar[XB_TMO])) break; if (sp > XB_SPIN_CAP) { atomicAdd(&bar[XB_TMO], 1u); break; } }
  }
  nloc = mine > 0u ? mine : 1u; nx = cnt > 0u ? cnt : 1u;
}
DI void xcd_barrier(const XcdBarrier& b) {
  asm volatile("s_waitcnt vmcnt(0)" ::: "memory");
  __syncthreads();
  if (threadIdx.x == 0) {
    unsigned* bar = b.bar;
    __builtin_amdgcn_s_waitcnt(0);
    unsigned nloc = b.st[0], nx = b.st[1];
    if (nloc == 0u) { xcd_barrier_complete(bar, b.x, nloc, nx); b.st[0] = nloc; b.st[1] = nx; }
    const unsigned old = xb_add(&bar[XB_XSUB(b.x)], 1u);
    const unsigned gen = old / nloc;
    if (old + 1u == (gen + 1u) * nloc) {
      __builtin_amdgcn_fence(__ATOMIC_RELEASE, "agent");
      asm volatile("s_waitcnt vmcnt(0)" ::: "memory");
      const unsigned og = xb_add(&bar[XB_TOP], 1u);
      const unsigned tg = og / nx;
      if (og + 1u == (tg + 1u) * nx) xb_add(&bar[XB_TOPGEN], 1u);
      else XB_SPIN(xb_ld(&bar[XB_TOPGEN]) == tg, bar);
      __builtin_amdgcn_fence(__ATOMIC_ACQUIRE, "agent");
      xb_add(&bar[XB_XGEN(b.x)], 1u);
      asm volatile("s_waitcnt vmcnt(0)" ::: "memory");
    } else {
      XB_SPIN(xb_ld(&bar[XB_XGEN(b.x)]) == gen, bar);
      __builtin_amdgcn_fence(__ATOMIC_ACQUIRE, "agent");
      asm volatile("s_waitcnt vmcnt(0)" ::: "memory");
    }
  }
  __syncthreads();
}

#if MULTI_LAUNCH
template <int PH>
__global__ void __launch_bounds__(256, 2) phase_kernel(KArgs a) {
  __shared__ __attribute__((aligned(16))) char smem[73728];
  const Params p = make_params(a);
  run_phase(p, PH, smem);
}
template <int PH>
static void launch_all(const KArgs& a, hipStream_t stream) {
  hipLaunchKernelGGL(phase_kernel<PH>, dim3(512), dim3(256), 0, stream, a);
  if constexpr (PH + 1 < NPHASE) launch_all<PH + 1>(a, stream);
}
#else
template <int PH>
DI void run_from(const Params& p, char* smem, cg::grid_group& grid, const XcdBarrier& xb) {
  run_phase(p, PH, smem);
  if constexpr (PH + 1 < NPHASE) {
    if constexpr (PH == 0) { if (p.out == nullptr) grid.sync(); }
    xcd_barrier(xb);
    run_from<PH + 1>(p, smem, grid, xb);
  }
}
__global__ void __launch_bounds__(256, 2) mega_kernel(KArgs a) {
  __shared__ __attribute__((aligned(16))) char smem[73728];
  __shared__ __attribute__((aligned(16))) unsigned xb_words[4];
  if (threadIdx.x < 4) xb_words[threadIdx.x] = 0u;
  __syncthreads();
  const Params p = make_params(a);
  const XcdBarrier xb = xcd_barrier_post(p.BAR, (volatile LAS unsigned*)xb_words);
  cg::grid_group grid = cg::this_grid();
  run_from<0>(p, smem, grid, xb);
}
#endif

extern "C" void kernel_launch(void* const* d_in, const int* in_sizes, int n_in, void* d_out, int out_size, void* d_ws, size_t ws_size,
                              hipStream_t stream) {
  KArgs a;
  memset(&a, 0, sizeof(a));
  for (int i = 0; i < 30; ++i) a.in[i] = (const float*)d_in[i];
  a.out = (float*)d_out;
  a.ws = (char*)d_ws;
#ifdef EXPERIMENT
  { const int r[8] = {EXPERIMENT}; for (int i = 0; i < 8; ++i) a.rep[i] = r[i]; }
#endif
  (void)hipMemsetAsync((char*)d_ws + OFF_MOD, 0, (OFF_BAR - OFF_MOD) + 4096 * 4, stream);
#if MULTI_LAUNCH
  launch_all<0>(a, stream);
#else
  static int grid_blocks = 0;
  if (!grid_blocks) {
    int dev = 0, cus = 0, per_cu = 0;
    (void)hipGetDevice(&dev);
    (void)hipDeviceGetAttribute(&cus, hipDeviceAttributeMultiprocessorCount, dev);
    (void)hipOccupancyMaxActiveBlocksPerMultiprocessor(&per_cu, mega_kernel, 256, 0);
    if (per_cu > 2) per_cu = 2;
    if (per_cu < 1) per_cu = 1;
    grid_blocks = (cus * per_cu) & ~7;
  }
  void* args[] = {&a};
  hipError_t e = hipLaunchCooperativeKernel((void*)mega_kernel, dim3(grid_blocks), dim3(256), args, 0, stream);
  if (e != hipSuccess) fprintf(stderr, "cooperative launch failed: %s (grid %d)\n", hipGetErrorString(e), grid_blocks);
#endif
}
```

```cpp
#include <hip/hip_runtime.h>
#include <hip/hip_cooperative_groups.h>
#include <cstdio>
#include <cstring>
namespace cg = cooperative_groups;

#ifndef MULTI_LAUNCH
#define MULTI_LAUNCH 0
#endif

typedef unsigned short u16;
typedef short bf16x8 __attribute__((ext_vector_type(8)));
typedef float f32x16 __attribute__((ext_vector_type(16)));
typedef short s16x4 __attribute__((ext_vector_type(4)));
#define LDS3 __attribute__((address_space(3)))
typedef __bf16 bf2_t __attribute__((ext_vector_type(2)));
typedef float f2_t __attribute__((ext_vector_type(2)));
typedef unsigned int u32x4 __attribute__((ext_vector_type(4)));
typedef unsigned int u32x2 __attribute__((ext_vector_type(2)));
typedef float f32x4 __attribute__((ext_vector_type(4)));
typedef float f32x2 __attribute__((ext_vector_type(2)));
#define DI __device__ __forceinline__
#define MFMA(a, b, c) __builtin_amdgcn_mfma_f32_32x32x16_bf16((a), (b), (c), 0, 0, 0)

constexpr int TL = 16384;
constexpr int TC = 2048;
constexpr int TA = 18432;
constexpr int NPHASE = 19;
constexpr float EPSF = 1e-6f;
constexpr float LOG2E = 1.4426950408889634f;

struct KArgs {
  const float* in[30];
  float* out;
  char* ws;
#ifdef EXPERIMENT
  int rep[8];
#endif
};
struct Params {
  const float *x, *c, *ctx, *c_ctx, *ada_w, *ada_b, *norm1_w, *norm2_w, *ab_w_in, *ab_w_o, *a_q_norm, *a_k_norm, *a_sink,
      *b_q_lora_norm, *b_kv_lora_norm, *b_w_uq, *b_w_ukv, *b_q_norm, *b_k_norm, *cd_w_in, *cd_w_o, *c_decay_fwd, *c_decay_bwd,
      *c_gn_w, *d_q_norm, *d_k_norm, *peer_w_q, *peer_keys, *peer_u, *peer_v;
  float* out;
  u16 *U16, *V16, *WT_ABIN, *WT_ABO, *WT_UQ, *WT_UKV, *WT_CDIN, *WT_CDO, *WT_PQ, *KEYS16;
  float *MOD, *ROPE16, *ROPE8, *XRES;
  u16 *HB, *AO, *Z, *QB, *KVR, *KB, *VB;
  float* LST;
  float* SC;
  u16* PQ;
  int* EIDX;
  float* GATE;
  unsigned* BAR;
  unsigned char *U8, *V8;
  float *SCU, *SCV;
#ifdef EXPERIMENT
  int rep[8];
#endif
};
constexpr size_t al256(size_t x) { return (x + 255) & ~(size_t)255; }
constexpr size_t OFF_U16 = 0;
constexpr size_t OFF_V16 = OFF_U16 + al256(2UL * 16384 * 1024 * 2);
constexpr size_t OFF_WT_ABIN = OFF_V16 + al256(2UL * 16384 * 1024 * 2);
constexpr size_t OFF_WT_ABO = OFF_WT_ABIN + al256(1408UL * 1024 * 2);
constexpr size_t OFF_WT_UQ = OFF_WT_ABO + al256(1024UL * 1024 * 2);
constexpr size_t OFF_WT_UKV = OFF_WT_UQ + al256(768UL * 256 * 2);
constexpr size_t OFF_WT_CDIN = OFF_WT_UKV + al256(1024UL * 256 * 2);
constexpr size_t OFF_WT_CDO = OFF_WT_CDIN + al256(2304UL * 1024 * 2);
constexpr size_t OFF_WT_PQ = OFF_WT_CDO + al256(1024UL * 1024 * 2);
constexpr size_t OFF_KEYS16 = OFF_WT_PQ + al256(2UL * 2048 * 1024 * 2);
constexpr size_t OFF_MOD = OFF_KEYS16 + al256(2UL * 16 * 128 * 128 * 2);
constexpr size_t OFF_ROPE16 = OFF_MOD + al256(2UL * 9 * 6144 * 4);
constexpr size_t OFF_ROPE8 = OFF_ROPE16 + al256(64UL * 16 * 2 * 4);
constexpr size_t OFF_BAR = OFF_ROPE8 + al256(64UL * 8 * 2 * 4);
constexpr size_t OFF_SCU = OFF_BAR + al256(4096UL * 4);
constexpr size_t OFF_SCV = OFF_SCU + al256(2UL * 16384 * 4);
constexpr size_t OFF_XRES = OFF_SCV + al256(2UL * 16384 * 4);
constexpr size_t OFF_HB = OFF_XRES + al256((size_t)TA * 1024 * 4);
constexpr size_t OFF_R = OFF_HB + al256((size_t)TA * 1024 * 2);
constexpr size_t OFF_AO = OFF_R;
constexpr size_t OFF_Z = OFF_AO + (size_t)TA * 1024 * 2;
constexpr size_t OFF_QB = OFF_Z + (size_t)TA * 2304 * 2;
constexpr size_t OFF_KVR = OFF_QB + (size_t)TA * 768 * 2;
constexpr size_t OFF_KB = OFF_KVR + (size_t)TA * 1024 * 2;
constexpr size_t OFF_VB = OFF_KB + (size_t)TA * 768 * 2;
constexpr size_t OFF_SC = OFF_R;
constexpr size_t OFF_PQ = OFF_SC + (size_t)TA * 2048 * 4;
constexpr size_t OFF_EIDX = OFF_PQ + (size_t)TA * 2048 * 2;
constexpr size_t OFF_GATE = OFF_EIDX + (size_t)TA * 128 * 4;
constexpr size_t WS_END = OFF_GATE + (size_t)TA * 128 * 4;
static_assert(WS_END <= 536870912UL, "workspace map exceeds 512 MiB");
static_assert(OFF_VB + (size_t)TA * 512 * 2 <= 536870912UL, "workspace map exceeds 512 MiB");

DI Params make_params(const KArgs& a) {
  Params p;
  p.x = a.in[0]; p.c = a.in[1]; p.ctx = a.in[2]; p.c_ctx = a.in[3]; p.ada_w = a.in[4]; p.ada_b = a.in[5]; p.norm1_w = a.in[6];
  p.norm2_w = a.in[7]; p.ab_w_in = a.in[8]; p.ab_w_o = a.in[9]; p.a_q_norm = a.in[10]; p.a_k_norm = a.in[11]; p.a_sink = a.in[12];
  p.b_q_lora_norm = a.in[13]; p.b_kv_lora_norm = a.in[14]; p.b_w_uq = a.in[15]; p.b_w_ukv = a.in[16]; p.b_q_norm = a.in[17];
  p.b_k_norm = a.in[18]; p.cd_w_in = a.in[19]; p.cd_w_o = a.in[20]; p.c_decay_fwd = a.in[21]; p.c_decay_bwd = a.in[22];
  p.c_gn_w = a.in[23]; p.d_q_norm = a.in[24]; p.d_k_norm = a.in[25]; p.peer_w_q = a.in[26]; p.peer_keys = a.in[27];
  p.peer_u = a.in[28]; p.peer_v = a.in[29];
  p.out = a.out;
#ifdef EXPERIMENT
  for (int i = 0; i < 8; ++i) p.rep[i] = a.rep[i];
#endif
  char* ws = a.ws;
  p.U16 = (u16*)(ws + OFF_U16); p.V16 = (u16*)(ws + OFF_V16); p.WT_ABIN = (u16*)(ws + OFF_WT_ABIN); p.WT_ABO = (u16*)(ws + OFF_WT_ABO);
  p.WT_UQ = (u16*)(ws + OFF_WT_UQ); p.WT_UKV = (u16*)(ws + OFF_WT_UKV); p.WT_CDIN = (u16*)(ws + OFF_WT_CDIN); p.WT_CDO = (u16*)(ws + OFF_WT_CDO);
  p.WT_PQ = (u16*)(ws + OFF_WT_PQ); p.KEYS16 = (u16*)(ws + OFF_KEYS16); p.MOD = (float*)(ws + OFF_MOD); p.ROPE16 = (float*)(ws + OFF_ROPE16);
  p.ROPE8 = (float*)(ws + OFF_ROPE8); p.BAR = (unsigned*)(ws + OFF_BAR); p.XRES = (float*)(ws + OFF_XRES); p.HB = (u16*)(ws + OFF_HB);
  p.AO = (u16*)(ws + OFF_AO); p.Z = (u16*)(ws + OFF_Z); p.QB = (u16*)(ws + OFF_QB); p.LST = (float*)(ws + OFF_QB); p.KVR = (u16*)(ws + OFF_KVR);
  p.KB = (u16*)(ws + OFF_KB); p.VB = (u16*)(ws + OFF_VB); p.SC = (float*)(ws + OFF_SC); p.PQ = (u16*)(ws + OFF_PQ);
  p.EIDX = (int*)(ws + OFF_EIDX); p.GATE = (float*)(ws + OFF_GATE);
  p.U8 = (unsigned char*)(ws + OFF_U16); p.V8 = (unsigned char*)(ws + OFF_V16); p.SCU = (float*)(ws + OFF_SCU); p.SCV = (float*)(ws + OFF_SCV);
  return p;
}

DI unsigned pack2(float a, float b) {
  f2_t v = {a, b};
  return __builtin_bit_cast(unsigned, __builtin_convertvector(v, bf2_t));
}
DI u16 f2bf(float a) { return (u16)(pack2(a, 0.f) & 0xffffu); }
DI float bf2f(u16 v) { return __uint_as_float(((unsigned)v) << 16); }
DI float bflo(unsigned v) { return __uint_as_float(v << 16); }
DI float bfhi(unsigned v) { return __uint_as_float(v & 0xffff0000u); }
DI float wsum(float v) {
#pragma unroll
  for (int o = 32; o >= 1; o >>= 1) v += __shfl_xor(v, o);
  return v;
}
DI float wmax(float v) {
#pragma unroll
  for (int o = 32; o >= 1; o >>= 1) v = fmaxf(v, __shfl_xor(v, o));
  return v;
}
DI int crow(int reg, int h) { return (reg & 3) + 8 * (reg >> 2) + 4 * h; }
DI float ex2(float x) { return __builtin_amdgcn_exp2f(x); }
DI bf16x8 as_bf16x8(u32x4 v) { return __builtin_bit_cast(bf16x8, v); }
DI bf16x8 join8(u32x2 a, u32x2 b) { u32x4 v = {a.x, a.y, b.x, b.y}; return __builtin_bit_cast(bf16x8, v); }
DI bf16x8 pack8(const f32x16& x, int s) {
  u32x4 v;
  v.x = pack2(x[8 * s + 0], x[8 * s + 1]);
  v.y = pack2(x[8 * s + 2], x[8 * s + 3]);
  v.z = pack2(x[8 * s + 4], x[8 * s + 5]);
  v.w = pack2(x[8 * s + 6], x[8 * s + 7]);
  return __builtin_bit_cast(bf16x8, v);
}
DI f32x16 zero16() {
  f32x16 z;
#pragma unroll
  for (int i = 0; i < 16; ++i) z[i] = 0.f;
  return z;
}
DI float log_sigmoid(float x) { return -log1pf(__expf(-x)); }
DI float silu(float x) { return x / (1.f + __expf(-x)); }
DI float gelu_tanh(float x) {
  float u = 0.7978845608028654f * (x + 0.044715f * x * x * x);
  float t = 1.f - 2.f / (__expf(2.f * u) + 1.f);
  return 0.5f * x * (1.f + t);
}

DI float rowsum16(float v) {
  v += __builtin_bit_cast(float, __builtin_amdgcn_update_dpp(0, __builtin_bit_cast(int, v), 0x128, 0xf, 0xf, false));
  v += __builtin_bit_cast(float, __builtin_amdgcn_update_dpp(0, __builtin_bit_cast(int, v), 0x124, 0xf, 0xf, false));
  v += __builtin_bit_cast(float, __builtin_amdgcn_update_dpp(0, __builtin_bit_cast(int, v), 0x122, 0xf, 0xf, false));
  v += __builtin_bit_cast(float, __builtin_amdgcn_update_dpp(0, __builtin_bit_cast(int, v), 0x121, 0xf, 0xf, false));
  return v;
}
DI float wsum_fast(float v) {
  v = rowsum16(v);
  const int iv = __builtin_bit_cast(int, v);
  const float a = __builtin_bit_cast(float, __builtin_amdgcn_readlane(iv, 0));
  const float b = __builtin_bit_cast(float, __builtin_amdgcn_readlane(iv, 16));
  const float c = __builtin_bit_cast(float, __builtin_amdgcn_readlane(iv, 32));
  const float d = __builtin_bit_cast(float, __builtin_amdgcn_readlane(iv, 48));
  return (a + b) + (c + d);
}
DI float rowmax16(float v) {
  v = fmaxf(v, __builtin_bit_cast(float, __builtin_amdgcn_update_dpp(0, __builtin_bit_cast(int, v), 0x128, 0xf, 0xf, false)));
  v = fmaxf(v, __builtin_bit_cast(float, __builtin_amdgcn_update_dpp(0, __builtin_bit_cast(int, v), 0x124, 0xf, 0xf, false)));
  v = fmaxf(v, __builtin_bit_cast(float, __builtin_amdgcn_update_dpp(0, __builtin_bit_cast(int, v), 0x122, 0xf, 0xf, false)));
  v = fmaxf(v, __builtin_bit_cast(float, __builtin_amdgcn_update_dpp(0, __builtin_bit_cast(int, v), 0x121, 0xf, 0xf, false)));
  return v;
}
DI float wmax_fast(float v) {
  v = rowmax16(v);
  const int iv = __builtin_bit_cast(int, v);
  const float a = __builtin_bit_cast(float, __builtin_amdgcn_readlane(iv, 0));
  const float b = __builtin_bit_cast(float, __builtin_amdgcn_readlane(iv, 16));
  const float c = __builtin_bit_cast(float, __builtin_amdgcn_readlane(iv, 32));
  const float d = __builtin_bit_cast(float, __builtin_amdgcn_readlane(iv, 48));
  return fmaxf(fmaxf(a, b), fmaxf(c, d));
}
DI void convert_fp8_rows(const float* __restrict__ src, unsigned char* __restrict__ dst, float* __restrict__ scl, int nrows, int wi, int nwk) {
  const int lane = threadIdx.x & 63, w = threadIdx.x >> 6;
  for (int row0 = (wi * 4 + w) * 4; row0 < nrows; row0 += nwk * 16) {
    f32x4 v[4][4];
#pragma unroll
    for (int rr = 0; rr < 4; ++rr) {
      const float* sp = src + (long)(row0 + rr) * 1024 + lane * 16;
#pragma unroll
      for (int q = 0; q < 4; ++q) v[rr][q] = *(const f32x4*)(sp + q * 4);
    }
#pragma unroll
    for (int rr = 0; rr < 4; ++rr) {
      float am = 0.f;
#pragma unroll
      for (int q = 0; q < 4; ++q)
        am = fmaxf(am, fmaxf(fmaxf(fabsf(v[rr][q].x), fabsf(v[rr][q].y)), fmaxf(fabsf(v[rr][q].z), fabsf(v[rr][q].w))));
      am = wmax_fast(am);
      const float inv = am > 0.f ? 224.f / am : 0.f;
      u32x4 o;
#pragma unroll
      for (int q = 0; q < 4; ++q) {
        int pk = 0;
        pk = __builtin_amdgcn_cvt_pk_fp8_f32(v[rr][q].x * inv, v[rr][q].y * inv, pk, false);
        pk = __builtin_amdgcn_cvt_pk_fp8_f32(v[rr][q].z * inv, v[rr][q].w * inv, pk, true);
        o[q] = (unsigned)pk;
      }
      *(u32x4*)(dst + (long)(row0 + rr) * 1024 + lane * 16) = o;
      if (lane == 0) scl[row0 + rr] = am * (1.f / 224.f);
    }
  }
}

DI void convert_fp4_rows(const float* __restrict__ src, unsigned char* __restrict__ dst, float* __restrict__ scl, int nrows, int wi, int nwk) {
  const int lane = threadIdx.x & 63, w = threadIdx.x >> 6;
  for (int row0 = (wi * 4 + w) * 4; row0 < nrows; row0 += nwk * 16) {
    f32x4 v[4][4];
#pragma unroll
    for (int rr = 0; rr < 4; ++rr) {
      const float* sp = src + (long)(row0 + rr) * 1024 + lane * 16;
#pragma unroll
      for (int q = 0; q < 4; ++q) v[rr][q] = *(const f32x4*)(sp + q * 4);
    }
#pragma unroll
    for (int rr = 0; rr < 4; ++rr) {
      float am = 0.f;
#pragma unroll
      for (int q = 0; q < 4; ++q)
        am = fmaxf(am, fmaxf(fmaxf(fabsf(v[rr][q].x), fabsf(v[rr][q].y)), fmaxf(fabsf(v[rr][q].z), fabsf(v[rr][q].w))));
      am = wmax_fast(am);
      const float inv = am > 0.f ? 6.f / am : 0.f;
      u32x2 o;
#pragma unroll
      for (int d = 0; d < 2; ++d) {
        unsigned pk = 0u;
        pk = __builtin_amdgcn_cvt_scalef32_pk_fp4_f32(pk, v[rr][2 * d].x * inv, v[rr][2 * d].y * inv, 1.0f, 0);
        pk = __builtin_amdgcn_cvt_scalef32_pk_fp4_f32(pk, v[rr][2 * d].z * inv, v[rr][2 * d].w * inv, 1.0f, 1);
        pk = __builtin_amdgcn_cvt_scalef32_pk_fp4_f32(pk, v[rr][2 * d + 1].x * inv, v[rr][2 * d + 1].y * inv, 1.0f, 2);
        pk = __builtin_amdgcn_cvt_scalef32_pk_fp4_f32(pk, v[rr][2 * d + 1].z * inv, v[rr][2 * d + 1].w * inv, 1.0f, 3);
        o[d] = pk;
      }
      *(u32x2*)(dst + (long)(row0 + rr) * 512 + lane * 8) = o;
      if (lane == 0) scl[row0 + rr] = am * (1.f / 6.f);
    }
  }
}

DI void transpose_w(const float* __restrict__ W, int K, int N, int Npad, u16* __restrict__ Wt, long gtid, long gsz) {
  const long items = (long)Npad * (K / 8);
  for (long id0 = gtid; id0 < items; id0 += 2 * gsz) {
    u32x4 o[2];
    long idv[2];
#pragma unroll
    for (int u = 0; u < 2; ++u) {
      const long id = id0 + u * gsz;
      idv[u] = id;
      u32x4 oo = {0u, 0u, 0u, 0u};
      if (id < items) {
        const int n = (int)(id % Npad), k8 = (int)(id / Npad);
        if (n < N) {
          const float* sp = W + (long)(k8 * 8) * N + n;
          oo.x = pack2(sp[0], sp[(long)N]);
          oo.y = pack2(sp[2L * N], sp[3L * N]);
          oo.z = pack2(sp[4L * N], sp[5L * N]);
          oo.w = pack2(sp[6L * N], sp[7L * N]);
        }
      }
      o[u] = oo;
    }
#pragma unroll
    for (int u = 0; u < 2; ++u) {
      const long id = idv[u];
      if (id < items) {
        const int n = (int)(id % Npad), k8 = (int)(id / Npad);
        *(u32x4*)(Wt + (long)n * K + k8 * 8) = o[u];
      }
    }
  }
}
DI void convert8(const float* __restrict__ src, u16* __restrict__ dst, long n8, long gtid, long gsz) {
  for (long i = gtid; i < n8; i += gsz) {
    const f32x4 a = ((const f32x4*)src)[2 * i], b = ((const f32x4*)src)[2 * i + 1];
    u32x4 o;
    o.x = pack2(a.x, a.y); o.y = pack2(a.z, a.w); o.z = pack2(b.x, b.y); o.w = pack2(b.z, b.w);
    ((u32x4*)dst)[i] = o;
  }
}

DI void phase_prep(const Params& p, char* smem) {
  const int tid = threadIdx.x;
  const long gtid = (long)blockIdx.x * 256 + tid, gsz = (long)gridDim.x * 256;
  {
    float* sS = (float*)smem;
    float* sR = sS + 9 * 256;
    for (int it = blockIdx.x; it < 768; it += gridDim.x) {
      const int kq = it & 3, cb = (it >> 2) % 96, l = it / 384;
      __syncthreads();
      for (int i = tid; i < 9 * 256; i += 256) {
        const int bi = i >> 8, k = kq * 256 + (i & 255);
        const float v = (bi < 8) ? p.c[bi * 1024 + k] : p.c_ctx[k];
        sS[i] = silu(v);
      }
      __syncthreads();
      const int col = cb * 64 + (tid & 63), kg = tid >> 6;
      const float* wp = p.ada_w + (long)l * 1024 * 6144 + (long)(kq * 256 + kg * 64) * 6144 + col;
      float acc[9];
#pragma unroll
      for (int i = 0; i < 9; ++i) acc[i] = 0.f;
#pragma unroll 8
      for (int k = 0; k < 64; ++k) {
        const float wv = wp[(long)k * 6144];
#pragma unroll
        for (int i = 0; i < 9; ++i) acc[i] += sS[i * 256 + kg * 64 + k] * wv;
      }
#pragma unroll
      for (int i = 0; i < 9; ++i) sR[(kg * 9 + i) * 64 + (tid & 63)] = acc[i];
      __syncthreads();
      for (int i = tid; i < 9 * 64; i += 256) {
        const int bi = i >> 6, cc = i & 63;
        float sm = sR[(0 * 9 + bi) * 64 + cc] + sR[(1 * 9 + bi) * 64 + cc] + sR[(2 * 9 + bi) * 64 + cc] + sR[(3 * 9 + bi) * 64 + cc];
        if (kq == 0) sm += p.ada_b[l * 6144 + cb * 64 + cc];
        atomicAdd(&p.MOD[((long)l * 9 + bi) * 6144 + cb * 64 + cc], sm);
      }
    }
    __syncthreads();
  }
  for (long i = gtid; i < 64 * 16; i += gsz) {
    const int pos = (int)(i >> 4), f = (int)(i & 15);
    const float ang = (float)pos * exp2f(-(float)f * (13.287712379549449f / 16.f));
    p.ROPE16[2 * i] = __cosf(ang); p.ROPE16[2 * i + 1] = __sinf(ang);
  }
  for (long i = gtid; i < 64 * 8; i += gsz) {
    const int pos = (int)(i >> 3), f = (int)(i & 7);
    const float ang = (float)pos * exp2f(-(float)f * (13.287712379549449f / 8.f));
    p.ROPE8[2 * i] = __cosf(ang); p.ROPE8[2 * i + 1] = __sinf(ang);
  }
  transpose_w(p.ab_w_in, 1024, 1312, 1408, p.WT_ABIN, gtid, gsz);
  transpose_w(p.ab_w_o, 1024, 1024, 1024, p.WT_ABO, gtid, gsz);
  transpose_w(p.b_w_uq, 256, 768, 768, p.WT_UQ, gtid, gsz);
  transpose_w(p.b_w_ukv, 256, 1024, 1024, p.WT_UKV, gtid, gsz);
  transpose_w(p.cd_w_in, 1024, 2304, 2304, p.WT_CDIN, gtid, gsz);
  transpose_w(p.cd_w_o, 1024, 1024, 1024, p.WT_CDO, gtid, gsz);
  transpose_w(p.peer_w_q, 1024, 2048, 2048, p.WT_PQ, gtid, gsz);
  transpose_w(p.peer_w_q + 1024L * 2048, 1024, 2048, 2048, p.WT_PQ + 2048L * 1024, gtid, gsz);
  convert8(p.peer_keys, p.KEYS16, 2L * 16 * 128 * 128 / 8, gtid, gsz);
}

DI void phase_modulate(const Params& p, const float* src_lat, const float* src_ctx, int nrows, const float* normw,
                       const float* modl, int sh_off, int sc_off) {
  const int lane = threadIdx.x & 63, w = threadIdx.x >> 6;
  const int stride = gridDim.x * 4;
  int m = blockIdx.x * 4 + w;
  f32x4 v[4], vn[4];
  f32x4 nw[4];
#pragma unroll
  for (int i = 0; i < 4; ++i) nw[i] = *(const f32x4*)(normw + i * 256 + lane * 4);
  if (m < nrows) {
    const float* src = (m < TL) ? src_lat + (long)m * 1024 : src_ctx + (long)(m - TL) * 1024;
#pragma unroll
    for (int i = 0; i < 4; ++i) v[i] = *(const f32x4*)(src + i * 256 + lane * 4);
  }
  while (m < nrows) {
    const int mn = m + stride;
    if (mn < nrows) {
      const float* src = (mn < TL) ? src_lat + (long)mn * 1024 : src_ctx + (long)(mn - TL) * 1024;
#pragma unroll
      for (int i = 0; i < 4; ++i) vn[i] = *(const f32x4*)(src + i * 256 + lane * 4);
    }
    const int bi = (m < TL) ? (m >> 11) : 8;
    const float* md = modl + bi * 6144;
    f32x4 sc[4], sh[4];
#pragma unroll
    for (int i = 0; i < 4; ++i) {
      sc[i] = *(const f32x4*)(md + sc_off + i * 256 + lane * 4);
      sh[i] = *(const f32x4*)(md + sh_off + i * 256 + lane * 4);
    }
    float ss = 0.f;
#pragma unroll
    for (int i = 0; i < 4; ++i) ss += v[i].x * v[i].x + v[i].y * v[i].y + v[i].z * v[i].z + v[i].w * v[i].w;
    ss = wsum_fast(ss);
    const float rstd = rsqrtf(ss * (1.f / 1024.f) + EPSF);
#pragma unroll
    for (int i = 0; i < 4; ++i) {
      const int col = i * 256 + lane * 4;
      const float y0 = v[i].x * rstd * nw[i].x * (1.f + sc[i].x) + sh[i].x;
      const float y1 = v[i].y * rstd * nw[i].y * (1.f + sc[i].y) + sh[i].y;
      const float y2 = v[i].z * rstd * nw[i].z * (1.f + sc[i].z) + sh[i].z;
      const float y3 = v[i].w * rstd * nw[i].w * (1.f + sc[i].w) + sh[i].w;
      u32x2 o = {pack2(y0, y1), pack2(y2, y3)};
      *(u32x2*)(p.HB + (long)m * 1024 + col) = o;
    }
#pragma unroll
    for (int i = 0; i < 4; ++i) v[i] = vn[i];
    m = mn;
  }
}

struct EpiArgs {
  void* C; int ldc; int N;
  const float* xin_lat; const float* xin_ctx; const float* g;
};
template <int EPI>
DI void gemm_phase(char* smem, const u16* __restrict__ A, int lda, int acs, const u16* __restrict__ Wt, int K, int MT, int NT,
                   int rot, const EpiArgs& ea) {
  u16* sAB = (u16*)smem;
  constexpr int STG = 2 * 128 * 72;
  const int tid = threadIdx.x, lane = tid & 63, w = tid >> 6, r = lane & 31, h = lane >> 5;
  const int wm = w >> 1, wn = w & 1;
  const int nslot = gridDim.x >> 3, xcd = blockIdx.x & 7;
  int first = ((int)(blockIdx.x >> 3) - rot) % nslot;
  if (first < 0) first += nslot;
  const int lrow = tid >> 3, lkc = tid & 7;
  const int per_xcd = (MT >> 3) * NT;
  for (int t = first; t < per_xcd; t += nslot) {
    const int mt = xcd + 8 * (t / NT), nt = t % NT;
    const u16* Ab = A + (long)(mt * 128 + lrow) * lda + nt * acs + lkc * 8;
    const u16* Bb = Wt + (long)(nt * 128 + lrow) * K + lkc * 8;
    f32x16 acc[2][2];
#pragma unroll
    for (int i = 0; i < 2; ++i)
#pragma unroll
      for (int j = 0; j < 2; ++j) acc[i][j] = zero16();
    u32x4 ra0[4], rb0[4], ra1[4], rb1[4];
    const int nk = K >> 6;
#pragma unroll
    for (int i = 0; i < 4; ++i) {
      ra0[i] = *(const u32x4*)(Ab + (long)(32 * i) * lda);
      rb0[i] = *(const u32x4*)(Bb + (long)(32 * i) * K);
    }
#pragma unroll
    for (int i = 0; i < 4; ++i) {
      ra1[i] = *(const u32x4*)(Ab + (long)(32 * i) * lda + 64);
      rb1[i] = *(const u32x4*)(Bb + (long)(32 * i) * K + 64);
    }
    __syncthreads();
#pragma unroll
    for (int i = 0; i < 4; ++i) {
      *(u32x4*)(sAB + (lrow + 32 * i) * 72 + lkc * 8) = ra0[i];
      *(u32x4*)(sAB + 128 * 72 + (lrow + 32 * i) * 72 + lkc * 8) = rb0[i];
    }
    __syncthreads();
    for (int k0 = 0; k0 < nk; k0 += 2) {
      if (k0 + 2 < nk) {
#pragma unroll
        for (int i = 0; i < 4; ++i) {
          ra0[i] = *(const u32x4*)(Ab + (long)(32 * i) * lda + (k0 + 2) * 64);
          rb0[i] = *(const u32x4*)(Bb + (long)(32 * i) * K + (k0 + 2) * 64);
        }
      }
      {
        const u16* cA = sAB;
        const u16* cB = cA + 128 * 72;
#pragma unroll
        for (int ks = 0; ks < 4; ++ks) {
          bf16x8 af[2], bfr[2];
#pragma unroll
          for (int i = 0; i < 2; ++i) {
            af[i] = *(const bf16x8*)(cA + (wm * 64 + i * 32 + r) * 72 + ks * 16 + h * 8);
            bfr[i] = *(const bf16x8*)(cB + (wn * 64 + i * 32 + r) * 72 + ks * 16 + h * 8);
          }
#pragma unroll
          for (int i = 0; i < 2; ++i)
#pragma unroll
            for (int j = 0; j < 2; ++j) acc[i][j] = MFMA(af[i], bfr[j], acc[i][j]);
        }
      }
      {
        u16* nA = sAB + STG;
#pragma unroll
        for (int i = 0; i < 4; ++i) {
          *(u32x4*)(nA + (lrow + 32 * i) * 72 + lkc * 8) = ra1[i];
          *(u32x4*)(nA + 128 * 72 + (lrow + 32 * i) * 72 + lkc * 8) = rb1[i];
        }
        __syncthreads();
      }
      if (k0 + 3 < nk) {
#pragma unroll
        for (int i = 0; i < 4; ++i) {
          ra1[i] = *(const u32x4*)(Ab + (long)(32 * i) * lda + (k0 + 3) * 64);
          rb1[i] = *(const u32x4*)(Bb + (long)(32 * i) * K + (k0 + 3) * 64);
        }
      }
      {
        const u16* cA = sAB + STG;
        const u16* cB = cA + 128 * 72;
#pragma unroll
        for (int ks = 0; ks < 4; ++ks) {
          bf16x8 af[2], bfr[2];
#pragma unroll
          for (int i = 0; i < 2; ++i) {
            af[i] = *(const bf16x8*)(cA + (wm * 64 + i * 32 + r) * 72 + ks * 16 + h * 8);
            bfr[i] = *(const bf16x8*)(cB + (wn * 64 + i * 32 + r) * 72 + ks * 16 + h * 8);
          }
#pragma unroll
          for (int i = 0; i < 2; ++i)
#pragma unroll
            for (int j = 0; j < 2; ++j) acc[i][j] = MFMA(af[i], bfr[j], acc[i][j]);
        }
      }
      if (k0 + 2 < nk) {
        u16* nA = sAB;
#pragma unroll
        for (int i = 0; i < 4; ++i) {
          *(u32x4*)(nA + (lrow + 32 * i) * 72 + lkc * 8) = ra0[i];
          *(u32x4*)(nA + 128 * 72 + (lrow + 32 * i) * 72 + lkc * 8) = rb0[i];
        }
        __syncthreads();
      }
    }
#pragma unroll
    for (int i = 0; i < 2; ++i)
#pragma unroll
      for (int j = 0; j < 2; ++j) {
        const int n = nt * 128 + wn * 64 + j * 32 + r;
        if (n < ea.N) {
#pragma unroll
          for (int reg = 0; reg < 16; ++reg) {
            const int m = mt * 128 + wm * 64 + i * 32 + crow(reg, h);
            const float v = acc[i][j][reg];
            if (EPI == 0) {
              ((u16*)ea.C)[(long)m * ea.ldc + n] = f2bf(v);
            } else if (EPI == 1) {
              ((float*)ea.C)[(long)m * ea.ldc + n] = v;
            } else {
              const int bi = (m < TL) ? (m >> 11) : 8;
              const float g = ea.g[bi * 6144 + n];
              float* dst = (float*)ea.C + (long)m * 1024 + n;
              float base;
              if (EPI == 2) base = (m < TL) ? ea.xin_lat[(long)m * 1024 + n] : ea.xin_ctx[(long)(m - TL) * 1024 + n];
              else base = *dst;
              *dst = base + g * v;
            }
          }
        }
      }
  }
}

DI void gemm_pq_scores(char* smem, const u16* __restrict__ A, const u16* __restrict__ Wt, const u16* __restrict__ KEYS, float* __restrict__ SC, int MT) {
  constexpr int lda = 1024, acs = 0, K = 1024, NT = 16, rot = 0;
  u16* sAB = (u16*)smem;
  constexpr int STG = 2 * 128 * 72;
  const int tid = threadIdx.x, lane = tid & 63, w = tid >> 6, r = lane & 31, h = lane >> 5;
  const int wm = w >> 1, wn = w & 1;
  const int nslot = gridDim.x >> 3, xcd = blockIdx.x & 7;
  int first = ((int)(blockIdx.x >> 3) - rot) % nslot;
  if (first < 0) first += nslot;
  const int lrow = tid >> 3, lkc = tid & 7;
  const int per_xcd = (MT >> 3) * NT;
  for (int t = first; t < per_xcd; t += nslot) {
    const int mt = xcd + 8 * (t / NT), nt = t % NT;
    const u16* Ab = A + (long)(mt * 128 + lrow) * lda + nt * acs + lkc * 8;
    const u16* Bb = Wt + (long)(nt * 128 + lrow) * K + lkc * 8;
    f32x16 acc[2][2];
#pragma unroll
    for (int i = 0; i < 2; ++i)
#pragma unroll
      for (int j = 0; j < 2; ++j) acc[i][j] = zero16();
    u32x4 ra0[4], rb0[4], ra1[4], rb1[4];
    const int nk = K >> 6;
#pragma unroll
    for (int i = 0; i < 4; ++i) {
      ra0[i] = *(const u32x4*)(Ab + (long)(32 * i) * lda);
      rb0[i] = *(const u32x4*)(Bb + (long)(32 * i) * K);
    }
#pragma unroll
    for (int i = 0; i < 4; ++i) {
      ra1[i] = *(const u32x4*)(Ab + (long)(32 * i) * lda + 64);
      rb1[i] = *(const u32x4*)(Bb + (long)(32 * i) * K + 64);
    }
    __syncthreads();
#pragma unroll
    for (int i = 0; i < 4; ++i) {
      *(u32x4*)(sAB + (lrow + 32 * i) * 72 + lkc * 8) = ra0[i];
      *(u32x4*)(sAB + 128 * 72 + (lrow + 32 * i) * 72 + lkc * 8) = rb0[i];
    }
    __syncthreads();
    for (int k0 = 0; k0 < nk; k0 += 2) {
      if (k0 + 2 < nk) {
#pragma unroll
        for (int i = 0; i < 4; ++i) {
          ra0[i] = *(const u32x4*)(Ab + (long)(32 * i) * lda + (k0 + 2) * 64);
          rb0[i] = *(const u32x4*)(Bb + (long)(32 * i) * K + (k0 + 2) * 64);
        }
      }
      {
        const u16* cA = sAB;
        const u16* cB = cA + 128 * 72;
#pragma unroll
        for (int ks = 0; ks < 4; ++ks) {
          bf16x8 af[2], bfr[2];
#pragma unroll
          for (int i = 0; i < 2; ++i) {
            af[i] = *(const bf16x8*)(cA + (wm * 64 + i * 32 + r) * 72 + ks * 16 + h * 8);
            bfr[i] = *(const bf16x8*)(cB + (wn * 64 + i * 32 + r) * 72 + ks * 16 + h * 8);
          }
#pragma unroll
          for (int i = 0; i < 2; ++i)
#pragma unroll
            for (int j = 0; j < 2; ++j) acc[i][j] = MFMA(bfr[j], af[i], acc[i][j]);
        }
      }
      {
        u16* nA = sAB + STG;
#pragma unroll
        for (int i = 0; i < 4; ++i) {
          *(u32x4*)(nA + (lrow + 32 * i) * 72 + lkc * 8) = ra1[i];
          *(u32x4*)(nA + 128 * 72 + (lrow + 32 * i) * 72 + lkc * 8) = rb1[i];
        }
        __syncthreads();
      }
      if (k0 + 3 < nk) {
#pragma unroll
        for (int i = 0; i < 4; ++i) {
          ra1[i] = *(const u32x4*)(Ab + (long)(32 * i) * lda + (k0 + 3) * 64);
          rb1[i] = *(const u32x4*)(Bb + (long)(32 * i) * K + (k0 + 3) * 64);
        }
      }
      {
        const u16* cA = sAB + STG;
        const u16* cB = cA + 128 * 72;
#pragma unroll
        for (int ks = 0; ks < 4; ++ks) {
          bf16x8 af[2], bfr[2];
#pragma unroll
          for (int i = 0; i < 2; ++i) {
            af[i] = *(const bf16x8*)(cA + (wm * 64 + i * 32 + r) * 72 + ks * 16 + h * 8);
            bfr[i] = *(const bf16x8*)(cB + (wn * 64 + i * 32 + r) * 72 + ks * 16 + h * 8);
          }
#pragma unroll
          for (int i = 0; i < 2; ++i)
#pragma unroll
            for (int j = 0; j < 2; ++j) acc[i][j] = MFMA(bfr[j], af[i], acc[i][j]);
        }
      }
      if (k0 + 2 < nk) {
        u16* nA = sAB;
#pragma unroll
        for (int i = 0; i < 4; ++i) {
          *(u32x4*)(nA + (lrow + 32 * i) * 72 + lkc * 8) = ra0[i];
          *(u32x4*)(nA + 128 * 72 + (lrow + 32 * i) * 72 + lkc * 8) = rb0[i];
        }
        __syncthreads();
      }
    }
    u16* sQ = (u16*)smem;
    u16* sKy = sQ + 128 * 136;
    u32x4 kreg[8];
    {
      const u16* kp = KEYS + (long)nt * 128 * 128;
#pragma unroll
      for (int i = 0; i < 8; ++i) { const int c = tid + i * 256; kreg[i] = *(const u32x4*)(kp + (long)(c >> 4) * 128 + (c & 15) * 8); }
    }
    __syncthreads();
#pragma unroll
    for (int i = 0; i < 2; ++i)
#pragma unroll
      for (int j = 0; j < 2; ++j)
#pragma unroll
        for (int g = 0; g < 4; ++g) {
          u32x2 o = {pack2(acc[i][j][4 * g], acc[i][j][4 * g + 1]), pack2(acc[i][j][4 * g + 2], acc[i][j][4 * g + 3])};
          *(u32x2*)(sQ + (wm * 64 + i * 32 + r) * 136 + wn * 64 + j * 32 + 8 * g + 4 * h) = o;
        }
#pragma unroll
    for (int i = 0; i < 8; ++i) { const int c = tid + i * 256; *(u32x4*)(sKy + (c >> 4) * 136 + (c & 15) * 8) = kreg[i]; }
    __syncthreads();
#pragma unroll
    for (int i = 0; i < 2; ++i)
#pragma unroll
      for (int j = 0; j < 2; ++j) acc[i][j] = zero16();
#pragma unroll
    for (int ks = 0; ks < 8; ++ks) {
      bf16x8 af[2], bfr[2];
#pragma unroll
      for (int i = 0; i < 2; ++i) {
        af[i] = *(const bf16x8*)(sQ + (wm * 64 + i * 32 + r) * 136 + ks * 16 + h * 8);
        bfr[i] = *(const bf16x8*)(sKy + (wn * 64 + i * 32 + r) * 136 + ks * 16 + h * 8);
      }
#pragma unroll
      for (int i = 0; i < 2; ++i)
#pragma unroll
        for (int j = 0; j < 2; ++j) acc[i][j] = MFMA(af[i], bfr[j], acc[i][j]);
    }
#pragma unroll
    for (int i = 0; i < 2; ++i)
#pragma unroll
      for (int j = 0; j < 2; ++j) {
        const int n = nt * 128 + wn * 64 + j * 32 + r;
#pragma unroll
        for (int reg = 0; reg < 16; ++reg) {
          const int m = mt * 128 + wm * 64 + i * 32 + crow(reg, h);
          SC[(long)m * 2048 + n] = acc[i][j][reg];
        }
      }
  }
}

DI float rope64(float y, int lane, int prow, int pcol, const float* __restrict__ R16) {
  const float partner = __shfl_xor(y, 16);
  const int pos = (lane < 32) ? prow : pcol;
  const f32x2 cs = *(const f32x2*)(R16 + (pos * 16 + (lane & 15)) * 2);
  return (lane & 16) ? (y * cs.x + partner * cs.y) : (y * cs.x - partner * cs.y);
}
DI float rope32(float y, int lane, int prow, int pcol, const float* __restrict__ R8) {
  const float partner = __shfl_xor(y, 8);
  const int pp = lane & 31;
  const int pos = (pp < 16) ? prow : pcol;
  const f32x2 cs = *(const f32x2*)(R8 + (pos * 8 + (pp & 7)) * 2);
  return (pp & 8) ? (y * cs.x + partner * cs.y) : (y * cs.x - partner * cs.y);
}

template <int CTRL>
DI float dppf(float v) { return __builtin_bit_cast(float, __builtin_amdgcn_update_dpp(0, __builtin_bit_cast(int, v), CTRL, 0xf, 0xf, false)); }
DI void unpack8(u32x4 r, float* x) {
#pragma unroll
  for (int q = 0; q < 4; ++q) { x[2 * q] = bflo(r[q]); x[2 * q + 1] = bfhi(r[q]); }
}
DI u32x4 pack8f(const float* y) { u32x4 o = {pack2(y[0], y[1]), pack2(y[2], y[3]), pack2(y[4], y[5]), pack2(y[6], y[7])}; return o; }
DI float sumsq8(const float* x) { float s = 0.f;
#pragma unroll
  for (int j = 0; j < 8; ++j) s += x[j] * x[j];
  return s; }
DI float sum_group8(float v) { v += dppf<0xB1>(v); v += dppf<0x4E>(v); v += dppf<0x141>(v); return v; }
DI void rope_head64(float* y, int cc8, const float* cs) {
  const bool second = (cc8 & 2) != 0;
#pragma unroll
  for (int j = 0; j < 8; ++j) {
    const float pr = dppf<0x4E>(y[j]);
    y[j] = second ? (y[j] * cs[2 * j] + pr * cs[2 * j + 1]) : (y[j] * cs[2 * j] - pr * cs[2 * j + 1]);
  }
}
DI void load_cs8(const float* tab, float* cs) {
#pragma unroll
  for (int q = 0; q < 4; ++q) { const f32x4 t = *(const f32x4*)(tab + q * 4); cs[4 * q] = t.x; cs[4 * q + 1] = t.y; cs[4 * q + 2] = t.z; cs[4 * q + 3] = t.w; }
}
DI void load_w8(const float* wsrc, float* wv) {
  const f32x4 a = *(const f32x4*)wsrc, b = *(const f32x4*)(wsrc + 4);
  wv[0] = a.x; wv[1] = a.y; wv[2] = a.z; wv[3] = a.w; wv[4] = b.x; wv[5] = b.y; wv[6] = b.z; wv[7] = b.w;
}
DI void phase_post0a(const Params& p) {
  const int lane = threadIdx.x & 63, w = threadIdx.x >> 6, cc8 = lane & 7;
  float wq[8], wk[8], wl[8];
  load_w8(p.a_q_norm + cc8 * 8, wq);
  load_w8(p.a_k_norm + cc8 * 8, wk);
  load_w8((lane < 32 ? p.b_kv_lora_norm : p.b_q_lora_norm) + (lane & 31) * 8, wl);
  const int offB = (lane < 32) ? 512 + (lane & 15) * 8 : 768 + (lane - 32) * 8;
  const int stride = gridDim.x * 4;
  int m = blockIdx.x * 4 + w;
  u32x4 rA, rB, rC, nA, nB, nC;
  if (m < TA) {
    const u16* z0 = p.Z + (long)m * 1312;
    rA = *(const u32x4*)(z0 + lane * 8); rB = *(const u32x4*)(z0 + offB); rC = *(const u32x4*)(z0 + 1024 + (lane & 31) * 8);
  }
  for (; m < TA; m += stride) {
    u16* z = p.Z + (long)m * 1312;
    const bool lat = m < TL;
    const int s = m & 2047, prow = s >> 6, pcol = s & 63;
    if (m + stride < TA) {
      const u16* zn = p.Z + (long)(m + stride) * 1312;
      nA = *(const u32x4*)(zn + lane * 8); nB = *(const u32x4*)(zn + offB); nC = *(const u32x4*)(zn + 1024 + (lane & 31) * 8);
    }
    float cs[16];
    load_cs8(p.ROPE16 + ((((cc8 < 4) ? prow : pcol) * 16 + (cc8 & 1) * 8) * 2), cs);
    float x[8];
    {
      unpack8(rA, x);
      const float rstd = rsqrtf(sum_group8(sumsq8(x)) * (1.f / 64.f) + EPSF);
#pragma unroll
      for (int j = 0; j < 8; ++j) x[j] *= rstd * wq[j] * (0.125f * LOG2E);
      if (lat) rope_head64(x, cc8, cs);
      *(u32x4*)(z + lane * 8) = pack8f(x);
    }
    {
      unpack8(rB, x);
      const float ssq = sumsq8(x);
      const float g8 = sum_group8(ssq);
      const float r16 = rowsum16(ssq);
      const int ir = __builtin_bit_cast(int, r16);
      const float t256 = __builtin_bit_cast(float, __builtin_amdgcn_readlane(ir, 32)) + __builtin_bit_cast(float, __builtin_amdgcn_readlane(ir, 48));
      if (lane < 32) {
        const float rstd = rsqrtf(g8 * (1.f / 64.f) + EPSF);
#pragma unroll
        for (int j = 0; j < 8; ++j) x[j] *= rstd * wk[j];
      } else {
        const float rstd = rsqrtf(t256 * (1.f / 256.f) + EPSF);
#pragma unroll
        for (int j = 0; j < 8; ++j) x[j] *= rstd * wl[j];
      }
      float xr[8];
#pragma unroll
      for (int j = 0; j < 8; ++j) xr[j] = x[j];
      rope_head64(xr, cc8, cs);
      if (lat && lane < 16) {
#pragma unroll
        for (int j = 0; j < 8; ++j) x[j] = xr[j];
      }
      if (lane < 16 || lane >= 32) *(u32x4*)(z + offB) = pack8f(x);
    }
    {
      unpack8(rC, x);
      const float r16 = rowsum16(sumsq8(x));
      const int ir = __builtin_bit_cast(int, r16);
      const float t256 = __builtin_bit_cast(float, __builtin_amdgcn_readlane(ir, 0)) + __builtin_bit_cast(float, __builtin_amdgcn_readlane(ir, 16));
      const float rstd = rsqrtf(t256 * (1.f / 256.f) + EPSF);
#pragma unroll
      for (int j = 0; j < 8; ++j) x[j] *= rstd * wl[j];
      if (lane < 32) *(u32x4*)(z + 1024 + lane * 8) = pack8f(x);
    }
    rA = nA; rB = nB; rC = nC;
  }
}
DI void rope_tail96(float* y, int c16, const float* cs) {
  const bool second = (c16 & 1) != 0;
#pragma unroll
  for (int j = 0; j < 8; ++j) {
    const float pr = dppf<0xB1>(y[j]);
    const float rz = second ? (y[j] * cs[2 * j] + pr * cs[2 * j + 1]) : (y[j] * cs[2 * j] - pr * cs[2 * j + 1]);
    y[j] = (c16 >= 8) ? rz : y[j];
  }
}
DI void phase_post0b(const Params& p) {
  const int lane = threadIdx.x & 63, w = threadIdx.x >> 6, c16 = lane & 15, hr = lane >> 4;
  const bool act = c16 < 12;
  float wq[8], wk[8];
  load_w8(p.b_q_norm + (act ? c16 : 0) * 8, wq);
  load_w8(p.b_k_norm + (act ? c16 : 0) * 8, wk);
  for (int m = blockIdx.x * 4 + w; m < TA; m += gridDim.x * 4) {
    const bool lat = m < TL;
    const int s = m & 2047, prow = s >> 6, pcol = s & 63;
    u16* q = p.QB + (long)m * 768;
    const u16* kv = p.KVR + (long)m * 1024;
    u16* kb = p.KB + (long)m * 768;
    u16* vb = p.VB + (long)m * 512;
    const u16* kr = p.Z + (long)m * 1312 + 1280;
    const u32x4 zero4 = {0u, 0u, 0u, 0u};
    u32x4 rq[2], rk[2];
#pragma unroll
    for (int ps = 0; ps < 2; ++ps) {
      const int hd = ps * 4 + hr;
      rq[ps] = act ? *(const u32x4*)(q + hd * 96 + c16 * 8) : zero4;
      rk[ps] = act ? ((c16 < 8) ? *(const u32x4*)(kv + hd * 128 + c16 * 8) : *(const u32x4*)(kr + (c16 - 8) * 8)) : zero4;
    }
    const u32x4 rv = *(const u32x4*)(kv + (lane >> 3) * 128 + 64 + (lane & 7) * 8);
    float cs[16];
    load_cs8(p.ROPE8 + ((((c16 < 10) ? prow : pcol) * 8) * 2), cs);
    float x[8];
#pragma unroll
    for (int ps = 0; ps < 2; ++ps) {
      const int hd = ps * 4 + hr;
      unpack8(rq[ps], x);
      float rstd = rsqrtf(rowsum16(sumsq8(x)) * (1.f / 96.f) + EPSF);
#pragma unroll
      for (int j = 0; j < 8; ++j) x[j] *= rstd * wq[j] * (0.10206207261596575f * LOG2E);
      if (lat) rope_tail96(x, c16, cs);
      if (act) *(u32x4*)(q + hd * 96 + c16 * 8) = pack8f(x);
      unpack8(rk[ps], x);
      rstd = rsqrtf(rowsum16(sumsq8(x)) * (1.f / 96.f) + EPSF);
#pragma unroll
      for (int j = 0; j < 8; ++j) x[j] *= rstd * wk[j];
      if (lat) rope_tail96(x, c16, cs);
      if (act) *(u32x4*)(kb + hd * 96 + c16 * 8) = pack8f(x);
    }
    *(u32x4*)(vb + lane * 8) = rv;
  }
}
DI void phase_post1(const Params& p) {
  const int lane = threadIdx.x & 63, w = threadIdx.x >> 6, cc8 = lane & 7;
  float wq[8], wk[8];
  load_w8(p.d_q_norm + cc8 * 8, wq);
  load_w8(p.d_k_norm + cc8 * 8, wk);
  const int stride = gridDim.x * 4;
  int m = blockIdx.x * 4 + w;
  u32x4 rA, rB, rC, nA, nB, nC;
  if (m < TA) {
    const u16* z0 = p.Z + (long)m * 2304;
    rA = *(const u32x4*)(z0 + lane * 8); rB = *(const u32x4*)(z0 + 1536 + lane * 8); rC = *(const u32x4*)(z0 + 2048 + (lane & 15) * 8);
  }
  for (; m < TA; m += stride) {
    u16* z = p.Z + (long)m * 2304;
    const bool lat = m < TL;
    const int s = m & 2047, prow = s >> 6, pcol = s & 63;
    if (m + stride < TA) {
      const u16* zn = p.Z + (long)(m + stride) * 2304;
      nA = *(const u32x4*)(zn + lane * 8); nB = *(const u32x4*)(zn + 1536 + lane * 8); nC = *(const u32x4*)(zn + 2048 + (lane & 15) * 8);
    }
    float cs[16];
    load_cs8(p.ROPE16 + ((((cc8 < 4) ? prow : pcol) * 16 + (cc8 & 1) * 8) * 2), cs);
    float x[8];
    {
      unpack8(rA, x);
      const float sc = (lane >= 32) ? 0.125f : 1.f;
#pragma unroll
      for (int j = 0; j < 8; ++j) x[j] *= sc;
      if (lat) rope_head64(x, cc8, cs);
      if (lat || lane >= 32) *(u32x4*)(z + lane * 8) = pack8f(x);
    }
    {
      unpack8(rB, x);
      const float rstd = rsqrtf(sum_group8(sumsq8(x)) * (1.f / 64.f) + EPSF);
#pragma unroll
      for (int j = 0; j < 8; ++j) x[j] *= rstd * wq[j] * (0.125f * LOG2E);
      if (lat) rope_head64(x, cc8, cs);
      *(u32x4*)(z + 1536 + lane * 8) = pack8f(x);
    }
    {
      unpack8(rC, x);
      const float rstd = rsqrtf(sum_group8(sumsq8(x)) * (1.f / 64.f) + EPSF);
#pragma unroll
      for (int j = 0; j < 8; ++j) x[j] *= rstd * wk[j];
      if (lat) rope_head64(x, cc8, cs);
      if (lane < 16) *(u32x4*)(z + 2048 + lane * 8) = pack8f(x);
    }
    rA = nA; rB = nB; rC = nC;
  }
}

template <int DQK>
DI void attn_item(char* smem, const u16* __restrict__ Qp, int qs, const u16* __restrict__ K0, const u16* __restrict__ V0,
                  int ks0, int vs0, int n0, const u16* __restrict__ K1, const u16* __restrict__ V1, int ks1, int vs1, int kbeg,
                  int kend, bool band, int qpos0, float scale, bool has_sink, float sink, u16* __restrict__ Op, int os) {
  constexpr int KSTR = DQK + 8, VROW = 96, KCH = DQK / 8, NKL = (64 * KCH) / 256;
  constexpr int NKS = DQK / 16;
  u16* sK = (u16*)smem;
  u16* sV = sK + 64 * KSTR;
  const int tid = threadIdx.x, lane = tid & 63, w = tid >> 6, r = lane & 31, h = lane >> 5;
  bf16x8 qf[NKS];
#pragma unroll
  for (int ks = 0; ks < NKS; ++ks) qf[ks] = *(const bf16x8*)(Qp + (long)(w * 32 + r) * qs + ks * 16 + h * 8);
  f32x16 oT[2];
  oT[0] = zero16(); oT[1] = zero16();
  (void)scale;
  float mrun = has_sink ? sink * LOG2E : -1e30f;
  float lrun = (has_sink && h == 0) ? 1.f : 0.f;
  const int nt0 = n0 >> 6, nt1 = (kend - kbeg) >> 6, ntot = nt0 + nt1;
  const int qpos = qpos0 + w * 32 + r;
  u32x4 rk[NKL], rv[2];
  auto tile_ptrs = [&](int t, const u16*& kp, const u16*& vp, int& kst, int& vst) {
    if (t < nt0) { kp = K0 + (long)(t * 64) * ks0; vp = V0 + (long)(t * 64) * vs0; kst = ks0; vst = vs0; }
    else { const int k0 = kbeg + (t - nt0) * 64; kp = K1 + (long)k0 * ks1; vp = V1 + (long)k0 * vs1; kst = ks1; vst = vs1; }
  };
  {
    const u16 *kp, *vp; int kst, vst;
    tile_ptrs(0, kp, vp, kst, vst);
#pragma unroll
    for (int i = 0; i < NKL; ++i) { const int c = tid + i * 256, key = c / KCH, kc = c % KCH; rk[i] = *(const u32x4*)(kp + (long)key * kst + kc * 8); }
#pragma unroll
    for (int i = 0; i < 2; ++i) { const int c = tid + i * 256, key = c >> 3, dc = c & 7; rv[i] = *(const u32x4*)(vp + (long)key * vst + dc * 8); }
  }
  for (int t = 0; t < ntot; ++t) {
    __syncthreads();
#pragma unroll
    for (int i = 0; i < NKL; ++i) { const int c = tid + i * 256, key = c / KCH, kc = c % KCH; *(u32x4*)(sK + key * KSTR + kc * 8) = rk[i]; }
#pragma unroll
    for (int i = 0; i < 2; ++i) { const int c = tid + i * 256, key = c >> 3, dc = c & 7; *(u32x4*)(sV + key * VROW + dc * 8) = rv[i]; }
    __syncthreads();
    if (t + 1 < ntot) {
      const u16 *kp, *vp; int kst, vst;
      tile_ptrs(t + 1, kp, vp, kst, vst);
#pragma unroll
      for (int i = 0; i < NKL; ++i) { const int c = tid + i * 256, key = c / KCH, kc = c % KCH; rk[i] = *(const u32x4*)(kp + (long)key * kst + kc * 8); }
#pragma unroll
      for (int i = 0; i < 2; ++i) { const int c = tid + i * 256, key = c >> 3, dc = c & 7; rv[i] = *(const u32x4*)(vp + (long)key * vst + dc * 8); }
    }
    f32x16 sT[2];
    sT[0] = zero16(); sT[1] = zero16();
#pragma unroll
    for (int kt = 0; kt < 2; ++kt)
#pragma unroll
      for (int ks = 0; ks < NKS; ++ks) {
        const bf16x8 kf = *(const bf16x8*)(sK + (kt * 32 + r) * KSTR + ks * 16 + h * 8);
        sT[kt] = MFMA(kf, qf[ks], sT[kt]);
      }
    const bool masked = band && (t >= nt0);
    const int kbase = kbeg + (t - nt0) * 64;
    float mx = -1e30f;
#pragma unroll
    for (int kt = 0; kt < 2; ++kt)
#pragma unroll
      for (int reg = 0; reg < 16; ++reg) {
        float sv = sT[kt][reg];
        if (masked) {
          const int kpos = kbase + kt * 32 + crow(reg, h);
          const int d = qpos - kpos;
          if (d > 128 || d < -128) sv = -1e30f;
        }
        sT[kt][reg] = sv;
        mx = fmaxf(mx, sv);
      }
    mx = fmaxf(mx, __shfl_xor(mx, 32));
    const float mnew = fmaxf(mrun, mx);
    const float alpha = ex2(mrun - mnew);
    mrun = mnew;
    float ps = 0.f;
#pragma unroll
    for (int kt = 0; kt < 2; ++kt)
#pragma unroll
      for (int reg = 0; reg < 16; ++reg) {
        const float pv = ex2(sT[kt][reg] - mnew);
        sT[kt][reg] = pv;
        ps += pv;
      }
    lrun = lrun * alpha + ps;
#pragma unroll
    for (int dt = 0; dt < 2; ++dt)
#pragma unroll
      for (int reg = 0; reg < 16; ++reg) oT[dt][reg] *= alpha;
#pragma unroll
    for (int kt = 0; kt < 2; ++kt)
#pragma unroll
      for (int s = 0; s < 2; ++s) {
        const bf16x8 pf = pack8(sT[kt], s);
#pragma unroll
        for (int dt = 0; dt < 2; ++dt) {
          const u16* vb0 = sV + (kt * 32 + s * 16 + 4 * h + ((lane & 15) >> 2)) * VROW + dt * 32 + ((lane >> 4) & 1) * 16 + (lane & 3) * 4;
          const s16x4 lo4 = __builtin_amdgcn_ds_read_tr16_b64_v4i16((LDS3 s16x4*)vb0);
          const s16x4 hi4 = __builtin_amdgcn_ds_read_tr16_b64_v4i16((LDS3 s16x4*)(vb0 + 8 * VROW));
          const bf16x8 vf = __builtin_shufflevector(lo4, hi4, 0, 1, 2, 3, 4, 5, 6, 7);
          oT[dt] = MFMA(vf, pf, oT[dt]);
        }
      }
  }
  const float ltot = lrun + __shfl_xor(lrun, 32);
  const float inv = 1.f / ltot;
#pragma unroll
  for (int dt = 0; dt < 2; ++dt)
#pragma unroll
    for (int g = 0; g < 4; ++g) {
      u32x2 o = {pack2(oT[dt][4 * g] * inv, oT[dt][4 * g + 1] * inv), pack2(oT[dt][4 * g + 2] * inv, oT[dt][4 * g + 3] * inv)};
      *(u32x2*)(Op + (long)(w * 32 + r) * os + dt * 32 + 8 * g + 4 * h) = o;
    }
}

DI void phase_attn0(const Params& p, char* smem) {
  const float sc96 = 0.10206207261596575f;
  for (int id = blockIdx.x; id < 2304; id += gridDim.x) {
    if (id < 1024) {
      const int b = id >> 7, hd = (id >> 4) & 7, qb = id & 15;
      const long qrow = (long)b * 2048 + qb * 128, crw = (long)TL + b * 256, lrow = (long)b * 2048;
      attn_item<96>(smem, p.QB + qrow * 768 + hd * 96, 768, p.KB + crw * 768 + hd * 96, p.VB + crw * 512 + hd * 64, 768, 512, 256,
                    p.KB + lrow * 768 + hd * 96, p.VB + lrow * 512 + hd * 64, 768, 512, 0, 2048, false, 0, sc96, false, 0.f,
                    p.AO + qrow * 1024 + 512 + hd * 64, 1024);
    } else if (id < 2048) {
      const int i2 = id - 1024;
      const int b = i2 >> 7, hd = (i2 >> 4) & 7, qb = i2 & 15, kvh = hd >> 2;
      const long qrow = (long)b * 2048 + qb * 128, crw = (long)TL + b * 256, lrow = (long)b * 2048;
      const int kbeg = (qb * 128 - 128) < 0 ? 0 : (qb * 128 - 128);
      const int kend = (qb * 128 + 256) > 2048 ? 2048 : (qb * 128 + 256);
      attn_item<64>(smem, p.Z + qrow * 1312 + hd * 64, 1312, p.Z + crw * 1312 + 512 + kvh * 64, p.Z + crw * 1312 + 640 + kvh * 64, 1312,
                    1312, 256, p.Z + lrow * 1312 + 512 + kvh * 64, p.Z + lrow * 1312 + 640 + kvh * 64, 1312, 1312, kbeg, kend, true,
                    qb * 128, 0.125f, true, p.a_sink[hd], p.AO + qrow * 1024 + hd * 64, 1024);
    } else if (id < 2176) {
      const int i2 = id - 2048;
      const int b = i2 >> 4, hd = (i2 >> 1) & 7, qb = i2 & 1, kvh = hd >> 2;
      const long qrow = (long)TL + b * 256 + qb * 128, crw = (long)TL + b * 256;
      attn_item<64>(smem, p.Z + qrow * 1312 + hd * 64, 1312, p.Z + crw * 1312 + 512 + kvh * 64, p.Z + crw * 1312 + 640 + kvh * 64, 1312,
                    1312, 256, p.Z, p.Z, 1312, 1312, 0, 0, false, 0, 0.125f, true, p.a_sink[hd], p.AO + qrow * 1024 + hd * 64, 1024);
    } else {
      const int i2 = id - 2176;
      const int b = i2 >> 4, hd = (i2 >> 1) & 7, qb = i2 & 1;
      const long qrow = (long)TL + b * 256 + qb * 128, crw = (long)TL + b * 256;
      attn_item<96>(smem, p.QB + qrow * 768 + hd * 96, 768, p.KB + crw * 768 + hd * 96, p.VB + crw * 512 + hd * 64, 768, 512, 256,
                    p.KB, p.VB, 768, 512, 0, 0, false, 0, sc96, false, 0.f, p.AO + qrow * 1024 + 512 + hd * 64, 1024);
    }
  }
}

DI long ret_row(int b, int dir, int c, int pp) {
  const int q = (c < 2) ? c * 128 + pp : (c - 2) * 128 + pp;
  if (c < 2) return (long)TL + b * 256 + (dir ? 255 - q : q);
  return (long)b * 2048 + (dir ? 2047 - q : q);
}
DI void ret_local_item(const Params& p, char* smem, int id) {
  const int c = id % 18, dir = (id / 18) & 1, hh = (id / 36) & 3, b = id / 144;
  u16* sK = (u16*)smem;
  u16* sV = sK + 128 * 64;
  float* sW = (float*)(sV + 128 * 128);
  const int tid = threadIdx.x;
  const float lg = log_sigmoid((dir ? p.c_decay_bwd : p.c_decay_fwd)[hh]);
  __syncthreads();
  for (int i = tid; i < 128 * 8; i += 256) {
    const int pp = i >> 3, ch = i & 7;
    const long row = ret_row(b, dir, c, pp);
    *(u32x4*)(sK + pp * 64 + ch * 8) = *(const u32x4*)(p.Z + row * 2304 + 256 + hh * 64 + ch * 8);
  }
  for (int i = tid; i < 128 * 16; i += 256) {
    const int pp = i >> 4, ch = i & 15;
    const long row = ret_row(b, dir, c, pp);
    *(u32x4*)(sV + pp * 128 + ch * 8) = *(const u32x4*)(p.Z + row * 2304 + 512 + hh * 128 + ch * 8);
  }
  if (tid < 128) sW[tid] = __expf(lg * (float)(127 - tid));
  __syncthreads();
  const int d = tid >> 2, vq = tid & 3;
  float acc[32];
#pragma unroll
  for (int j = 0; j < 32; ++j) acc[j] = 0.f;
  for (int pp = 0; pp < 128; ++pp) {
    const float kv = bf2f(sK[pp * 64 + d]) * sW[pp];
#pragma unroll
    for (int q = 0; q < 4; ++q) {
      const u32x4 vv = *(const u32x4*)(sV + pp * 128 + vq * 32 + q * 8);
      acc[q * 8 + 0] += kv * bflo(vv.x); acc[q * 8 + 1] += kv * bfhi(vv.x);
      acc[q * 8 + 2] += kv * bflo(vv.y); acc[q * 8 + 3] += kv * bfhi(vv.y);
      acc[q * 8 + 4] += kv * bflo(vv.z); acc[q * 8 + 5] += kv * bfhi(vv.z);
      acc[q * 8 + 6] += kv * bflo(vv.w); acc[q * 8 + 7] += kv * bfhi(vv.w);
    }
  }
  u16* dst = (u16*)p.LST + (long)id * 8192 + d * 128 + vq * 32;
#pragma unroll
  for (int q = 0; q < 4; ++q) *(u32x4*)(dst + q * 8) = pack8f(acc + q * 8);
}

DI void phase_attn1(const Params& p, char* smem) {
  for (int id = blockIdx.x; id < 1024 + 1152; id += gridDim.x) {
    if (id < 1024) {
      const int b = id >> 7, hd = (id >> 4) & 7, qb = id & 15, kvh = hd >> 2;
      const long qrow = (long)b * 2048 + qb * 128, crw = (long)TL + b * 256, lrow = (long)b * 2048;
      attn_item<64>(smem, p.Z + qrow * 2304 + 1536 + hd * 64, 2304, p.Z + crw * 2304 + 2048 + kvh * 64, p.Z + crw * 2304 + 2176 + kvh * 64,
                    2304, 2304, 256, p.Z + lrow * 2304 + 2048 + kvh * 64, p.Z + lrow * 2304 + 2176 + kvh * 64, 2304, 2304, 0, 2048, false, 0,
                    0.125f, false, 0.f, p.AO + qrow * 1024 + 512 + hd * 64, 1024);
    } else {
      ret_local_item(p, smem, id - 1024);
    }
  }
}

DI void ret_out_item(const Params& p, char* smem, int id) {
  const int c = id & 15, hh = (id >> 4) & 3, b = id >> 6;
  const int tid = threadIdx.x, lane = tid & 63, w = tid >> 6, r = lane & 31, h = lane >> 5;
  const float lgf = log_sigmoid(p.c_decay_fwd[hh]), lgb = log_sigmoid(p.c_decay_bwd[hh]);
  u16* sS = (u16*)smem;
  __syncthreads();
  {
    const int d = tid >> 2, vq = tid & 3;
#pragma unroll 1
    for (int dir = 0; dir < 2; ++dir) {
      const int cc = dir ? (17 - c) : (c + 2);
      const float lgG = (dir ? lgb : lgf) * 128.f;
      float acc[32];
#pragma unroll
      for (int j = 0; j < 32; ++j) acc[j] = 0.f;
#pragma unroll 8
      for (int c2 = 0; c2 < cc; ++c2) {
        const float coef = __expf(lgG * (float)(cc - 1 - c2));
        const u16* src = (const u16*)p.LST + ((long)(((b * 4 + hh) * 2 + dir) * 18 + c2)) * 8192 + d * 128 + vq * 32;
#pragma unroll
        for (int q = 0; q < 4; ++q) {
          const u32x4 v = *(const u32x4*)(src + q * 8);
          acc[q * 8] += coef * bflo(v.x); acc[q * 8 + 1] += coef * bfhi(v.x); acc[q * 8 + 2] += coef * bflo(v.y); acc[q * 8 + 3] += coef * bfhi(v.y);
          acc[q * 8 + 4] += coef * bflo(v.z); acc[q * 8 + 5] += coef * bfhi(v.z); acc[q * 8 + 6] += coef * bflo(v.w); acc[q * 8 + 7] += coef * bfhi(v.w);
        }
      }
#pragma unroll
      for (int j = 0; j < 32; ++j) sS[dir * 128 * 72 + (vq * 32 + j) * 72 + d] = f2bf(acc[j]);
    }
  }
  __syncthreads();
  const long qrow = (long)b * 2048 + c * 128 + w * 32 + r;
  const int qi = w * 32 + r;
  u32x4 qraw[4];
#pragma unroll
  for (int ks = 0; ks < 4; ++ks) qraw[ks] = *(const u32x4*)(p.Z + qrow * 2304 + hh * 64 + ks * 16 + h * 8);
  f32x16 oT[4];
#pragma unroll
  for (int vt = 0; vt < 4; ++vt) oT[vt] = zero16();
#pragma unroll 1
  for (int dir = 0; dir < 2; ++dir) {
    const float qd = dir ? __expf(lgb * (float)(128 - qi)) : __expf(lgf * (float)(qi + 1));
#pragma unroll
    for (int ks = 0; ks < 4; ++ks) {
      u32x4 sq;
      sq.x = pack2(bflo(qraw[ks].x) * qd, bfhi(qraw[ks].x) * qd);
      sq.y = pack2(bflo(qraw[ks].y) * qd, bfhi(qraw[ks].y) * qd);
      sq.z = pack2(bflo(qraw[ks].z) * qd, bfhi(qraw[ks].z) * qd);
      sq.w = pack2(bflo(qraw[ks].w) * qd, bfhi(qraw[ks].w) * qd);
      const bf16x8 qs8 = as_bf16x8(sq);
#pragma unroll
      for (int vt = 0; vt < 4; ++vt) {
        const bf16x8 sf = *(const bf16x8*)(sS + dir * 128 * 72 + (vt * 32 + r) * 72 + ks * 16 + h * 8);
        oT[vt] = MFMA(sf, qs8, oT[vt]);
      }
    }
  }
  __syncthreads();
  u16* sK = (u16*)smem;
  u16* sVt = sK + 128 * 72;
  const long crow0 = (long)b * 2048 + c * 128;
  for (int i = tid; i < 128 * 8; i += 256) {
    const int j = i >> 3, ch = i & 7;
    *(u32x4*)(sK + j * 72 + ch * 8) = *(const u32x4*)(p.Z + (crow0 + j) * 2304 + 256 + hh * 64 + ch * 8);
  }
  for (int i = tid; i < 128 * 16; i += 256) {
    const int j = i & 127, ch = i >> 7;
    const u32x4 vv = *(const u32x4*)(p.Z + (crow0 + j) * 2304 + 512 + hh * 128 + ch * 8);
    const unsigned ve[4] = {vv.x, vv.y, vv.z, vv.w};
#pragma unroll
    for (int q = 0; q < 4; ++q) {
      sVt[(ch * 8 + 2 * q) * 132 + j] = (u16)(ve[q] & 0xffffu);
      sVt[(ch * 8 + 2 * q + 1) * 132 + j] = (u16)(ve[q] >> 16);
    }
  }
  __syncthreads();
  const float l2f = lgf * LOG2E, l2b = lgb * LOG2E;
#pragma unroll 1
  for (int jt = 0; jt < 4; ++jt) {
    f32x16 sT = zero16();
#pragma unroll
    for (int ks = 0; ks < 4; ++ks) {
      const bf16x8 kf = *(const bf16x8*)(sK + (jt * 32 + r) * 72 + ks * 16 + h * 8);
      sT = MFMA(kf, as_bf16x8(qraw[ks]), sT);
    }
#pragma unroll
    for (int reg = 0; reg < 16; ++reg) {
      const int j = jt * 32 + crow(reg, h);
      const int df = qi - j;
      const float dec = (df > 0) ? ex2(l2f * (float)df) : ((df < 0) ? ex2(l2b * (float)(-df)) : 2.f);
      sT[reg] *= dec;
    }
#pragma unroll
    for (int s = 0; s < 2; ++s) {
      const bf16x8 pf = pack8(sT, s);
#pragma unroll
      for (int vt = 0; vt < 4; ++vt) {
        const u16* vr = sVt + (vt * 32 + r) * 132 + jt * 32 + s * 16 + h * 4;
        const bf16x8 vf = join8(*(const u32x2*)vr, *(const u32x2*)(vr + 8));
        oT[vt] = MFMA(vf, pf, oT[vt]);
      }
    }
  }
  float sm = 0.f;
#pragma unroll
  for (int vt = 0; vt < 4; ++vt)
#pragma unroll
    for (int reg = 0; reg < 16; ++reg) sm += oT[vt][reg];
  sm += __shfl_xor(sm, 32);
  const float mu = sm * (1.f / 128.f);
  float sv = 0.f;
#pragma unroll
  for (int vt = 0; vt < 4; ++vt)
#pragma unroll
    for (int reg = 0; reg < 16; ++reg) { const float dd = oT[vt][reg] - mu; sv += dd * dd; }
  sv += __shfl_xor(sv, 32);
  const float rstd = rsqrtf(sv * (1.f / 128.f) + EPSF);
#pragma unroll
  for (int vt = 0; vt < 4; ++vt) {
    __builtin_amdgcn_sched_barrier(0);
#pragma unroll
    for (int g = 0; g < 4; ++g) {
      const int v0 = vt * 32 + 8 * g + 4 * h;
      const u32x2 graw = *(const u32x2*)(p.Z + qrow * 2304 + 1024 + hh * 128 + v0);
      const f32x4 gw = *(const f32x4*)(p.c_gn_w + hh * 128 + v0);
      const float y0 = silu(bflo(graw.x)) * (oT[vt][4 * g] - mu) * rstd * gw.x;
      const float y1 = silu(bfhi(graw.x)) * (oT[vt][4 * g + 1] - mu) * rstd * gw.y;
      const float y2 = silu(bflo(graw.y)) * (oT[vt][4 * g + 2] - mu) * rstd * gw.z;
      const float y3 = silu(bfhi(graw.y)) * (oT[vt][4 * g + 3] - mu) * rstd * gw.w;
      u32x2 o = {pack2(y0, y1), pack2(y2, y3)};
      *(u32x2*)(p.AO + qrow * 1024 + hh * 128 + v0) = o;
    }
  }
}

DI unsigned fkey(float f) {
  const unsigned u = __float_as_uint(f);
  return u ^ ((unsigned)((int)u >> 31) | 0x80000000u);
}
DI unsigned wmax_u32_fast(unsigned v) {
  unsigned t;
  t = (unsigned)__builtin_amdgcn_update_dpp(0, (int)v, 0x128, 0xf, 0xf, false); v = v > t ? v : t;
  t = (unsigned)__builtin_amdgcn_update_dpp(0, (int)v, 0x124, 0xf, 0xf, false); v = v > t ? v : t;
  t = (unsigned)__builtin_amdgcn_update_dpp(0, (int)v, 0x122, 0xf, 0xf, false); v = v > t ? v : t;
  t = (unsigned)__builtin_amdgcn_update_dpp(0, (int)v, 0x121, 0xf, 0xf, false); v = v > t ? v : t;
  const unsigned a = (unsigned)__builtin_amdgcn_readlane((int)v, 0), b = (unsigned)__builtin_amdgcn_readlane((int)v, 16);
  const unsigned c = (unsigned)__builtin_amdgcn_readlane((int)v, 32), d = (unsigned)__builtin_amdgcn_readlane((int)v, 48);
  const unsigned ab = a > b ? a : b, cd = c > d ? c : d;
  return ab > cd ? ab : cd;
}
DI float fkey_inv(unsigned k) { return __uint_as_float((k & 0x80000000u) ? (k ^ 0x80000000u) : ~k); }
DI int lane_rank(unsigned long long m) {
  return __builtin_amdgcn_mbcnt_hi((unsigned)(m >> 32), __builtin_amdgcn_mbcnt_lo((unsigned)m, 0u));
}
template <int G>
DI void topk_group(const float (&vin)[G][4], float* wbase, int* oidx, float* ogate) {
  const int lane = threadIdx.x & 63;
  {
    unsigned k[G][4];
    float v[G][4];
#pragma unroll
    for (int g = 0; g < G; ++g) {
#pragma unroll
      for (int q = 0; q < 4; ++q) { v[g][q] = vin[g][q]; k[g][q] = fkey(v[g][q]); }
    }
    unsigned T[G][2], Mk[G][2];
    int n[G][2];
#pragma unroll
    for (int g = 0; g < G; ++g)
#pragma unroll
      for (int part = 0; part < 2; ++part) {
        const unsigned ka = k[g][2 * part], kb = k[g][2 * part + 1];
        const unsigned M = wmax_u32_fast(ka > kb ? ka : kb);
        Mk[g][part] = M;
        unsigned P = M >> 23;
        unsigned Tc; int c;
        for (;;) {
          Tc = P << 23;
          c = __popcll(__ballot(ka >= Tc)) + __popcll(__ballot(kb >= Tc));
          if (c >= 16 || P == 0u) break;
          --P;
        }
        T[g][part] = Tc; n[g][part] = c;
      }
#pragma unroll 1
    for (int bit = 22; bit >= 0; --bit) {
      bool done = true;
#pragma unroll
      for (int g = 0; g < G; ++g) done = done && (n[g][0] == 16) && (n[g][1] == 16);
      if (done) break;
      const unsigned bm = 1u << bit;
#pragma unroll
      for (int g = 0; g < G; ++g) {
        const unsigned t0 = T[g][0] | bm, t1 = T[g][1] | bm;
        const int c0 = __popcll(__ballot(k[g][0] >= t0)) + __popcll(__ballot(k[g][1] >= t0));
        const int c1 = __popcll(__ballot(k[g][2] >= t1)) + __popcll(__ballot(k[g][3] >= t1));
        if (c0 >= 16) { T[g][0] = t0; n[g][0] = c0; }
        if (c1 >= 16) { T[g][1] = t1; n[g][1] = c1; }
      }
    }
    unsigned ck[G][4];
    float cv[G][4];
#pragma unroll
    for (int g = 0; g < G; ++g) {
      float* sv = wbase + g * 128;
      int* si = (int*)(sv + 32);
#pragma unroll
      for (int part = 0; part < 2; ++part) {
        const unsigned Tp = T[g][part];
        const unsigned long long m0 = __ballot(k[g][2 * part] >= Tp), m1 = __ballot(k[g][2 * part + 1] >= Tp);
        const int r0 = lane_rank(m0), r1 = __popcll(m0) + lane_rank(m1);
        if (k[g][2 * part] >= Tp && r0 < 16) { sv[part * 16 + r0] = v[g][2 * part]; si[part * 16 + r0] = lane; }
        if (k[g][2 * part + 1] >= Tp && r1 < 16) { sv[part * 16 + r1] = v[g][2 * part + 1]; si[part * 16 + r1] = 64 + lane; }
      }
    }
#pragma unroll
    for (int g = 0; g < G; ++g) {
      const float* sv = wbase + g * 128;
      const float a = sv[lane >> 2];
#pragma unroll
      for (int q = 0; q < 4; ++q) { cv[g][q] = a + sv[16 + (lane & 3) * 4 + q]; ck[g][q] = fkey(cv[g][q]); }
    }
    unsigned T2[G];
    int n2[G];
#pragma unroll
    for (int g = 0; g < G; ++g) {
      const unsigned M = fkey(fkey_inv(Mk[g][0]) + fkey_inv(Mk[g][1]));
      unsigned P = M >> 23;
      unsigned Tc; int c;
      for (;;) {
        Tc = P << 23;
        c = __popcll(__ballot(ck[g][0] >= Tc)) + __popcll(__ballot(ck[g][1] >= Tc)) + __popcll(__ballot(ck[g][2] >= Tc)) + __popcll(__ballot(ck[g][3] >= Tc));
        if (c >= 16 || P == 0u) break;
        --P;
      }
      T2[g] = Tc; n2[g] = c;
    }
#pragma unroll 1
    for (int bit = 22; bit >= 0; --bit) {
      bool done = true;
#pragma unroll
      for (int g = 0; g < G; ++g) done = done && (n2[g] == 16);
      if (done) break;
      const unsigned bm = 1u << bit;
#pragma unroll
      for (int g = 0; g < G; ++g) {
        const unsigned t2 = T2[g] | bm;
        const int c = __popcll(__ballot(ck[g][0] >= t2)) + __popcll(__ballot(ck[g][1] >= t2)) + __popcll(__ballot(ck[g][2] >= t2)) + __popcll(__ballot(ck[g][3] >= t2));
        if (c >= 16) { T2[g] = t2; n2[g] = c; }
      }
    }
#pragma unroll
    for (int g = 0; g < G; ++g) {
      float* sv = wbase + g * 128;
      float* s2v = sv + 64;
      int* s2c = (int*)(sv + 80);
      int base = 0;
#pragma unroll
      for (int q = 0; q < 4; ++q) {
        const unsigned long long m = __ballot(ck[g][q] >= T2[g]);
        const int r = base + lane_rank(m);
        if (ck[g][q] >= T2[g] && r < 16) { s2v[r] = cv[g][q]; s2c[r] = lane * 4 + q; }
        base += __popcll(m);
      }
    }
    {
      const int g = (lane >> 4) % G, kk = lane & 15;
      const float* sv = wbase + g * 128;
      const int* si = (const int*)(sv + 32);
      const float* s2v = sv + 64;
      const int* s2c = (const int*)(sv + 80);
      const float val = s2v[kk];
      const float mx = rowmax16(val);
      const float ev = __expf(val - mx);
      const float ssum = rowsum16(ev);
      if (lane < 16 * G) {
        const int bc = s2c[kk];
        const int i0 = si[bc >> 4], i1 = si[16 + (bc & 15)];
        oidx[g * 16 + kk] = i0 * 128 + i1;
        ogate[g * 16 + kk] = ev / ssum;
      }
    }
  }
}
DI float dot16(const f32x2* hp, u32x4 u) {
  f32x2 d0 = {0.f, 0.f}, d1 = {0.f, 0.f};
#pragma unroll
  for (int q = 0; q < 4; ++q) {
    const int wq = (int)u[q];
    const f32x2 lo = __builtin_amdgcn_cvt_pk_f32_fp8(wq, false), hi = __builtin_amdgcn_cvt_pk_f32_fp8(wq, true);
    d0 = __builtin_elementwise_fma(hp[2 * q], lo, d0);
    d1 = __builtin_elementwise_fma(hp[2 * q + 1], hi, d1);
  }
  const f32x2 d = d0 + d1;
  return d.x + d.y;
}
DI float dot16_fp4(const f32x2* hp, u32x2 u) {
  f32x2 d0 = {0.f, 0.f}, d1 = {0.f, 0.f};
#pragma unroll
  for (int d = 0; d < 2; ++d) {
    const unsigned wq = u[d];
    d0 = __builtin_elementwise_fma(hp[4 * d], __builtin_amdgcn_cvt_scalef32_pk_f32_fp4(wq, 1.0f, 0), d0);
    d1 = __builtin_elementwise_fma(hp[4 * d + 1], __builtin_amdgcn_cvt_scalef32_pk_f32_fp4(wq, 1.0f, 1), d1);
    d0 = __builtin_elementwise_fma(hp[4 * d + 2], __builtin_amdgcn_cvt_scalef32_pk_f32_fp4(wq, 1.0f, 2), d0);
    d1 = __builtin_elementwise_fma(hp[4 * d + 3], __builtin_amdgcn_cvt_scalef32_pk_f32_fp4(wq, 1.0f, 3), d1);
  }
  const f32x2 dd = d0 + d1;
  return dd.x + dd.y;
}
DI void axpy16_fp4(f32x2* acc, float wgt, u32x2 v) {
  const f32x2 w2 = {wgt, wgt};
#pragma unroll
  for (int d = 0; d < 2; ++d) {
    const unsigned wq = v[d];
    acc[4 * d] = __builtin_elementwise_fma(w2, __builtin_amdgcn_cvt_scalef32_pk_f32_fp4(wq, 1.0f, 0), acc[4 * d]);
    acc[4 * d + 1] = __builtin_elementwise_fma(w2, __builtin_amdgcn_cvt_scalef32_pk_f32_fp4(wq, 1.0f, 1), acc[4 * d + 1]);
    acc[4 * d + 2] = __builtin_elementwise_fma(w2, __builtin_amdgcn_cvt_scalef32_pk_f32_fp4(wq, 1.0f, 2), acc[4 * d + 2]);
    acc[4 * d + 3] = __builtin_elementwise_fma(w2, __builtin_amdgcn_cvt_scalef32_pk_f32_fp4(wq, 1.0f, 3), acc[4 * d + 3]);
  }
}
DI void phase_peer(const Params& p, int layer, int ntok, float* dstbase, char* smem) {
  const int lane = threadIdx.x & 63;
  const int w = __builtin_amdgcn_readfirstlane(threadIdx.x >> 6);
  const unsigned char* U = p.U8 + (long)layer * 16384 * 512;
  const unsigned char* V = p.V8 + (long)layer * 16384 * 512;
  const float* SU = p.SCU + layer * 16384;
  const float* SV = p.SCV + layer * 16384;
  const float* modl = p.MOD + (long)layer * 9 * 6144;
  float* wtk = (float*)smem + w * 768;
  int* eidx_s = (int*)(wtk + 512);
  float* gate_s = wtk + 640;
  for (int t = blockIdx.x * 4 + w; t < ntok; t += gridDim.x * 4) {
    f32x2 hp[8];
    {
      const u32x4 ha = *(const u32x4*)(p.HB + (long)t * 1024 + lane * 16);
      const u32x4 hb = *(const u32x4*)(p.HB + (long)t * 1024 + lane * 16 + 8);
#pragma unroll
      for (int q = 0; q < 4; ++q) { hp[q].x = bflo(ha[q]); hp[q].y = bfhi(ha[q]); hp[4 + q].x = bflo(hb[q]); hp[4 + q].y = bfhi(hb[q]); }
    }
    constexpr int NB = 16;
    u32x2 un[NB], vn[NB];
    int idxA; float gA, suA, svAr;
    {
      float sva[4][4], svb[4][4];
      const float* scp = p.SC + (long)t * 2048 + lane;
#pragma unroll
      for (int g = 0; g < 4; ++g)
#pragma unroll
        for (int q = 0; q < 4; ++q) { sva[g][q] = scp[g * 256 + q * 64]; svb[g][q] = scp[1024 + g * 256 + q * 64]; }
      topk_group<4>(sva, wtk, eidx_s, gate_s);
      idxA = eidx_s[lane];
      gA = gate_s[lane];
      suA = SU[idxA];
      svAr = SV[idxA];
#pragma unroll
      for (int j = 0; j < NB; ++j) {
        const int idx = __builtin_amdgcn_readlane(idxA, j);
        un[j] = *(const u32x2*)(U + (long)idx * 512 + lane * 8);
        vn[j] = *(const u32x2*)(V + (long)idx * 512 + lane * 8);
      }
      topk_group<4>(svb, wtk, eidx_s + 64, gate_s + 64);
    }
    const int idxB = eidx_s[64 + lane];
    const float gB = gate_s[64 + lane];
    const float suB = SU[idxB];
    const float gvA = gA * svAr, gvB = gB * SV[idxB];
    f32x2 acc2[8];
#pragma unroll
    for (int j = 0; j < 8; ++j) { acc2[j].x = 0.f; acc2[j].y = 0.f; }
#pragma unroll 1
    for (int b = 0; b < 128 / NB; ++b) {
      const int l0 = (b * NB) & 63;
      const bool hiHalf = b * NB >= 64;
      u32x2 uc[NB];
      u32x2 vc[NB];
#pragma unroll
      for (int j = 0; j < NB; ++j) {
        uc[j] = un[j];
        vc[j] = vn[j];
      }
      if (b + 1 < 128 / NB) {
        const int l1 = ((b + 1) * NB) & 63;
        const bool hi1 = (b + 1) * NB >= 64;
#pragma unroll
        for (int j = 0; j < NB; ++j) {
          const int idx = hi1 ? __builtin_amdgcn_readlane(idxB, l1 + j) : __builtin_amdgcn_readlane(idxA, l1 + j);
          un[j] = *(const u32x2*)(U + (long)idx * 512 + lane * 8);
          vn[j] = *(const u32x2*)(V + (long)idx * 512 + lane * 8);
        }
      }
      float dsel = 0.f;
#pragma unroll
      for (int j = 0; j < NB; ++j) {
        const float d = rowsum16(dot16_fp4(hp, uc[j]));
        if ((lane & (NB - 1)) == j) dsel = d;
      }
      dsel += __shfl_xor(dsel, 16);
      dsel += __shfl_xor(dsel, 32);
      const float wv = hiHalf ? gvB * gelu_tanh(dsel * suB) : gvA * gelu_tanh(dsel * suA);
      const int wvi = __builtin_bit_cast(int, wv);
#pragma unroll
      for (int j = 0; j < NB; ++j) {
        const float wj = __builtin_bit_cast(float, __builtin_amdgcn_readlane(wvi, l0 + j));
        axpy16_fp4(acc2, wj, vc[j]);
      }
    }
    float acc[16];
#pragma unroll
    for (int j = 0; j < 8; ++j) { acc[2 * j] = acc2[j].x; acc[2 * j + 1] = acc2[j].y; }
    const int bi = (t < TL) ? (t >> 11) : 8;
    const float* g2 = modl + bi * 6144 + 5120 + lane * 16;
    const float* xr = p.XRES + (long)t * 1024 + lane * 16;
    float* dst = dstbase + (long)t * 1024 + lane * 16;
    float ssq = 0.f;
#pragma unroll
    for (int q = 0; q < 4; ++q) {
      const f32x4 x0 = *(const f32x4*)(xr + q * 4);
      const f32x4 ga = *(const f32x4*)(g2 + q * 4);
      f32x4 o = {x0.x + ga.x * acc[q * 4], x0.y + ga.y * acc[q * 4 + 1], x0.z + ga.z * acc[q * 4 + 2], x0.w + ga.w * acc[q * 4 + 3]};
      *(f32x4*)(dst + q * 4) = o;
      acc[q * 4] = o.x; acc[q * 4 + 1] = o.y; acc[q * 4 + 2] = o.z; acc[q * 4 + 3] = o.w;
      ssq += o.x * o.x + o.y * o.y + o.z * o.z + o.w * o.w;
    }
    if (layer == 0) {
      const float rstd = rsqrtf(wsum_fast(ssq) * (1.f / 1024.f) + EPSF);
      const float* md1 = p.MOD + (long)(9 + bi) * 6144 + lane * 16;
      const float* nw1 = p.norm1_w + 1024 + lane * 16;
      float y[16];
#pragma unroll
      for (int q = 0; q < 4; ++q) {
        const f32x4 nw = *(const f32x4*)(nw1 + q * 4);
        const f32x4 sh = *(const f32x4*)(md1 + q * 4);
        const f32x4 sc = *(const f32x4*)(md1 + 1024 + q * 4);
        y[q * 4] = acc[q * 4] * rstd * nw.x * (1.f + sc.x) + sh.x;
        y[q * 4 + 1] = acc[q * 4 + 1] * rstd * nw.y * (1.f + sc.y) + sh.y;
        y[q * 4 + 2] = acc[q * 4 + 2] * rstd * nw.z * (1.f + sc.z) + sh.z;
        y[q * 4 + 3] = acc[q * 4 + 3] * rstd * nw.w * (1.f + sc.w) + sh.w;
      }
      *(u32x4*)(p.HB + (long)t * 1024 + lane * 16) = pack8f(y);
      *(u32x4*)(p.HB + (long)t * 1024 + lane * 16 + 8) = pack8f(y + 8);
    }
  }
}

#ifdef EXPERIMENT
#define REPL(k) for (int rep_ = 0; rep_ < p.rep[k]; ++rep_)
#else
#define REPL(k)
#endif
DI void run_phase(const Params& p, int ph, char* smem) {
  const float* mod0 = p.MOD;
  const float* mod1 = p.MOD + 9 * 6144;
  EpiArgs ea;
  ea.C = nullptr; ea.ldc = 0; ea.N = 0; ea.xin_lat = nullptr; ea.xin_ctx = nullptr; ea.g = nullptr;
  switch (ph) {
    case 0: REPL(5) phase_prep(p, smem); break;
    case 1: REPL(1) phase_modulate(p, p.x, p.ctx, TA, p.norm1_w, mod0, 0, 1024); break;
    case 2: ea.C = p.Z; ea.ldc = 1312; ea.N = 1312; gemm_phase<0>(smem, p.HB, 1024, 0, p.WT_ABIN, 1024, 144, 11, 0, ea);
      {
        const int nslot = gridDim.x >> 3, slot = blockIdx.x >> 3, busy = 198 % nslot;
        const int nidle = nslot - busy;
        if (slot >= busy) {
          const int wi = (slot - busy) * 8 + (blockIdx.x & 7), nwk = nidle * 8;
          convert_fp4_rows(p.peer_u, p.U8, p.SCU, 2 * 16384, wi, nwk);
        }
      }
      break;
    case 3: phase_post0a(p); break;
    case 4:
      ea.C = p.QB; ea.ldc = 768; ea.N = 768; gemm_phase<0>(smem, p.Z + 768, 1312, 0, p.WT_UQ, 256, 144, 6, 0, ea);
      ea.C = p.KVR; ea.ldc = 1024; ea.N = 1024; gemm_phase<0>(smem, p.Z + 1024, 1312, 0, p.WT_UKV, 256, 144, 8, 108, ea);
      break;
    case 5: phase_post0b(p); break;
    case 6: REPL(3) phase_attn0(p, smem); break;
    case 7: ea.C = p.XRES; ea.N = 1024; ea.xin_lat = p.x; ea.xin_ctx = p.ctx; ea.g = mod0 + 2048;
      gemm_phase<2>(smem, p.AO, 1024, 0, p.WT_ABO, 1024, 144, 8, 0, ea);
      {
        const int nslot = gridDim.x >> 3, slot = blockIdx.x >> 3, busy = 144 % nslot;
        if (slot >= busy) convert_fp4_rows(p.peer_v, p.V8, p.SCV, 2 * 16384, (slot - busy) * 8 + (blockIdx.x & 7), (nslot - busy) * 8);
      }
      break;
    case 8: REPL(1) phase_modulate(p, p.XRES, p.XRES + (long)TL * 1024, TA, p.norm2_w, mod0, 3072, 4096); break;
    case 9: gemm_pq_scores(smem, p.HB, p.WT_PQ, p.KEYS16, p.SC, 144); break;
    case 10: phase_peer(p, 0, TA, p.XRES, smem); break;
    case 11: ea.C = p.Z; ea.ldc = 2304; ea.N = 2304; gemm_phase<0>(smem, p.HB, 1024, 0, p.WT_CDIN, 1024, 144, 18, 0, ea); break;
    case 12: phase_post1(p); break;
    case 13: REPL(4) phase_attn1(p, smem); break;
    case 14: REPL(2) for (int id = blockIdx.x; id < 512; id += gridDim.x) ret_out_item(p, smem, id); break;
    case 15: ea.C = p.XRES; ea.N = 1024; ea.g = mod1 + 2048; gemm_phase<3>(smem, p.AO, 1024, 0, p.WT_CDO, 1024, 128, 8, 0, ea); break;
    case 16: REPL(1) phase_modulate(p, p.XRES, p.XRES + (long)TL * 1024, TL, p.norm2_w + 1024, mod1, 3072, 4096); break;
    case 17: gemm_pq_scores(smem, p.HB, p.WT_PQ + 2048L * 1024, p.KEYS16 + 16L * 128 * 128, p.SC, 128); break;
    case 18: phase_peer(p, 1, TL, p.out, smem); break;
    default: break;
  }
}


#define XB_TMO      128
#define XB_XCNT(j)  (256  + 64 * (j))
#define XB_XSUB(j)  (1280 + 64 * (j))
#define XB_XGEN(j)  (2304 + 64 * (j))
#define XB_TOP      3328
#define XB_TOPGEN   3392
#define XCD_BAR_WORDS 3456
#define XB_SPIN_CAP (1u << 20)
#define LAS __attribute__((address_space(3)))
DI unsigned xb_ld(unsigned* p) { return __hip_atomic_load(p, __ATOMIC_RELAXED, __HIP_MEMORY_SCOPE_AGENT); }
DI unsigned xb_add(unsigned* p, unsigned v) { return __hip_atomic_fetch_add(p, v, __ATOMIC_RELAXED, __HIP_MEMORY_SCOPE_AGENT); }
DI unsigned xb_xcc_id() { return (unsigned)__builtin_amdgcn_s_getreg((3 << 11) | 20) & 0xFu; }
#define XB_SPIN(cond, bar) do { unsigned _sp = 0; while (cond) { __builtin_amdgcn_s_sleep(1); \
    if ((++_sp & 255u) == 0u) { if (xb_ld(&(bar)[XB_TMO])) break; if (_sp > XB_SPIN_CAP) { atomicAdd(&(bar)[XB_TMO], 1u); break; } } } } while (0)
struct XcdBarrier { unsigned* bar; unsigned x; volatile LAS unsigned* st; };
DI XcdBarrier xcd_barrier_post(unsigned* bar, volatile LAS unsigned* st) {
  XcdBarrier b; b.bar = bar; b.x = xb_xcc_id(); b.st = st;
  if (threadIdx.x == 0) (void)xb_add(&bar[XB_XCNT(b.x)], 1u);
  return b;
}
DI void xcd_barrier_complete(unsigned* bar, unsigned x, unsigned& nloc, unsigned& nx) {
  const unsigned G = gridDim.x * gridDim.y * gridDim.z;
  unsigned sum, cnt, mine, sp = 0u;
  for (;;) {
    sum = 0u; cnt = 0u; mine = 0u;
#pragma unroll
    for (unsigned j = 0; j < 16; ++j) { const unsigned c = xb_ld(&bar[XB_XCNT(j)]); sum += c; cnt += (c > 0u) ? 1u : 0u; mine = (j == x) ? c : mine; }
    if (sum == G) break;
    __builtin_amdgcn_s_sleep(1);
    if ((++sp & 255u) == 0u) { if (xb_ld(&bar[XB_TMO])) break; if (sp > XB_SPIN_CAP) { atomicAdd(&bar[XB_TMO], 1u); break; } }
  }
  nloc = mine > 0u ? mine : 1u; nx = cnt > 0u ? cnt : 1u;
}
DI void xcd_barrier(const XcdBarrier& b) {
  asm volatile("s_waitcnt vmcnt(0)" ::: "memory");
  __syncthreads();
  if (threadIdx.x == 0) {
    unsigned* bar = b.bar;
    __builtin_amdgcn_s_waitcnt(0);
    unsigned nloc = b.st[0], nx = b.st[1];
    if (nloc == 0u) { xcd_barrier_complete(bar, b.x, nloc, nx); b.st[0] = nloc; b.st[1] = nx; }
    const unsigned old = xb_add(&bar[XB_XSUB(b.x)], 1u);
    const unsigned gen = old / nloc;
    if (old + 1u == (gen + 1u) * nloc) {
      __builtin_amdgcn_fence(__ATOMIC_RELEASE, "agent");
      asm volatile("s_waitcnt vmcnt(0)" ::: "memory");
      const unsigned og = xb_add(&bar[XB_TOP], 1u);
      const unsigned tg = og / nx;
      if (og + 1u == (tg + 1u) * nx) xb_add(&bar[XB_TOPGEN], 1u);
      else XB_SPIN(xb_ld(&bar[XB_TOPGEN]) == tg, bar);
      __builtin_amdgcn_fence(__ATOMIC_ACQUIRE, "agent");
      xb_add(&bar[XB_XGEN(b.x)], 1u);
      asm volatile("s_waitcnt vmcnt(0)" ::: "memory");
    } else {
      XB_SPIN(xb_ld(&bar[XB_XGEN(b.x)]) == gen, bar);
      __builtin_amdgcn_fence(__ATOMIC_ACQUIRE, "agent");
      asm volatile("s_waitcnt vmcnt(0)" ::: "memory");
    }
  }
  __syncthreads();
}

#if MULTI_LAUNCH
template <int PH>
__global__ void __launch_bounds__(256, 2) phase_kernel(KArgs a) {
  __shared__ __attribute__((aligned(16))) char smem[73728];
  const Params p = make_params(a);
  run_phase(p, PH, smem);
}
template <int PH>
static void launch_all(const KArgs& a, hipStream_t stream) {
  hipLaunchKernelGGL(phase_kernel<PH>, dim3(512), dim3(256), 0, stream, a);
  if constexpr (PH + 1 < NPHASE) launch_all<PH + 1>(a, stream);
}
#else
template <int PH>
DI void run_from(const Params& p, char* smem, cg::grid_group& grid, const XcdBarrier& xb) {
  run_phase(p, PH, smem);
  if constexpr (PH + 1 < NPHASE) {
    if constexpr (PH == 0) { if (p.out == nullptr) grid.sync(); }
    xcd_barrier(xb);
    run_from<PH + 1>(p, smem, grid, xb);
  }
}
__global__ void __launch_bounds__(256, 2) mega_kernel(KArgs a) {
  __shared__ __attribute__((aligned(16))) char smem[73728];
  __shared__ __attribute__((aligned(16))) unsigned xb_words[4];
  if (threadIdx.x < 4) xb_words[threadIdx.x] = 0u;
  __syncthreads();
  const Params p = make_params(a);
  const XcdBarrier xb = xcd_barrier_post(p.BAR, (volatile LAS unsigned*)xb_words);
  cg::grid_group grid = cg::this_grid();
  run_from<0>(p, smem, grid, xb);
}
#endif

extern "C" void kernel_launch(void* const* d_in, const int* in_sizes, int n_in, void* d_out, int out_size, void* d_ws, size_t ws_size,
                              hipStream_t stream) {
  KArgs a;
  memset(&a, 0, sizeof(a));
  for (int i = 0; i < 30; ++i) a.in[i] = (const float*)d_in[i];
  a.out = (float*)d_out;
  a.ws = (char*)d_ws;
#ifdef EXPERIMENT
  { const int r[8] = {EXPERIMENT}; for (int i = 0; i < 8; ++i) a.rep[i] = r[i]; }
#endif
  (void)hipMemsetAsync((char*)d_ws + OFF_MOD, 0, (OFF_BAR - OFF_MOD) + 4096 * 4, stream);
#if MULTI_LAUNCH
  launch_all<0>(a, stream);
#else
  static int grid_blocks = 0;
  if (!grid_blocks) {
    int dev = 0, cus = 0, per_cu = 0;
    (void)hipGetDevice(&dev);
    (void)hipDeviceGetAttribute(&cus, hipDeviceAttributeMultiprocessorCount, dev);
    (void)hipOccupancyMaxActiveBlocksPerMultiprocessor(&per_cu, mega_kernel, 256, 0);
    if (per_cu > 2) per_cu = 2;
    if (per_cu < 1) per_cu = 1;
    grid_blocks = (cus * per_cu) & ~7;
  }
  void* args[] = {&a};
  hipError_t e = hipLaunchCooperativeKernel((void*)mega_kernel, dim3(grid_blocks), dim3(256), args, 0, stream);
  if (e != hipSuccess) fprintf(stderr, "cooperative launch failed: %s (grid %d)\n", hipGetErrorString(e), grid_blocks);
#endif
}
```
